# Optimizing an MI355X kernel written in HIP

```python
import math
import jax, jax.numpy as jnp
from jax import lax
import numpy as np

D_MODEL = 1024
BATCH = 4
SEQ = 8192
DEPTH = 2

CHUNK = 64
N_META = 16
Q_BLOCK = 128
N_MIXERS = 2
MLA_HEADS = 16
MLA_Q_RANK = 384
MLA_KV_RANK = 256
MLA_NOPE = 64
MLA_ROPE = 32
MLA_V = 64
MLA_QK = MLA_NOPE + MLA_ROPE
ROPE_THETA = 10000.0
GLA_HEADS = 4
GLA_DK = D_MODEL // 2 // GLA_HEADS
GLA_DV = D_MODEL // GLA_HEADS
GLA_GATE_RANK = 16
GLA_TAU = 16.0
N_GROUPS = 4
EXPERTS_PER_GROUP = 8
N_EXPERTS = N_GROUPS * EXPERTS_PER_GROUP
TOP_K = 2
D_EXPERT = 256
EPS = 1e-6

N_MLA_LAYERS = (DEPTH + 1) // 2
N_GLA_LAYERS = DEPTH // 2
MLA_IN = MLA_Q_RANK + MLA_KV_RANK + MLA_ROPE
GLA_NK = GLA_HEADS * GLA_DK
GLA_NV = GLA_HEADS * GLA_DV
GLA_IN = 2 * GLA_NK + GLA_NV + GLA_GATE_RANK + GLA_NV

kernel_name = "hybrid_mla_gla_hmoe_streaming"


def rms_norm(x, g):
    xf = x.astype(jnp.float32)
    y = xf * lax.rsqrt(jnp.mean(xf * xf, axis=-1, keepdims=True) + EPS)
    return (y * g.astype(jnp.float32)).astype(x.dtype)


def chunk_ids(n):
    p = jnp.arange(n)
    return jnp.where(p < N_META, 0, 1 + (p - N_META) // CHUNK)


def rope(x, pos):
    half = x.shape[-1] // 2
    inv = 1.0 / (ROPE_THETA ** (jnp.arange(half, dtype=jnp.float32) / half))
    ang = pos.astype(jnp.float32)[:, None] * inv[None, :]
    cos = jnp.cos(ang)[:, None, :]
    sin = jnp.sin(ang)[:, None, :]
    xf = x.astype(jnp.float32)
    x1, x2 = xf[..., :half], xf[..., half:]
    return jnp.concatenate([x1 * cos - x2 * sin, x2 * cos + x1 * sin], axis=-1).astype(x.dtype)


def block_causal_attention(q, k, v):
    B, L, H, dh = q.shape
    nblk = L // Q_BLOCK
    cid = chunk_ids(L)
    scale = dh ** -0.5
    qb = q.reshape(B, nblk, Q_BLOCK, H, dh).transpose(1, 0, 3, 2, 4)
    cb = cid.reshape(nblk, Q_BLOCK)
    kt = k.transpose(0, 2, 1, 3)
    vt = v.transpose(0, 2, 1, 3)

    def one_block(args):
        q_blk, c_blk = args
        s = jnp.einsum('bhqd,bhkd->bhqk', q_blk, kt,
                       preferred_element_type=jnp.float32) * scale
        mask = c_blk[:, None] >= cid[None, :]
        s = jnp.where(mask[None, None], s, -jnp.inf)
        p = jax.nn.softmax(s, axis=-1)
        return jnp.einsum('bhqk,bhkd->bhqd', p.astype(vt.dtype), vt)

    o = lax.map(one_block, (qb, cb))
    return o.transpose(1, 0, 3, 2, 4).reshape(B, L, H, -1)


def mla_mixer(h, w_in, g_q, w_uq, g_kv, w_ukv, g_qn, g_kn, w_o):
    B, L, _ = h.shape
    z = h @ w_in
    c_q, c_kv, k_r = jnp.split(z, [MLA_Q_RANK, MLA_Q_RANK + MLA_KV_RANK], axis=-1)
    q = (rms_norm(c_q, g_q) @ w_uq).reshape(B, L, MLA_HEADS, MLA_QK)
    kv = (rms_norm(c_kv, g_kv) @ w_ukv).reshape(B, L, MLA_HEADS, MLA_NOPE + MLA_V)
    k_nope, v = jnp.split(kv, [MLA_NOPE], axis=-1)
    k_r = jnp.broadcast_to(k_r[:, :, None, :], (B, L, MLA_HEADS, MLA_ROPE))
    k = jnp.concatenate([k_nope, k_r], axis=-1)
    q = rms_norm(q, g_qn)
    k = rms_norm(k, g_kn)
    pos = jnp.arange(L)
    q = jnp.concatenate([q[..., :MLA_NOPE], rope(q[..., MLA_NOPE:], pos)], axis=-1)
    k = jnp.concatenate([k[..., :MLA_NOPE], rope(k[..., MLA_NOPE:], pos)], axis=-1)
    o = block_causal_attention(q, k, v)
    return o.reshape(B, L, MLA_HEADS * MLA_V) @ w_o


def gla_mixer(h, w_in, w_gate_up, b_gate, g_out, w_o):
    B, L, _ = h.shape
    f32 = jnp.float32
    z = h @ w_in
    q, k, v, g_lr, r = jnp.split(
        z, [GLA_NK, 2 * GLA_NK, 2 * GLA_NK + GLA_NV, 2 * GLA_NK + GLA_NV + GLA_GATE_RANK], axis=-1)
    log_a = jax.nn.log_sigmoid((g_lr @ w_gate_up + b_gate).astype(f32)) / GLA_TAU
    n = L // CHUNK

    def heads(t, d):
        return t.astype(f32).reshape(B, n, CHUNK, GLA_HEADS, d).transpose(1, 0, 3, 2, 4)

    qc = heads(q, GLA_DK) * (GLA_DK ** -0.5)
    kc = heads(k, GLA_DK)
    vc = heads(v, GLA_DV)
    gc = heads(log_a, GLA_DK)
    tri = jnp.tril(jnp.ones((CHUNK, CHUNK), dtype=bool))

    def step(S, inp):
        qq, kk, vv, gg = inp
        b = jnp.cumsum(gg, axis=-2)
        o_inter = jnp.einsum('bhck,bhkv->bhcv', qq * jnp.exp(b), S)
        diff = b[:, :, :, None, :] - b[:, :, None, :, :]
        decay = jnp.exp(jnp.where(tri[:, :, None], diff, -jnp.inf))
        att = jnp.einsum('bhtk,bhtsk,bhsk->bhts', qq, decay, kk)
        o = o_inter + jnp.einsum('bhts,bhsv->bhtv', att, vv)
        b_last = b[:, :, -1:, :]
        S = jnp.exp(b_last[:, :, 0, :, None]) * S + jnp.einsum(
            'bhck,bhcv->bhkv', kk * jnp.exp(b_last - b), vv)
        return S, o

    S0 = jnp.zeros((B, GLA_HEADS, GLA_DK, GLA_DV), f32)
    _, o = lax.scan(step, S0, (qc, kc, vc, gc))
    o = o.transpose(1, 0, 3, 2, 4).reshape(B, L, GLA_HEADS, GLA_DV)
    o = rms_norm(o, g_out).astype(h.dtype).reshape(B, L, GLA_NV)
    o = o * jax.nn.silu(r)
    return o @ w_o


def hier_moe(h, w_rg, b_rg, w_re, b_re, w_gate, w_up, w_down):
    B, L, D = h.shape
    f32 = jnp.float32
    t = h.reshape(-1, D)
    g_logits = (t @ w_rg).astype(f32) + b_rg.astype(f32)
    g_prob = jax.nn.softmax(g_logits, axis=-1)
    g_sel = jnp.argmax(g_logits, axis=-1)
    p_g = jnp.take_along_axis(g_prob, g_sel[:, None], axis=-1)
    e_logits = ((t @ w_re).astype(f32) + b_re.astype(f32)).reshape(-1, N_GROUPS, EXPERTS_PER_GROUP)
    e_logits = jnp.take_along_axis(e_logits, g_sel[:, None, None], axis=1)[:, 0]
    e_prob = jax.nn.softmax(e_logits, axis=-1)
    top_p, top_i = lax.top_k(e_prob, TOP_K)
    top_w = top_p / jnp.sum(top_p, axis=-1, keepdims=True) * p_g
    expert_id = g_sel[:, None] * EXPERTS_PER_GROUP + top_i
    gates = jnp.einsum('tk,tke->te', top_w, jax.nn.one_hot(expert_id, N_EXPERTS, dtype=f32))
    out = jnp.zeros(t.shape, f32)
    for e in range(N_EXPERTS):
        hid = jax.nn.silu(t @ w_gate[e]) * (t @ w_up[e])
        out = out + gates[:, e:e + 1] * (hid @ w_down[e]).astype(f32)
    return out.astype(h.dtype).reshape(B, L, D)


def setup_inputs(seed: int = 0) -> dict:
    key = jax.random.key(seed)
    ks = iter(jax.random.split(key, 40))
    f32 = jnp.float32

    def dense(shape, fan_in):
        return jax.random.normal(next(ks), shape, f32) * (fan_in ** -0.5)

    def gain(shape):
        return 1.0 + 0.01 * jax.random.normal(next(ks), shape, f32)

    def bias(shape, s):
        return s * jax.random.normal(next(ks), shape, f32)

    nm, ng = N_MLA_LAYERS, N_GLA_LAYERS
    return {
        "x": jax.random.normal(next(ks), (BATCH, SEQ, D_MODEL), f32),
        "meta_tokens": jax.random.normal(next(ks), (N_META, D_MODEL), f32),
        "norm_mix": gain((DEPTH, D_MODEL)),
        "norm_ffn": gain((DEPTH, D_MODEL)),
        "mla_w_in": dense((nm, D_MODEL, MLA_IN), D_MODEL),
        "mla_g_q": gain((nm, MLA_Q_RANK)),
        "mla_w_uq": dense((nm, MLA_Q_RANK, MLA_HEADS * MLA_QK), MLA_Q_RANK),
        "mla_g_kv": gain((nm, MLA_KV_RANK)),
        "mla_w_ukv": dense((nm, MLA_KV_RANK, MLA_HEADS * (MLA_NOPE + MLA_V)), MLA_KV_RANK),
        "mla_g_qn": gain((nm, MLA_QK)),
        "mla_g_kn": gain((nm, MLA_QK)),
        "mla_w_o": dense((nm, MLA_HEADS * MLA_V, D_MODEL), MLA_HEADS * MLA_V),
        "gla_w_in": dense((ng, D_MODEL, GLA_IN), D_MODEL),
        "gla_w_gate_up": dense((ng, GLA_GATE_RANK, GLA_NK), GLA_GATE_RANK),
        "gla_b_gate": bias((ng, GLA_NK), 0.1),
        "gla_g_out": gain((ng, GLA_DV)),
        "gla_w_o": dense((ng, GLA_NV, D_MODEL), GLA_NV),
        "moe_w_rg": dense((DEPTH, D_MODEL, N_GROUPS), D_MODEL),
        "moe_b_rg": bias((DEPTH, N_GROUPS), 0.01),
        "moe_w_re": dense((DEPTH, D_MODEL, N_EXPERTS), D_MODEL),
        "moe_b_re": bias((DEPTH, N_EXPERTS), 0.01),
        "moe_w_gate": dense((DEPTH, N_EXPERTS, D_MODEL, D_EXPERT), D_MODEL),
        "moe_w_up": dense((DEPTH, N_EXPERTS, D_MODEL, D_EXPERT), D_MODEL),
        "moe_w_down": dense((DEPTH, N_EXPERTS, D_EXPERT, D_MODEL), D_EXPERT),
    }


def reference(x, meta_tokens, norm_mix, norm_ffn,
              mla_w_in, mla_g_q, mla_w_uq, mla_g_kv, mla_w_ukv, mla_g_qn, mla_g_kn, mla_w_o,
              gla_w_in, gla_w_gate_up, gla_b_gate, gla_g_out, gla_w_o,
              moe_w_rg, moe_b_rg, moe_w_re, moe_b_re, moe_w_gate, moe_w_up, moe_w_down):
    B, S, D = x.shape
    L = N_META + S
    Lp = ((L + Q_BLOCK - 1) // Q_BLOCK) * Q_BLOCK
    meta = jnp.broadcast_to(meta_tokens.astype(x.dtype)[None], (B, N_META, D))
    h = jnp.concatenate([meta, x, jnp.zeros((B, Lp - L, D), x.dtype)], axis=1)
    for i in range(DEPTH):
        j = i // N_MIXERS
        hn = rms_norm(h, norm_mix[i])
        if i % N_MIXERS == 0:
            h = h + mla_mixer(hn, mla_w_in[j], mla_g_q[j], mla_w_uq[j], mla_g_kv[j],
                              mla_w_ukv[j], mla_g_qn[j], mla_g_kn[j], mla_w_o[j])
        else:
            h = h + gla_mixer(hn, gla_w_in[j], gla_w_gate_up[j], gla_b_gate[j],
                              gla_g_out[j], gla_w_o[j])
        h = h + hier_moe(rms_norm(h, norm_ffn[i]), moe_w_rg[i], moe_b_rg[i], moe_w_re[i],
                         moe_b_re[i], moe_w_gate[i], moe_w_up[i], moe_w_down[i])
    return h[:, N_META:N_META + S]
```

```cpp
#include <hip/hip_runtime.h>
#include <cstdio>
#include <cstdint>

#define LAS __attribute__((address_space(3)))
#define GAS __attribute__((address_space(1)))
typedef unsigned short bf16;
typedef short bf16x8 __attribute__((ext_vector_type(8)));
typedef short s16x4 __attribute__((ext_vector_type(4)));
typedef float f32x4 __attribute__((ext_vector_type(4)));
typedef float f32x16 __attribute__((ext_vector_type(16)));
typedef unsigned u32x4 __attribute__((ext_vector_type(4)));
typedef unsigned u32x2 __attribute__((ext_vector_type(2)));
typedef GAS unsigned gu32;

constexpr int NB = 4, SEQ = 8192, DM = 1024;
constexpr int NREAL = NB * SEQ;
constexpr int MROWS = NREAL + 256;
constexpr int NTILE = 129;
constexpr int NHEAD = 16, QK = 96, NOPE = 64, ROPE = 32, VD = 64;
constexpr int MLA_Q = 384, MLA_KV = 256, MLA_IN = 672, MLA_INP = 768;
constexpr int GH = 4, GDK = 128, GDV = 256, GNK = 512, GNV = 1024, GLA_IN = 3088, GLA_INP = 3328;
constexpr int NEXP = 32, DEXP = 256;
constexpr float EPS = 1e-6f;
constexpr int NWAVES = 8, NTHREADS = 512;

__device__ __forceinline__ float bf2f(unsigned short b) { return __uint_as_float(((unsigned)b) << 16); }
__device__ __forceinline__ unsigned f2bf(float f) { unsigned u = __float_as_uint(f); return (u + 0x7fffu + ((u >> 16) & 1u)) >> 16; }
typedef float f32x2_t __attribute__((ext_vector_type(2))); typedef __bf16 bf16x2_t __attribute__((ext_vector_type(2)));
__device__ __forceinline__ unsigned pk2(float lo, float hi) { f32x2_t v = {lo, hi}; bf16x2_t b = __builtin_convertvector(v, bf16x2_t); return __builtin_bit_cast(unsigned, b); }
constexpr float KQ_SC = 0.38372263f;
__device__ __forceinline__ unsigned pk4_e4m3(float a, float b, float c, float d) {
    a = __builtin_amdgcn_fmed3f(a, -448.f, 448.f); b = __builtin_amdgcn_fmed3f(b, -448.f, 448.f); c = __builtin_amdgcn_fmed3f(c, -448.f, 448.f); d = __builtin_amdgcn_fmed3f(d, -448.f, 448.f);
    int w = 0; w = __builtin_amdgcn_cvt_pk_fp8_f32(a, b, w, false); w = __builtin_amdgcn_cvt_pk_fp8_f32(c, d, w, true); return (unsigned)w;
}
__device__ __forceinline__ unsigned pk4_bf8(float a, float b, float c, float d) { int w = 0; w = __builtin_amdgcn_cvt_pk_bf8_f32(a, b, w, false); w = __builtin_amdgcn_cvt_pk_bf8_f32(c, d, w, true); return (unsigned)w; }
__device__ __forceinline__ float max3f(float a, float b, float c) { float r; asm("v_max3_f32 %0, %1, %2, %3" : "=v"(r) : "v"(a), "v"(b), "v"(c)); return r; }
__device__ __forceinline__ float max2f(float a, float b) { float r; asm("v_max_f32_e32 %0, %1, %2" : "=v"(r) : "v"(a), "v"(b)); return r; }
__device__ __forceinline__ float wave_sum(float v) {
#pragma unroll
    for (int o = 1; o < 64; o <<= 1) v += __shfl_xor(v, o);
    return v;
}
#define LDS_WAIT() asm volatile("s_waitcnt lgkmcnt(0)" ::: "memory")
#define VM_WAIT() asm volatile("s_waitcnt vmcnt(0)" ::: "memory")

__device__ const float ROPE_INV[16] = {1.000000000e+00f, 5.623413324e-01f, 3.162277639e-01f, 1.778279394e-01f, 1.000000015e-01f, 5.623412877e-02f, 3.162277862e-02f, 1.778279431e-02f,
                                       9.999999776e-03f, 5.623413250e-03f, 3.162277862e-03f, 1.778279431e-03f, 1.000000047e-03f, 5.623413017e-04f, 3.162277862e-04f, 1.778279402e-04f};


__device__ __forceinline__ void fast_sincos(float a, float& sn, float& cs) {
    const float k = rintf(a * 0.15915494309189535f);
    float r = fmaf(-k, 6.2831854820251465f, a); r = fmaf(-k, -1.7484556e-7f, r);
    const float rev = r * 0.15915494309189535f;
    sn = __builtin_amdgcn_sinf(rev); cs = __builtin_amdgcn_cosf(rev);
}

__device__ __forceinline__ bool row_is_dummy(int r) { return r >= NREAL && ((r - NREAL) & 63) < 48; }
__device__ __forceinline__ int row_pos(int r) { return r < NREAL ? 16 + (r & (SEQ - 1)) : ((r - NREAL) & 63) - 48; }
__device__ __forceinline__ void row_btr(int r, int& b, int& tile, int& r64) {
    if (r < NREAL) { b = r >> 13; const int s = r & (SEQ - 1); tile = 1 + (s >> 6); r64 = s & 63; }
    else { const int q = r - NREAL; b = q >> 6; tile = 0; r64 = q & 63; }
}
__device__ __forceinline__ int row_of(int b, int tile, int r64) { return tile == 0 ? NREAL + b * 64 + r64 : b * SEQ + (tile - 1) * 64 + r64; }

namespace pg8 {
typedef unsigned short bf16_t;
constexpr int BM = 256, BK = 64, HALF = 128, HTB = HALF * BK * 2, STAGE_BYTES = 8 * HTB, NXCD = 8, WGM = 8;
__host__ __device__ __forceinline__ int lds_byte(int r, int c) { const int st = (r >> 4) * 2 + (c >> 5), rr = r & 15, cc = c & 31, ob = rr * 64 + cc * 2; return st * 1024 + (ob ^ (((ob >> 9) & 1) << 5)); }
__host__ __device__ __forceinline__ void stage_rc(int b, int& R, int& C) { const int st = b / 1024, sb = b % 1024, swz = sb ^ (((sb >> 9) & 1) << 5); R = (st >> 1) * 16 + swz / 64; C = (st & 1) * 32 + (swz % 64) / 2; }
__host__ __device__ __forceinline__ int perm32(int rho) { const int n = rho >> 4, i = rho & 15; return 8 * (i >> 2) + 4 * n + (i & 3); }

struct Unit { int pm, pn, e, r0; };

struct DenseSched {
    int nM, nN, nwg, G, c;
    const char* A; int lda; const char* Bt; int K;
    __device__ void init(int M, int N, int G_, int c_, const void* A_, int lda_, const void* Bt_, int K_) { nM = M / BM; nN = N / BM; nwg = nM * nN; G = G_; c = c_; A = (const char*)A_; lda = lda_; Bt = (const char*)Bt_; K = K_; }
    __device__ bool next(int i, Unit& u) const {
        const long L = (long)i * G + c; if (L >= nwg) return false;
        int wgid = (int)L; { const int q = nwg / NXCD, r = nwg % NXCD, xcd = wgid % NXCD, off = wgid / NXCD; wgid = (xcd < r ? xcd * (q + 1) : r * (q + 1) + (xcd - r) * q) + off; }
        const int nig = WGM * nN, gid = wgid / nig, fm = gid * WGM, gsz = (nM - fm) < WGM ? (nM - fm) : WGM;
        u.pm = fm + ((wgid % nig) % gsz); u.pn = (wgid % nig) / gsz; u.e = 0; u.r0 = u.pm; return true;
    }
    __device__ __forceinline__ const char* a_base() const { return A; }
    __device__ __forceinline__ unsigned a_off(const Unit& u, int r, int c_) const { return (unsigned)(((u.pm * BM + r) * lda + c_) * 2); }
    __device__ __forceinline__ const char* b_ptr(const Unit& u) const { return Bt + (size_t)u.pn * BM * K * 2; }
};

template <class Epi, class Sched>
__device__ __forceinline__ void gemm_phase(LAS unsigned char* lds, const int K, const Sched& S, const Epi& E) {
    const int tid = threadIdx.x, wid = __builtin_amdgcn_readfirstlane(tid >> 6), lane = tid & 63, wr = wid >> 2, wc = wid & 3, fr = lane & 15, fq = lane >> 4;
    const int nt = K / BK;
    int sR[2], sC[2]; unsigned voffB[2];
#pragma unroll
    for (int i = 0; i < 2; ++i) { int R, C; stage_rc(tid * 16 + i * 8192, R, C); sR[i] = R; sC[i] = C; const int Rb = Epi::PERM ? ((Epi::ADJ ? (R >> 5) * 64 : (R & ~31)) + perm32(R & 31)) : R; voffB[i] = (unsigned)(Rb * K + C) * 2u; }
    const size_t kstep = (size_t)(BK * 2);
    const size_t hstepB = (size_t)(Epi::ADJ ? 32 : HALF) * K * 2;
    const unsigned ldsw = (unsigned)wid * 1024u;
    const int aoff = lds_byte(wr * 64 + fr, fq * 8), boff = lds_byte(wc * 32 + fr, fq * 8);
#define PG8_SA(b, h) (((b) * 2 + (h)) * HTB)
#define PG8_SB(b, h) ((4 + (b) * 2 + (h)) * HTB)
#define PG8_STAGE(bufoff, gbase, voff) do { _Pragma("unroll") for (int _i = 0; _i < 2; ++_i) \
        __builtin_amdgcn_global_load_lds((const unsigned*)((const char*)(gbase) + (voff)[_i]), (LAS unsigned*)(lds + (bufoff) + ldsw + _i * 8192), 16, 0, 0); } while (0)
#define PG8_LDA(dst, b, h) do { _Pragma("unroll") for (int m = 0; m < 4; ++m) _Pragma("unroll") for (int k = 0; k < 2; ++k) dst[m][k] = *(const LAS bf16x8*)(lds + PG8_SA(b, h) + aoff + m * 2048 + k * 1024); } while (0)
#define PG8_LDB(dst, b, h) do { _Pragma("unroll") for (int n = 0; n < 2; ++n) _Pragma("unroll") for (int k = 0; k < 2; ++k) dst[n][k] = *(const LAS bf16x8*)(lds + PG8_SB(b, h) + boff + n * 2048 + k * 1024); } while (0)
#define PG8_MMA(ai, bj, At, Bt) do { __builtin_amdgcn_s_setprio(1); _Pragma("unroll") for (int m = 0; m < 4; ++m) _Pragma("unroll") for (int n = 0; n < 2; ++n) _Pragma("unroll") for (int k = 0; k < 2; ++k) \
        acc[ai][bj][m][n] = __builtin_amdgcn_mfma_f32_16x16x32_bf16(Bt[n][k], At[m][k], acc[ai][bj][m][n], 0, 0, 0); __builtin_amdgcn_s_setprio(0); } while (0)
#define PG8_WAIT_V(n) asm volatile("s_waitcnt vmcnt(" #n ")" ::: "memory")
#define PG8_WAIT_L(n) asm volatile("s_waitcnt lgkmcnt(" #n ")" ::: "memory")
#define PG8_BAR __builtin_amdgcn_s_barrier()
#define PG8_SCHED __builtin_amdgcn_sched_barrier(0)
    Unit cur, nxt; int ui = 0;
    if (!S.next(0, cur)) return;
    f32x4 acc[2][2][4][2];
#pragma unroll
    for (int a = 0; a < 2; ++a)
#pragma unroll
        for (int b = 0; b < 2; ++b)
#pragma unroll
            for (int m = 0; m < 4; ++m)
#pragma unroll
                for (int n = 0; n < 2; ++n) acc[a][b][m][n] = (f32x4){0.f, 0.f, 0.f, 0.f};
    bf16x8 At[4][2], B0[2][2], B1[2][2];
    const char* const Ab = S.a_base();
    unsigned vc0[2], vc1[2], vn0[2], vn1[2];
#pragma unroll
    for (int i = 0; i < 2; ++i) { vc0[i] = S.a_off(cur, sR[i], sC[i]); vc1[i] = S.a_off(cur, HALF + sR[i], sC[i]); }
    const char* cB = S.b_ptr(cur);
    PG8_STAGE(PG8_SB(0, 0), cB, voffB); PG8_STAGE(PG8_SB(0, 1), cB + hstepB, voffB); PG8_STAGE(PG8_SA(0, 0), Ab, vc0); PG8_STAGE(PG8_SA(0, 1), Ab, vc1);
    if (wr == 1) PG8_BAR;
    PG8_WAIT_V(2); PG8_BAR;
    PG8_STAGE(PG8_SB(1, 0), cB + kstep, voffB); PG8_STAGE(PG8_SA(1, 0), Ab + kstep, vc0); PG8_STAGE(PG8_SB(1, 1), cB + hstepB + kstep, voffB);
    PG8_WAIT_V(6); PG8_BAR;
    for (;;) {
        const bool has_next = S.next(ui + 1, nxt);
        const char* nB = has_next ? S.b_ptr(nxt) : cB;
#pragma unroll
        for (int i = 0; i < 2; ++i) { vn0[i] = has_next ? S.a_off(nxt, sR[i], sC[i]) : vc0[i]; vn1[i] = has_next ? S.a_off(nxt, HALF + sR[i], sC[i]) : vc1[i]; }
#pragma unroll 1
        for (int t = 0; t < nt; t += 2) {
            const bool last = (t == nt - 2);
            const char* a1 = Ab + (size_t)(t + 1) * kstep;
            const char* a2 = last ? Ab : Ab + (size_t)(t + 2) * kstep; const char* b2 = last ? nB : cB + (size_t)(t + 2) * kstep;
            const char* a3 = a2 + kstep; const char* b3 = b2 + kstep;
            unsigned v20[2], v21[2];
#pragma unroll
            for (int i = 0; i < 2; ++i) { v20[i] = last ? vn0[i] : vc0[i]; v21[i] = last ? vn1[i] : vc1[i]; }
            PG8_LDB(B0, 0, 0); PG8_LDB(B1, 0, 1); PG8_SCHED; PG8_LDA(At, 0, 0); PG8_STAGE(PG8_SA(1, 1), a1, vc1);
            PG8_WAIT_V(8); PG8_WAIT_L(0); PG8_BAR; PG8_MMA(0, 0, At, B0); PG8_MMA(0, 1, At, B1); PG8_BAR; PG8_SCHED;
            PG8_LDA(At, 0, 1); PG8_STAGE(PG8_SB(0, 0), b2, voffB); PG8_STAGE(PG8_SB(0, 1), b2 + hstepB, voffB); PG8_STAGE(PG8_SA(0, 0), a2, v20);
            PG8_WAIT_V(8); PG8_WAIT_L(0); PG8_BAR; PG8_MMA(1, 0, At, B0); PG8_MMA(1, 1, At, B1); PG8_BAR; PG8_SCHED;
            PG8_LDB(B0, 1, 0); PG8_LDB(B1, 1, 1); PG8_SCHED; PG8_LDA(At, 1, 0); PG8_STAGE(PG8_SA(0, 1), a2, v21);
            PG8_WAIT_V(8); PG8_WAIT_L(0); PG8_BAR; PG8_MMA(0, 0, At, B0); PG8_MMA(0, 1, At, B1); PG8_BAR; PG8_SCHED;
            PG8_LDA(At, 1, 1); PG8_STAGE(PG8_SB(1, 0), b3, voffB); PG8_STAGE(PG8_SB(1, 1), b3 + hstepB, voffB); PG8_STAGE(PG8_SA(1, 0), a3, v20);
            PG8_WAIT_V(8); PG8_WAIT_L(0); PG8_BAR; PG8_MMA(1, 0, At, B0); PG8_MMA(1, 1, At, B1); PG8_BAR; PG8_SCHED;
        }
        if (wr == 0) PG8_BAR;
        E(acc, cur, wr, wc, fr, fq);
        if (!has_next) break;
#pragma unroll
        for (int a = 0; a < 2; ++a)
#pragma unroll
            for (int b = 0; b < 2; ++b)
#pragma unroll
                for (int m = 0; m < 4; ++m)
#pragma unroll
                    for (int n = 0; n < 2; ++n) acc[a][b][m][n] = (f32x4){0.f, 0.f, 0.f, 0.f};
        cur = nxt; cB = nB; ++ui;
#pragma unroll
        for (int i = 0; i < 2; ++i) { vc0[i] = vn0[i]; vc1[i] = vn1[i]; }
        if (wr == 1) PG8_BAR;
    }
    PG8_WAIT_V(0);
    PG8_BAR;
#undef PG8_SA
#undef PG8_SB
#undef PG8_STAGE
#undef PG8_LDA
#undef PG8_LDB
#undef PG8_MMA
#undef PG8_WAIT_V
#undef PG8_WAIT_L
#undef PG8_BAR
#undef PG8_SCHED
}
}

#define XB_TMO      128
#define XB_XCNT(j)  (256  + 64 * (j))
#define XB_XSUB(j)  (1280 + 64 * (j))
#define XB_XGEN(j)  (2304 + 64 * (j))
#define XB_TOP      3328
#define XB_TOPGEN   3392
#define XCD_BAR_WORDS 3456
#define XB_SPIN_CAP (1u << 21)
__device__ __forceinline__ unsigned xb_ld(unsigned* p)              { return __hip_atomic_load(p, __ATOMIC_RELAXED, __HIP_MEMORY_SCOPE_AGENT); }
__device__ __forceinline__ unsigned xb_add(unsigned* p, unsigned v) { return __hip_atomic_fetch_add(p, v, __ATOMIC_RELAXED, __HIP_MEMORY_SCOPE_AGENT); }
__device__ __forceinline__ unsigned xb_xcc_id() { return (unsigned)__builtin_amdgcn_s_getreg((3 << 11) | 20) & 0xFu; }
#define XB_SPIN(cond, bar) do { unsigned _sp = 0; while (cond) { __builtin_amdgcn_s_sleep(1); \
    if ((++_sp & 255u) == 0u) { if (xb_ld(&(bar)[XB_TMO])) break; if (_sp > XB_SPIN_CAP) { atomicAdd(&(bar)[XB_TMO], 1u); break; } } } } while (0)
struct XcdBarrier { unsigned* bar; unsigned x; volatile LAS unsigned* st; };
__device__ __forceinline__ XcdBarrier xcd_barrier_post(unsigned* bar, volatile LAS unsigned* st) {
    XcdBarrier b; b.bar = bar; b.x = xb_xcc_id(); b.st = st;
    if (threadIdx.x == 0) (void)xb_add(&bar[XB_XCNT(b.x)], 1u);
    return b;
}
__device__ __forceinline__ void xcd_barrier_complete(unsigned* bar, unsigned x, unsigned& nloc, unsigned& nx) {
    const unsigned G = gridDim.x * gridDim.y * gridDim.z;
    unsigned sum, cnt, mine, sp = 0u;
    for (;;) {
        sum = 0u; cnt = 0u; mine = 0u;
#pragma unroll
        for (unsigned j = 0; j < 16; ++j) { const unsigned c = xb_ld(&bar[XB_XCNT(j)]); sum += c; cnt += (c > 0u) ? 1u : 0u; mine = (j == x) ? c : mine; }
        if (sum == G) break;
        __builtin_amdgcn_s_sleep(1);
        if ((++sp & 255u) == 0u) { if (xb_ld(&bar[XB_TMO])) break; if (sp > XB_SPIN_CAP) { atomicAdd(&bar[XB_TMO], 1u); break; } }
    }
    nloc = mine > 0u ? mine : 1u; nx = cnt > 0u ? cnt : 1u;
}
__device__ __forceinline__ void xcd_barrier(const XcdBarrier& b) {
    asm volatile("s_waitcnt vmcnt(0)" ::: "memory");
    __syncthreads();
    if (threadIdx.x == 0) {
        unsigned* bar = b.bar;
        __builtin_amdgcn_s_waitcnt(0);
        unsigned nloc = b.st[0], nx = b.st[1];
        if (nloc == 0u) { xcd_barrier_complete(bar, b.x, nloc, nx); b.st[0] = nloc; b.st[1] = nx; }
        const unsigned old = xb_add(&bar[XB_XSUB(b.x)], 1u);
        const unsigned gen = old / nloc;
        if (old + 1u == (gen + 1u) * nloc) {
            __builtin_amdgcn_fence(__ATOMIC_RELEASE, "agent");
            asm volatile("s_waitcnt vmcnt(0)" ::: "memory");
            const unsigned og = xb_add(&bar[XB_TOP], 1u);
            const unsigned tg = og / nx;
            if (og + 1u == (tg + 1u) * nx) xb_add(&bar[XB_TOPGEN], 1u);
            else XB_SPIN(xb_ld(&bar[XB_TOPGEN]) == tg, bar);
            __builtin_amdgcn_fence(__ATOMIC_ACQUIRE, "agent");
            xb_add(&bar[XB_XGEN(b.x)], 1u);
            asm volatile("s_waitcnt vmcnt(0)" ::: "memory");
        } else {
            XB_SPIN(xb_ld(&bar[XB_XGEN(b.x)]) == gen, bar);
            __builtin_amdgcn_fence(__ATOMIC_ACQUIRE, "agent");
            asm volatile("s_waitcnt vmcnt(0)" ::: "memory");
        }
    }
    __syncthreads();
}

constexpr size_t MiB = 1u << 20;
constexpr size_t UNIT_B = (size_t)MROWS * 1024 * 2;
constexpr size_t WS_CTL = 0, CTL_ZERO_BYTES = 64 * 1024;
constexpr int CW_TMO = 0, CW_BAR = 4096, CW_CNT = 8192;
constexpr size_t W_MI = 1 * MiB;
constexpr size_t W_UQ = W_MI + (size_t)MLA_INP * 1024 * 2;
constexpr size_t W_UKV = W_UQ + (size_t)1536 * 384 * 2;
constexpr size_t W_OM = W_UKV + (size_t)2048 * 256 * 2;
constexpr size_t W_GI = W_OM + (size_t)1024 * 1024 * 2;
constexpr size_t W_OG = W_GI + (size_t)GLA_INP * 1024 * 2;
constexpr size_t W_GU = W_OG + (size_t)1024 * 1024 * 2;
constexpr size_t W_D = W_GU + (size_t)2 * 32 * 512 * 1024 * 2;
constexpr size_t W_END = W_D + (size_t)2 * 32 * 1024 * 256 * 2;
static_assert(W_END <= 112 * MiB, "weights");
constexpr size_t S_SSQ_Q = 112 * MiB;
constexpr size_t S_SSQ_KV = S_SSQ_Q + (size_t)MROWS * 4;
constexpr size_t S_HMETA = S_SSQ_KV + (size_t)MROWS * 4;
constexpr size_t S_GLR = S_HMETA + (size_t)256 * 1024 * 4;
constexpr size_t S_GAM = S_GLR + (size_t)MROWS * 16 * 4;
constexpr size_t S_LIST = S_GAM + (size_t)NB * GH * NTILE * 128 * 4;
constexpr size_t S_WTS = S_LIST + (size_t)NEXP * MROWS * 4;
constexpr size_t S_PART = S_WTS + (size_t)2 * MROWS * 4;
constexpr size_t S_EPOS = S_PART + (size_t)MROWS * 24 * 4;
constexpr size_t S_END = S_EPOS + (size_t)2 * MROWS * 4;
static_assert(S_END <= 124 * MiB, "small buffers");
constexpr size_t ACT0 = 124 * MiB;
constexpr size_t A_HN = ACT0;
constexpr size_t A_K = ACT0;
constexpr size_t V8_OFF = (size_t)NB * NHEAD * NTILE * 8192;
constexpr size_t A_BST = ACT0 + 4 * UNIT_B;
constexpr size_t A_K0 = ACT0 + UNIT_B;
constexpr size_t A_ZMLA = ACT0 + UNIT_B * 3 / 2;
constexpr size_t A_QRAW = ACT0 + UNIT_B * 9 / 4;
constexpr size_t A_KNRAW = ACT0 + UNIT_B * 15 / 4;
constexpr size_t A_O = A_KNRAW;
constexpr size_t A_RSL = ACT0;
constexpr size_t A_HID = ACT0 + UNIT_B;
constexpr size_t A_Y = ACT0 + 2 * UNIT_B;
constexpr size_t A_HN2 = ACT0 + 4 * UNIT_B;
constexpr size_t A_HB = ACT0 + 5 * UNIT_B;
constexpr size_t A_ZQK = ACT0;
constexpr size_t A_ZV = ACT0 + UNIT_B;
constexpr size_t A_ZR = ACT0 + 2 * UNIT_B;
constexpr size_t A_QT = ACT0 + 3 * UNIT_B;
constexpr size_t A_ATT = ACT0 + UNIT_B * 7 / 2;
constexpr size_t A_OG = ACT0;
constexpr size_t WS_END = ACT0 + 6 * UNIT_B;
static_assert(WS_END <= 512 * MiB, "workspace map");
static_assert(A_ATT + (size_t)NB * GH * NTILE * 4096 * 2 <= A_HN2, "att");
static_assert(A_HID + (size_t)74240 * 256 * 2 <= A_Y, "hid");
constexpr int HID_TILES_MAX = 290;

constexpr int RING_OFF = 0;
constexpr int LDSCTL_OFF = 139264, MISC_OFF = LDSCTL_OFF;
constexpr int LDS_BYTES = 147456;

struct Args {
    const float* in[24]; float* out; unsigned char* ws; int ph_lo, ph_hi;
};
struct Frame {
    unsigned char* lds; volatile LAS unsigned* MISC; unsigned* ctl; unsigned char* ws;
    int tid, lane, wave, vcu, G;
    float* out;
};
#define FIN(i) (args.in[i])
enum { I_X = 0, I_META, I_NMIX, I_NFFN, I_MWIN, I_MGQ, I_MWUQ, I_MGKV, I_MWUKV, I_MGQN, I_MGKN, I_MWO, I_GWIN, I_GWGU, I_GBG, I_GGOUT, I_GWO, I_RWG, I_RBG, I_RWE, I_RBE, I_EWG, I_EWU, I_EWD };

struct TrItem { const float* src; int ok; int ldw; const float* gk; int k0; bf16* dst; int Kdst; };
__device__ __forceinline__ TrItem tr_make(const float* W0, int c0, int n0v, const float* W1, int c1, int n1v, int ldw, const float* gk, int k0, bf16* dst, int Kdst, int lane) {
    const int r = lane >> 3, c4 = lane & 7; TrItem t;
    t.src = (c4 < 4 ? W0 + c0 + 4 * c4 : W1 + c1 + 4 * (c4 - 4)) + (size_t)(k0 + r) * ldw; t.ok = c4 < 4 ? (n0v > 0) : (n1v > 0); t.ldw = ldw; t.gk = gk; t.k0 = k0; t.dst = dst; t.Kdst = Kdst; return t;
}
__device__ __forceinline__ TrItem tr_make_plain(const float* W, int K, int N, const float* gk, bf16* dst, int item, int lane) {
    const int kb = item % (K / 64), nb = item / (K / 64); const int c0 = 32 * nb, c1 = c0 + 16;
    int n0v = N - c0; n0v = n0v < 0 ? 0 : (n0v > 16 ? 16 : n0v); int n1v = N - c1; n1v = n1v < 0 ? 0 : (n1v > 16 ? 16 : n1v);
    return tr_make(W, c0, n0v, W, c1, n1v, N, gk, 64 * kb, dst + (size_t)32 * nb * K, K, lane);
}
__device__ __forceinline__ void tr_load(const TrItem& t, f32x4 (&v)[8]) {
#pragma unroll
    for (int i = 0; i < 8; ++i) v[i] = t.ok ? *(const f32x4*)(t.src + (size_t)(8 * i) * t.ldw) : (f32x4){0.f, 0.f, 0.f, 0.f};
}
__device__ __forceinline__ void tr_finish(const TrItem& t, const f32x4 (&v)[8], float* scr, int lane) {
    const int r = lane >> 3, c4 = lane & 7;
#pragma unroll
    for (int i = 0; i < 8; ++i) { const int kk = 8 * i + r; f32x4 w = v[i]; if (t.gk) w = w * t.gk[t.k0 + kk];
        float* d = scr + kk * 33 + 4 * c4; d[0] = w.x; d[1] = w.y; d[2] = w.z; d[3] = w.w; }
    LDS_WAIT(); asm volatile("" ::: "memory");
    int c = lane & 7; asm volatile("" : "+v"(c));
#pragma unroll
    for (int j4 = 0; j4 < 4; ++j4) { const int n = (lane >> 3) + 8 * j4; const float* sp = scr + (8 * c) * 33 + n;
        u32x4 o; o.x = pk2(sp[0 * 33], sp[1 * 33]); o.y = pk2(sp[2 * 33], sp[3 * 33]); o.z = pk2(sp[4 * 33], sp[5 * 33]); o.w = pk2(sp[6 * 33], sp[7 * 33]);
        *(u32x4*)(t.dst + (size_t)n * t.Kdst + t.k0 + 8 * c) = o; }
    LDS_WAIT(); asm volatile("" ::: "memory");
}

template <bool FIRST, bool COMBINE, bool WRITE_HN>
__device__ __forceinline__ void norm_rows(const Args& args, Frame& F, const float* gain, bf16* hn, const bf16* y, bf16* hb) {
    const int gw = F.vcu * NWAVES + F.wave, NGW = F.G * NWAVES, lane = F.lane;
    f32x4 g4[4];
    if (WRITE_HN) {
#pragma unroll
        for (int j = 0; j < 4; ++j) g4[j] = *(const f32x4*)(gain + 4 * lane + 256 * j);
    }
    f32x4 va[4], vb[4]; u32x2 ha[4], hbq[4], ya0[4], ya1[4], yb0[4], yb1[4];
#define NR_LOAD(r_, v_, h_, y0_, y1_) do { if (!row_is_dummy(r_)) { \
            if (FIRST) { const float* src_ = (r_) < NREAL ? FIN(I_X) + (size_t)(r_) * 1024 : FIN(I_META) + (size_t)((((r_) - NREAL) & 63) - 48) * 1024; \
                _Pragma("unroll") for (int j = 0; j < 4; ++j) v_[j] = *(const f32x4*)(src_ + 4 * lane + 256 * j); } \
            else { _Pragma("unroll") for (int j = 0; j < 4; ++j) h_[j] = *(const u32x2*)(hb + (size_t)(r_) * 1024 + 4 * lane + 256 * j); } \
            if (COMBINE) { _Pragma("unroll") for (int j = 0; j < 4; ++j) { y0_[j] = *(const u32x2*)(y + (size_t)(2 * (r_)) * 1024 + 4 * lane + 256 * j); y1_[j] = *(const u32x2*)(y + (size_t)(2 * (r_) + 1) * 1024 + 4 * lane + 256 * j); } } } } while (0)
    if (gw < MROWS) NR_LOAD(gw, va, ha, ya0, ya1);
    for (int r = gw; r < MROWS; r += NGW) {
        const int rn = r + NGW;
        if (rn < MROWS) NR_LOAD(rn, vb, hbq, yb0, yb1);
        if (row_is_dummy(r)) {
            if (WRITE_HN) {
#pragma unroll
                for (int j = 0; j < 4; ++j) *(u32x2*)(hn + (size_t)r * 1024 + 4 * lane + 256 * j) = (u32x2){0u, 0u};
            }
        } else {
            f32x4 v[4];
#pragma unroll
            for (int j = 0; j < 4; ++j) { if (FIRST) v[j] = va[j]; else { const u32x2 q = ha[j]; v[j] = (f32x4){bf2f(q.x & 0xffff), bf2f(q.x >> 16), bf2f(q.y & 0xffff), bf2f(q.y >> 16)}; } }
            if (COMBINE) {
#pragma unroll
                for (int j = 0; j < 4; ++j) { const u32x2 a = ya0[j], b = ya1[j];
                    v[j].x += bf2f(a.x & 0xffff) + bf2f(b.x & 0xffff); v[j].y += bf2f(a.x >> 16) + bf2f(b.x >> 16);
                    v[j].z += bf2f(a.y & 0xffff) + bf2f(b.y & 0xffff); v[j].w += bf2f(a.y >> 16) + bf2f(b.y >> 16); }
#pragma unroll
                for (int j = 0; j < 4; ++j) { u32x2 o; o.x = pk2(v[j].x, v[j].y); o.y = pk2(v[j].z, v[j].w); *(u32x2*)(hb + (size_t)r * 1024 + 4 * lane + 256 * j) = o;
                    v[j] = (f32x4){bf2f(o.x & 0xffff), bf2f(o.x >> 16), bf2f(o.y & 0xffff), bf2f(o.y >> 16)}; }
            }
            if (WRITE_HN) {
                float s = 0.f;
#pragma unroll
                for (int j = 0; j < 4; ++j) s += (v[j].x * v[j].x + v[j].y * v[j].y) + (v[j].z * v[j].z + v[j].w * v[j].w);
                const float rstd = rsqrtf(wave_sum(s) * (1.f / 1024.f) + EPS);
#pragma unroll
                for (int j = 0; j < 4; ++j) { u32x2 o; o.x = pk2(v[j].x * rstd * g4[j].x, v[j].y * rstd * g4[j].y); o.y = pk2(v[j].z * rstd * g4[j].z, v[j].w * rstd * g4[j].w);
                    *(u32x2*)(hn + (size_t)r * 1024 + 4 * lane + 256 * j) = o; }
            }
        }
#pragma unroll
        for (int j = 0; j < 4; ++j) { va[j] = vb[j]; ha[j] = hbq[j]; ya0[j] = yb0[j]; ya1[j] = yb1[j]; }
    }
#undef NR_LOAD
}

constexpr int GU_ITEMS = 32 * 256, WD_ITEMS = 32 * 128, WGI_ITEMS = 16 * 104;
__device__ __forceinline__ TrItem gu_item(const Args& args, unsigned char* ws, int layer, int it, int lane) {
    const int le = layer * 32 + (it >> 8), q = it & 255, kb = q % 16, nb = q / 16; const int pn = nb >> 3, bj = (nb >> 2) & 1, wc = nb & 3, hc0 = 128 * pn + 64 * bj + 16 * wc;
    return tr_make(FIN(I_EWG) + (size_t)le * 1024 * 256, hc0, 16, FIN(I_EWU) + (size_t)le * 1024 * 256, hc0, 16, 256, FIN(I_NFFN) + layer * 1024, 64 * kb, (bf16*)(ws + W_GU) + ((size_t)le * 512 + 32 * nb) * 1024, 1024, lane);
}
__device__ __forceinline__ TrItem wd_item(const Args& args, unsigned char* ws, int layer, int it, int lane) {
    const int le = layer * 32 + it / 128, q = it % 128;
    return tr_make_plain(FIN(I_EWD) + (size_t)le * 256 * 1024, 256, 1024, nullptr, (bf16*)(ws + W_D) + (size_t)le * 1024 * 256, q, lane);
}
__device__ __forceinline__ TrItem wgi_item(const Args& args, unsigned char* ws, int r, int lane) {
    const int kb = r % 16, nb = r / 16; const float* W = FIN(I_GWIN); int c0, n0v, c1, n1v;
    if (nb < 64) { c0 = 32 * nb; n0v = 16; c1 = c0 + 16; n1v = 16; }
    else if (nb < 96) { c0 = 2064 + 32 * (nb - 64); n0v = 16; c1 = c0 + 16; n1v = 16; }
    else if (nb == 96) { c0 = 2048; n0v = 16; c1 = 0; n1v = 0; }
    else { c0 = 0; n0v = 0; c1 = 0; n1v = 0; }
    return tr_make(W, c0, n0v, W, c1, n1v, GLA_IN, FIN(I_NMIX) + 1024, 64 * kb, (bf16*)(ws + W_GI) + (size_t)32 * nb * 1024, 1024, lane);
}
constexpr int D1_ITEMS = GU_ITEMS + WGI_ITEMS, D7_ITEMS = WD_ITEMS + GU_ITEMS, D16_ITEMS = WD_ITEMS;
template <int SET> __device__ __forceinline__ TrItem def_item(const Args& args, unsigned char* ws, int it, int lane) {
    if (SET == 1) return it < GU_ITEMS ? gu_item(args, ws, 0, it, lane) : wgi_item(args, ws, it - GU_ITEMS, lane);
    if (SET == 7) return it < WD_ITEMS ? wd_item(args, ws, 0, it, lane) : gu_item(args, ws, 1, it - WD_ITEMS, lane);
    return wd_item(args, ws, 1, it, lane);
}
template <int SET> __device__ __forceinline__ void def_convert(const Args& args, Frame& F, int first, int stride, int limit, int maxn) {
    float* scr = (float*)(F.lds + RING_OFF + F.wave * 16384); const int lane = F.lane;
    if (first >= limit || maxn <= 0) return;
    TrItem cur = def_item<SET>(args, F.ws, first, lane); f32x4 va[8]; tr_load(cur, va);
    int n = 1;
    for (int it = first; ; ) {
        const int nx = it + stride; const bool more = nx < limit && n < maxn; TrItem nxt = cur; f32x4 vb[8];
        if (more) { nxt = def_item<SET>(args, F.ws, nx, lane); tr_load(nxt, vb); }
        tr_finish(cur, va, scr, lane);
        if (!more) break;
#pragma unroll
        for (int i = 0; i < 8; ++i) va[i] = vb[i];
        cur = nxt; it = nx; ++n;
    }
}
template <int SET> __device__ __forceinline__ void def_fill_idle(const Args& args, Frame& F, int tot, int nitems, int per_wave, bool rest) {
    const int maxu = (tot + F.G - 1) / F.G, thr = tot - (maxu - 1) * F.G, nfill = F.G - thr;
    int cov = nfill > 0 ? nfill * NWAVES * per_wave : 0; cov = cov < nitems ? cov : nitems;
    if (F.vcu >= thr && nfill > 0) def_convert<SET>(args, F, (F.vcu - thr) * NWAVES + F.wave, nfill * NWAVES, cov, per_wave);
    if (rest) def_convert<SET>(args, F, cov + F.vcu * NWAVES + F.wave, F.G * NWAVES, nitems, 1 << 30);
}
constexpr int P1_FILL_PER_WAVE = 10;
constexpr int P7_FILL_PER_WAVE = 4;
constexpr int P7_FILL2_PER_WAVE = 6;

__device__ __forceinline__ void p0_prologue(const Args& args, Frame& F) {
    float* scr = (float*)(F.lds + RING_OFF + F.wave * 16384);
    const int gw = F.vcu * NWAVES + F.wave, NGW = F.G * NWAVES, lane = F.lane;
    unsigned char* ws = F.ws;
    constexpr int I0 = 16 * 24, I1 = 6 * 48, I2 = 4 * 64, I3 = 16 * 32, I5 = 16 * 32;
    const int nfill1 = (F.G == 256) ? (2 * 256 - 387) * NWAVES * P1_FILL_PER_WAVE : 0;
    const int D1_COV = nfill1 < D1_ITEMS ? nfill1 : D1_ITEMS;
    const int NITEMS = I0 + I1 + I2 + I3 + I5 + (D1_ITEMS - D1_COV);
    auto make = [&](int it) -> TrItem {
        int r = it;
        if (r < I0) return tr_make_plain(FIN(I_MWIN), 1024, MLA_IN, nullptr, (bf16*)(ws + W_MI), r, lane); r -= I0;
        if (r < I1) return tr_make_plain(FIN(I_MWUQ), MLA_Q, 1536, FIN(I_MGQ), (bf16*)(ws + W_UQ), r, lane); r -= I1;
        if (r < I2) {
            const int kb = r % 4, nb = r / 4; int c0;
            if (nb < 32) { const int pn = nb >> 3, bj = (nb >> 2) & 1, wc = nb & 3; c0 = (4 * pn + wc) * 128 + 32 * bj; } else { const int j = nb - 32; c0 = (j >> 1) * 128 + 64 + 32 * (j & 1); }
            return tr_make(FIN(I_MWUKV), c0, 16, FIN(I_MWUKV), c0 + 16, 16, 2048, FIN(I_MGKV), 64 * kb, (bf16*)(ws + W_UKV) + (size_t)32 * nb * MLA_KV, MLA_KV, lane); } r -= I2;
        if (r < I3) return tr_make_plain(FIN(I_MWO), 1024, 1024, nullptr, (bf16*)(ws + W_OM), r, lane); r -= I3;
        if (r < I5) return tr_make_plain(FIN(I_GWO), 1024, 1024, nullptr, (bf16*)(ws + W_OG), r, lane); r -= I5;
        return def_item<1>(args, ws, D1_COV + r, lane);
    };
    if (gw < NITEMS) {
        TrItem cur = make(gw); f32x4 va[8]; tr_load(cur, va);
        for (int it = gw; it < NITEMS; it += NGW) {
            const int nx = it + NGW; TrItem nxt = cur; f32x4 vb[8];
            if (nx < NITEMS) { nxt = make(nx); tr_load(nxt, vb); }
            tr_finish(cur, va, scr, lane);
            if (nx < NITEMS) {
#pragma unroll
                for (int i = 0; i < 8; ++i) va[i] = vb[i];
                cur = nxt; }
        }
    }
    { unsigned* vz = (unsigned*)F.out; for (int i = blockIdx.x * NTHREADS + F.tid; i < 64 * 2 * 48 * 16; i += F.G * NTHREADS) { const int w16 = i & 15, r = (i >> 4) % 48, dh = ((i >> 4) / 48) & 1, bh = (i >> 4) / 96;
        vz[((((size_t)bh * NTILE + 0) * 2 + dh) * 64 + r) * 16 + w16] = 0u; } }
    { unsigned* hz = (unsigned*)(ws + A_HB + (size_t)NREAL * 1024 * 2); for (int i = blockIdx.x * NTHREADS + F.tid; i < 256 * 512; i += F.G * NTHREADS) { if (((i >> 9) & 63) < 48) hz[i] = 0u; } }
    norm_rows<true, false, true>(args, F, FIN(I_NMIX), (bf16*)(ws + A_HN), nullptr, (bf16*)(ws + A_HB));
}

struct EpiZmla {
    static constexpr bool PERM = true; static constexpr bool ADJ = false;
    bf16* Z; float* part;
    __device__ __forceinline__ void operator()(const f32x4 (&acc)[2][2][4][2], const pg8::Unit& u, int wr, int wc, int fr, int fq) const {
#pragma unroll
        for (int ai = 0; ai < 2; ++ai)
#pragma unroll
            for (int m = 0; m < 4; ++m) { __builtin_amdgcn_sched_barrier(0);
                const int row = u.pm * 256 + ai * 128 + wr * 64 + m * 16 + fr;
#pragma unroll
                for (int bj = 0; bj < 2; ++bj) {
                    const f32x4 v0 = acc[ai][bj][m][0], v1 = acc[ai][bj][m][1];
                    const int col = u.pn * 256 + bj * 128 + wc * 32 + 8 * fq;
                    u32x4 w; w.x = pk2(v0[0], v0[1]); w.y = pk2(v0[2], v0[3]); w.z = pk2(v1[0], v1[1]); w.w = pk2(v1[2], v1[3]);
                    *(u32x4*)(Z + (size_t)row * MLA_INP + col) = w;
                    const int cb = u.pn * 256 + bj * 128;
                    if (cb < 768) {
                        float s = (v0[0] * v0[0] + v0[1] * v0[1]) + (v0[2] * v0[2] + v0[3] * v0[3]) + (v1[0] * v1[0] + v1[1] * v1[1]) + (v1[2] * v1[2] + v1[3] * v1[3]);
                        s += __shfl_xor(s, 16); s += __shfl_xor(s, 32);
                        if (fq == 0) part[(size_t)row * 24 + (cb >> 7) * 4 + wc] = s;
                    }
                }
            }
    }
};
struct EpiQ {
    static constexpr bool PERM = true; static constexpr bool ADJ = false;
    bf16* Q; const float* ssq;
    __device__ __forceinline__ void operator()(const f32x4 (&acc)[2][2][4][2], const pg8::Unit& u, int wr, int wc, int fr, int fq) const {
        float rsv[8];
#pragma unroll
        for (int i = 0; i < 8; ++i) { const int row = u.pm * 256 + (i >> 2) * 128 + wr * 64 + (i & 3) * 16 + fr;
            const f32x4 pa = *(const f32x4*)(ssq + (size_t)row * 24), pb = *(const f32x4*)(ssq + (size_t)row * 24 + 4), pc = *(const f32x4*)(ssq + (size_t)row * 24 + 8);
            rsv[i] = rsqrtf((((pa[0] + pa[1]) + (pa[2] + pa[3])) + ((pb[0] + pb[1]) + (pb[2] + pb[3])) + ((pc[0] + pc[1]) + (pc[2] + pc[3]))) * (1.f / MLA_Q) + EPS); }
#pragma unroll
        for (int ai = 0; ai < 2; ++ai)
#pragma unroll
            for (int m = 0; m < 4; ++m) { __builtin_amdgcn_sched_barrier(0);
                const int row = u.pm * 256 + ai * 128 + wr * 64 + m * 16 + fr;
                const float rs = rsv[ai * 4 + m];
#pragma unroll
                for (int bj = 0; bj < 2; ++bj) {
                    const f32x4 v0 = acc[ai][bj][m][0] * rs, v1 = acc[ai][bj][m][1] * rs;
                    const int col = u.pn * 256 + bj * 128 + wc * 32 + 8 * fq;
                    u32x4 w; w.x = pk2(v0[0], v0[1]); w.y = pk2(v0[2], v0[3]); w.z = pk2(v1[0], v1[1]); w.w = pk2(v1[2], v1[3]);
                    *(u32x4*)(Q + (size_t)row * 1536 + col) = w;
                }
            }
    }
};
struct EpiKV {
    static constexpr bool PERM = true; static constexpr bool ADJ = false;
    bf16* KT; bf16* V; const float* ssq; float* RH; const float* gkn;
    __device__ __forceinline__ void operator()(const f32x4 (&acc)[2][2][4][2], const pg8::Unit& u, int wr, int wc, int fr, int fq) const {
        if (u.pn < 4) {
            const int head = 4 * u.pn + wc;
#pragma unroll
            for (int ai = 0; ai < 2; ++ai)
#pragma unroll
                for (int m = 0; m < 4; ++m) { __builtin_amdgcn_sched_barrier(0);
                    const int row = u.pm * 256 + ai * 128 + wr * 64 + m * 16 + fr;
                    const int b = row >> 13, sfr = row & (SEQ - 1), tile = 1 + (sfr >> 6), r64 = sfr & 63;
                    const f32x4 pa_ = *(const f32x4*)(ssq + (size_t)row * 24 + 12), pb_ = *(const f32x4*)(ssq + (size_t)row * 24 + 16); const float rs = rsqrtf((((pa_[0] + pa_[1]) + (pa_[2] + pa_[3])) + ((pb_[0] + pb_[1]) + (pb_[2] + pb_[3]))) * (1.f / MLA_KV) + EPS);
                    float sq = 0.f;
#pragma unroll
                    for (int bj = 0; bj < 2; ++bj)
#pragma unroll
                        for (int n = 0; n < 2; ++n) { const f32x4 a = acc[ai][bj][m][n]; sq += (a[0] * a[0] + a[1] * a[1]) + (a[2] * a[2] + a[3] * a[3]); }
                    sq += __shfl_xor(sq, 16); sq += __shfl_xor(sq, 32);
                    const float rh = rsqrtf((sq * rs * rs + ssq[(size_t)row * 24 + 20]) * (1.f / QK) + EPS), rr = rs * rh;
                    unsigned char* kt = (unsigned char*)KT + ((size_t)(b * NHEAD + head) * NTILE + tile) * 8192 + r64 * 16 + (fq & 1) * 8;
                    const float rk = rr * KQ_SC;
#pragma unroll
                    for (int bj = 0; bj < 2; ++bj) { const f32x4 g0 = *(const f32x4*)(gkn + 32 * bj + 8 * fq), g1 = *(const f32x4*)(gkn + 32 * bj + 8 * fq + 4);
                        const f32x4 x0 = acc[ai][bj][m][0] * g0 * rk, x1 = acc[ai][bj][m][1] * g1 * rk;
                        *(u32x2*)(kt + (2 * bj + (fq >> 1)) * 1024) = (u32x2){pk4_e4m3(x0[0], x0[1], x0[2], x0[3]), pk4_e4m3(x1[0], x1[1], x1[2], x1[3])}; }
                    if (fq == 0) RH[(size_t)row * NHEAD + head] = rh;
                }
        } else {
#pragma unroll
            for (int ai = 0; ai < 2; ++ai)
#pragma unroll
                for (int m = 0; m < 4; ++m) { __builtin_amdgcn_sched_barrier(0);
                    const int row = u.pm * 256 + ai * 128 + wr * 64 + m * 16 + fr;
                    const f32x4 pa_ = *(const f32x4*)(ssq + (size_t)row * 24 + 12), pb_ = *(const f32x4*)(ssq + (size_t)row * 24 + 16); const float rs = rsqrtf((((pa_[0] + pa_[1]) + (pa_[2] + pa_[3])) + ((pb_[0] + pb_[1]) + (pb_[2] + pb_[3]))) * (1.f / MLA_KV) + EPS);
                    const int b = row >> 13, sfr = row & (SEQ - 1), tile = 1 + (sfr >> 6), r64 = sfr & 63;
#pragma unroll
                    for (int bj = 0; bj < 2; ++bj) {
                        const f32x4 v0 = acc[ai][bj][m][0] * rs, v1 = acc[ai][bj][m][1] * rs;
                        const int colv = (u.pn - 4) * 256 + bj * 128 + wc * 32 + 8 * fq, hv = colv >> 6, d = colv & 63;
                        *(u32x2*)((unsigned char*)V + ((size_t)(b * NHEAD + hv) * NTILE + tile) * 8192 + r64 * 64 + d) = (u32x2){pk4_e4m3(v0[0], v0[1], v0[2], v0[3]), pk4_e4m3(v1[0], v1[1], v1[2], v1[3])};
                    }
                }
        }
    }
};
struct EpiRes {
    static constexpr bool PERM = true; static constexpr bool ADJ = false;
    const float* x; bf16* hb;
    __device__ __forceinline__ void operator()(const f32x4 (&acc)[2][2][4][2], const pg8::Unit& u, int wr, int wc, int fr, int fq) const {
#pragma unroll
        for (int ai = 0; ai < 2; ++ai)
#pragma unroll
            for (int m = 0; m < 4; ++m) {
                const int row = u.pm * 256 + ai * 128 + wr * 64 + m * 16 + fr;
#pragma unroll
                for (int bj = 0; bj < 2; ++bj) {
                    const int col = u.pn * 256 + bj * 128 + wc * 32 + 8 * fq;
                    f32x4 s0, s1;
                    if (x) { s0 = *(const f32x4*)(x + (size_t)row * 1024 + col); s1 = *(const f32x4*)(x + (size_t)row * 1024 + col + 4); }
                    else { const u32x4 q = *(const u32x4*)(hb + (size_t)row * 1024 + col);
                        s0 = (f32x4){bf2f(q.x & 0xffff), bf2f(q.x >> 16), bf2f(q.y & 0xffff), bf2f(q.y >> 16)}; s1 = (f32x4){bf2f(q.z & 0xffff), bf2f(q.z >> 16), bf2f(q.w & 0xffff), bf2f(q.w >> 16)}; }
                    const f32x4 v0 = s0 + acc[ai][bj][m][0], v1 = s1 + acc[ai][bj][m][1];
                    u32x4 w; w.x = pk2(v0[0], v0[1]); w.y = pk2(v0[2], v0[3]); w.z = pk2(v1[0], v1[1]); w.w = pk2(v1[2], v1[3]);
                    *(u32x4*)(hb + (size_t)row * 1024 + col) = w;
                }
            }
    }
};
struct EpiZgla {
    static constexpr bool PERM = true; static constexpr bool ADJ = false;
    bf16* ZQK; bf16* ZV; bf16* ZR; float* GLR; const float* RS2;
    __device__ __forceinline__ void operator()(const f32x4 (&acc)[2][2][4][2], const pg8::Unit& u, int wr, int wc, int fr, int fq) const {
        bf16* dst = (bf16*)((char*)ZQK + (size_t)(u.pn >> 2) * UNIT_B); const int cbase = (u.pn & 3) * 256;
        float rsv[8];
#pragma unroll
        for (int i = 0; i < 8; ++i) rsv[i] = RS2[u.pm * 256 + (i >> 2) * 128 + wr * 64 + (i & 3) * 16 + fr];
#pragma unroll
        for (int ai = 0; ai < 2; ++ai)
#pragma unroll
            for (int m = 0; m < 4; ++m) { __builtin_amdgcn_sched_barrier(0);
                const int row = u.pm * 256 + ai * 128 + wr * 64 + m * 16 + fr;
#pragma unroll
                for (int bj = 0; bj < 2; ++bj) {
                    const float rs = rsv[ai * 4 + m]; const f32x4 v0 = acc[ai][bj][m][0] * rs, v1 = acc[ai][bj][m][1] * rs;
                    const int c = bj * 128 + wc * 32 + 8 * fq;
                    if (u.pn < 12) { u32x4 w; w.x = pk2(v0[0], v0[1]); w.y = pk2(v0[2], v0[3]); w.z = pk2(v1[0], v1[1]); w.w = pk2(v1[2], v1[3]); *(u32x4*)(dst + (size_t)row * 1024 + cbase + c) = w; }
                    else if (c < 16) { *(f32x4*)(GLR + (size_t)row * 16 + c) = v0; *(f32x4*)(GLR + (size_t)row * 16 + c + 4) = v1; }
                }
            }
    }
};

struct MoeTables { volatile LAS unsigned* tpre; volatile LAS unsigned* cnt; volatile LAS unsigned* cpre; volatile LAS unsigned* t2e; };
__device__ __forceinline__ MoeTables moe_tables(Frame& F, const unsigned* gcnt) {
    MoeTables T; T.tpre = F.MISC + 16; T.cnt = F.MISC + 64; T.cpre = F.MISC + 112; T.t2e = F.MISC + 160;
    __syncthreads();
    if (F.wave == 0) {
        const int e = F.lane & 31;
        const unsigned cn = __hip_atomic_load(gcnt + e, __ATOMIC_RELAXED, __HIP_MEMORY_SCOPE_AGENT), tl = (cn + 255u) >> 8;
        unsigned st = tl, sc = cn;
#pragma unroll
        for (int dlt = 1; dlt < 32; dlt <<= 1) { const unsigned a = __shfl_up(st, dlt, 32), b = __shfl_up(sc, dlt, 32); if (e >= dlt) { st += a; sc += b; } }
        if (F.lane < 32) { T.cnt[e] = cn; T.tpre[e] = st - tl; T.cpre[e] = sc - cn; if (e == 31) { T.tpre[32] = st; T.cpre[32] = sc; }
            for (unsigned t = 0; t < tl; ++t) T.t2e[st - tl + t] = (unsigned)e | (t << 8); }
    }
    __syncthreads();
    return T;
}
struct MoeSched {
    MoeTables T; int nN, G, c; bool gather;
    const char* A; int lda; const char* Bt; int K; size_t bexp; const int* list;
    __device__ bool next(int i, pg8::Unit& u) const {
        const int total = (int)T.tpre[32] * nN; const int L = i * G + c; if (L >= total) return false;
        const int mt = L >> (nN == 4 ? 2 : 1); u.pn = L & (nN - 1); const unsigned v = T.t2e[mt];
        u.e = (int)(v & 255u); u.pm = (int)(v >> 8); u.r0 = mt; return true;
    }
    __device__ __forceinline__ const char* a_base() const { return A; }
    __device__ __forceinline__ unsigned a_off(const pg8::Unit& u, int r, int c_) const {
        if (gather) { const int pos = u.pm * 256 + r; int tok = NREAL; if (pos < (int)T.cnt[u.e]) tok = list[(size_t)u.e * MROWS + pos] >> 1; return (unsigned)((tok * lda + c_) * 2); }
        return (unsigned)(((u.r0 * 256 + r) * lda + c_) * 2);
    }
    __device__ __forceinline__ const char* b_ptr(const pg8::Unit& u) const { return Bt + (size_t)u.e * bexp + (size_t)u.pn * 256 * K * 2; }
};
struct EpiGU {
    static constexpr bool PERM = false; static constexpr bool ADJ = false;
    bf16* HID; const float* RSL; volatile LAS unsigned* cnt;
    __device__ __forceinline__ void operator()(const f32x4 (&acc)[2][2][4][2], const pg8::Unit& u, int wr, int wc, int fr, int fq) const {
        const int n_e = (int)cnt[u.e]; const float* rsp = RSL + (size_t)u.e * MROWS + u.pm * 256 + wr * 64 + fr; float rsv[8];
#pragma unroll
        for (int i = 0; i < 8; ++i) { const int off = (i >> 2) * 128 + (i & 3) * 16; rsv[i] = (u.pm * 256 + wr * 64 + fr + off < n_e) ? rsp[off] : 0.f; }
#pragma unroll
        for (int ai = 0; ai < 2; ++ai)
#pragma unroll
            for (int m = 0; m < 4; ++m) { __builtin_amdgcn_sched_barrier(0);
                const int rr = ai * 128 + wr * 64 + m * 16 + fr; const float rs = rsv[ai * 4 + m];
#pragma unroll
                for (int bj = 0; bj < 2; ++bj) {
                    const f32x4 g = acc[ai][bj][m][0] * rs, up = acc[ai][bj][m][1] * rs; float o[4];
#pragma unroll
                    for (int j = 0; j < 4; ++j) o[j] = g[j] * __builtin_amdgcn_rcpf(1.f + __expf(-g[j])) * up[j];
                    u32x2 w; w.x = pk2(o[0], o[1]); w.y = pk2(o[2], o[3]);
                    *(u32x2*)(HID + ((size_t)u.r0 * 256 + rr) * 256 + u.pn * 128 + bj * 64 + wc * 16 + 4 * fq) = w;
                }
            }
    }
};
constexpr float Y_SCALE = 32.f, Y_INV = 1.f / 32.f;
__device__ __forceinline__ unsigned pk4_fp8(const f32x4 v) {
    const float a = __builtin_amdgcn_fmed3f(v[0] * Y_SCALE, -448.f, 448.f), b = __builtin_amdgcn_fmed3f(v[1] * Y_SCALE, -448.f, 448.f), c = __builtin_amdgcn_fmed3f(v[2] * Y_SCALE, -448.f, 448.f), d = __builtin_amdgcn_fmed3f(v[3] * Y_SCALE, -448.f, 448.f);
    int w = 0; w = __builtin_amdgcn_cvt_pk_fp8_f32(a, b, w, false); w = __builtin_amdgcn_cvt_pk_fp8_f32(c, d, w, true); return (unsigned)w;
}
struct EpiDown {
    static constexpr bool PERM = true; static constexpr bool ADJ = true;
    unsigned char* Y; volatile LAS unsigned* cnt; volatile LAS unsigned* cpre;
    __device__ __forceinline__ void operator()(const f32x4 (&acc)[2][2][4][2], const pg8::Unit& u, int wr, int wc, int fr, int fq) const {
        const int n_e = (int)cnt[u.e]; const size_t base = (size_t)cpre[u.e];
        const bool lo8 = fr < 8;
        unsigned char* const yb = Y + base * 1024 + u.pn * 256 + wc * 64 + (fr >> 3) * 32 + 8 * fq;
#pragma unroll
        for (int ai = 0; ai < 2; ++ai)
#pragma unroll
            for (int m = 0; m < 4; ++m) { __builtin_amdgcn_sched_barrier(0);
                const int pos = u.pm * 256 + ai * 128 + wr * 64 + m * 16 + (fr & 7);
                u32x2 o0, o1, snd, rcv;
                o0.x = pk4_fp8(acc[ai][0][m][0]); o0.y = pk4_fp8(acc[ai][0][m][1]); o1.x = pk4_fp8(acc[ai][1][m][0]); o1.y = pk4_fp8(acc[ai][1][m][1]);
                snd = lo8 ? o1 : o0;
#pragma unroll
                for (int k = 0; k < 2; ++k) rcv[k] = (unsigned)__builtin_amdgcn_update_dpp(0, (int)snd[k], 0x128, 0xf, 0xf, false);
                const u32x2 sa = lo8 ? o0 : rcv, sb = lo8 ? rcv : o1;
                if (pos < n_e) __builtin_nontemporal_store(sa, (u32x2*)(yb + (size_t)pos * 1024));
                if (pos + 8 < n_e) __builtin_nontemporal_store(sb, (u32x2*)(yb + (size_t)(pos + 8) * 1024));
            }
    }
};

__device__ __forceinline__ void unpack8(const u32x4 w, float (&x)[8]) {
    x[0] = bf2f(w.x & 0xffff); x[1] = bf2f(w.x >> 16); x[2] = bf2f(w.y & 0xffff); x[3] = bf2f(w.y >> 16);
    x[4] = bf2f(w.z & 0xffff); x[5] = bf2f(w.z >> 16); x[6] = bf2f(w.w & 0xffff); x[7] = bf2f(w.w >> 16);
}
__device__ __forceinline__ u32x4 pack8(const float (&x)[8]) { u32x4 w; w.x = pk2(x[0], x[1]); w.y = pk2(x[2], x[3]); w.z = pk2(x[4], x[5]); w.w = pk2(x[6], x[7]); return w; }
__device__ __forceinline__ void kprep_phase(const Args& args, Frame& F) {
    const bf16* KN = (const bf16*)(F.ws + A_KNRAW); const bf16* Z = (const bf16*)(F.ws + A_ZMLA); unsigned char* Kt = (unsigned char*)(F.ws + A_K); bf16* K0 = (bf16*)(F.ws + A_K0);
    const float* RH = (const float*)(F.ws + A_KNRAW);
    const float* gkn = FIN(I_MGKN);
    const int gw = F.vcu * NWAVES + F.wave, NGW = F.G * NWAVES, lane = F.lane;
    const u32x4 zero4 = {0u, 0u, 0u, 0u};
    for (int task = gw; task < (NREAL / 64) * NHEAD; task += NGW) {
        const int rt = task / NHEAD, h = task % NHEAD; const int row = rt * 64 + lane;
        const int b = row >> 13, sfr = row & (SEQ - 1), tile = 1 + (sfr >> 6), r64 = sfr & 63;
        u32x4 raw[4];
#pragma unroll
        for (int c = 0; c < 4; ++c) raw[c] = *(const u32x4*)(Z + (size_t)row * MLA_INP + 640 + 8 * c);
        const float rh = RH[(size_t)row * NHEAD + h] * KQ_SC;
        unsigned char* dst = Kt + ((size_t)(b * NHEAD + h) * NTILE + tile) * 8192 + r64 * 16;
        const float pos = (float)(16 + sfr);
        u32x4 c4, c5;
#pragma unroll
        for (int c = 0; c < 2; ++c) {
            float x1[8], x2[8]; unpack8(raw[c], x1); unpack8(raw[2 + c], x2);
#pragma unroll
            for (int e = 0; e < 8; ++e) { const int i = 8 * c + e; float sn, cs; fast_sincos(pos * ROPE_INV[i], sn, cs);
                const float a = x1[e] * rh * gkn[64 + i], bq = x2[e] * rh * gkn[80 + i]; x1[e] = a * cs - bq * sn; x2[e] = bq * cs + a * sn; }
            c4[2 * c] = pk4_e4m3(x1[0], x1[1], x1[2], x1[3]); c4[2 * c + 1] = pk4_e4m3(x1[4], x1[5], x1[6], x1[7]);
            c5[2 * c] = pk4_e4m3(x2[0], x2[1], x2[2], x2[3]); c5[2 * c + 1] = pk4_e4m3(x2[4], x2[5], x2[6], x2[7]); }
        *(u32x4*)(dst + 4 * 1024) = c4; *(u32x4*)(dst + 5 * 1024) = c5; *(u32x4*)(dst + 6 * 1024) = zero4; *(u32x4*)(dst + 7 * 1024) = zero4;
    }
    const int NTASK = 4 * NHEAD;
    for (int task = gw; task < NTASK; task += NGW) {
        const int rt = NREAL / 64 + task / NHEAD, h = task % NHEAD; const int row = rt * 64 + lane;
        int b, tile, r64; row_btr(row, b, tile, r64);
        u32x4 raw[12];
#pragma unroll
        for (int c = 0; c < 8; ++c) raw[c] = *(const u32x4*)(KN + (size_t)row * 1024 + h * 64 + 8 * c);
#pragma unroll
        for (int c = 0; c < 4; ++c) raw[8 + c] = *(const u32x4*)(Z + (size_t)row * MLA_INP + 640 + 8 * c);
        float ss = 0.f;
#pragma unroll
        for (int c = 0; c < 12; ++c) { float x[8]; unpack8(raw[c], x);
#pragma unroll
            for (int e = 0; e < 8; ++e) ss += x[e] * x[e]; }
        const float rstd = rsqrtf(ss * (1.f / QK) + EPS);
        bf16* dst = K0 + (size_t)(b * NHEAD + h) * (12 * 64 * 8) + r64 * 8;
        unsigned char* dst8 = Kt + ((size_t)(b * NHEAD + h) * NTILE + tile) * 8192 + r64 * 16;
#pragma unroll
        for (int c = 0; c < 8; ++c) { float x[8]; unpack8(raw[c], x);
#pragma unroll
            for (int e = 0; e < 8; ++e) x[e] *= rstd * gkn[8 * c + e];
            *(u32x4*)(dst + c * 512) = pack8(x);
            *(u32x2*)(dst8 + (c >> 1) * 1024 + (c & 1) * 8) = (u32x2){pk4_e4m3(x[0] * KQ_SC, x[1] * KQ_SC, x[2] * KQ_SC, x[3] * KQ_SC), pk4_e4m3(x[4] * KQ_SC, x[5] * KQ_SC, x[6] * KQ_SC, x[7] * KQ_SC)}; }
        const float pos = (float)row_pos(row);
#pragma unroll
        for (int c = 0; c < 2; ++c) {
            float x1[8], x2[8]; unpack8(raw[8 + c], x1); unpack8(raw[10 + c], x2);
#pragma unroll
            for (int e = 0; e < 8; ++e) { const int i = 8 * c + e; float sn, cs; fast_sincos(pos * ROPE_INV[i], sn, cs);
                const float a = x1[e] * rstd * gkn[64 + i], bq = x2[e] * rstd * gkn[80 + i]; x1[e] = a * cs - bq * sn; x2[e] = bq * cs + a * sn; }
            *(u32x4*)(dst + (8 + c) * 512) = pack8(x1); *(u32x4*)(dst + (10 + c) * 512) = pack8(x2);
            *(u32x2*)(dst8 + 4 * 1024 + c * 8) = (u32x2){pk4_e4m3(x1[0] * KQ_SC, x1[1] * KQ_SC, x1[2] * KQ_SC, x1[3] * KQ_SC), pk4_e4m3(x1[4] * KQ_SC, x1[5] * KQ_SC, x1[6] * KQ_SC, x1[7] * KQ_SC)};
            *(u32x2*)(dst8 + 5 * 1024 + c * 8) = (u32x2){pk4_e4m3(x2[0] * KQ_SC, x2[1] * KQ_SC, x2[2] * KQ_SC, x2[3] * KQ_SC), pk4_e4m3(x2[4] * KQ_SC, x2[5] * KQ_SC, x2[6] * KQ_SC, x2[7] * KQ_SC)}; }
        *(u32x4*)(dst8 + 6 * 1024) = zero4; *(u32x4*)(dst8 + 7 * 1024) = zero4;
    }
    { const bf16* Vb = (const bf16*)F.out; unsigned char* V8 = (unsigned char*)F.out + V8_OFF;
      LAS unsigned* scr = (LAS unsigned*)((LAS unsigned char*)F.lds + RING_OFF + F.wave * 8192);
      const LAS unsigned char* scr8 = (const LAS unsigned char*)scr;
      const unsigned char* VR = (const unsigned char*)F.out;
      u32x4 raw[8];
#define KP_VLOAD(task_) do { if ((task_) % NTILE == 0) { const bf16* src_ = Vb + (size_t)(task_) * 4096 + lane * 32; \
              _Pragma("unroll") for (int q_ = 0; q_ < 8; ++q_) raw[q_] = *(const u32x4*)(src_ + (q_ >> 2) * 2048 + 8 * (q_ & 3)); } \
          else { const unsigned char* src_ = VR + (size_t)(task_) * 8192 + lane * 64; _Pragma("unroll") for (int q_ = 0; q_ < 4; ++q_) raw[q_] = *(const u32x4*)(src_ + 16 * q_); } } while (0)
      if (gw < NB * NHEAD * NTILE) KP_VLOAD(gw);
      for (int task = gw; task < NB * NHEAD * NTILE; task += NGW) {
          if (task % NTILE == 0) {
#pragma unroll
              for (int q_ = 0; q_ < 8; ++q_) { float x[8]; unpack8(raw[q_], x);
                  scr[lane * 17 + 2 * q_] = pk4_e4m3(x[0], x[1], x[2], x[3]); scr[lane * 17 + 2 * q_ + 1] = pk4_e4m3(x[4], x[5], x[6], x[7]); }
          } else {
#pragma unroll
              for (int q_ = 0; q_ < 4; ++q_) { scr[lane * 17 + 4 * q_] = raw[q_].x; scr[lane * 17 + 4 * q_ + 1] = raw[q_].y; scr[lane * 17 + 4 * q_ + 2] = raw[q_].z; scr[lane * 17 + 4 * q_ + 3] = raw[q_].w; }
          }
          if (task + NGW < NB * NHEAD * NTILE) KP_VLOAD(task + NGW);
          asm volatile("s_waitcnt lgkmcnt(0)" ::: "memory");
#pragma unroll
          for (int i = 0; i < 4; ++i) { const int cell = lane + 64 * i, dvf = 32 * (cell >> 7) + (cell & 31), hf = (cell >> 6) & 1, c = (cell >> 5) & 1;
              unsigned w[4];
#pragma unroll
              for (int j = 0; j < 4; ++j) { unsigned acc = 0u;
#pragma unroll
                  for (int e = 0; e < 4; ++e) { const int r = 4 * j + e; const int key = 32 * c + (r & 3) + 8 * (r >> 2) + 4 * hf; acc |= (unsigned)scr8[key * 68 + dvf] << (8 * e); }
                  w[j] = acc; }
              *(u32x4*)(V8 + (size_t)task * 4096 + cell * 16) = (u32x4){w[0], w[1], w[2], w[3]}; }
          asm volatile("s_waitcnt lgkmcnt(0)" ::: "memory");
      }
#undef KP_VLOAD
    }
}

__device__ __forceinline__ int crow(int r, int hi) { return (r & 3) + 8 * (r >> 2) + 4 * hi; }
__device__ __forceinline__ s16x4 vtr(const LAS char* p) { typedef short v4i16_t __attribute__((ext_vector_type(4))); return __builtin_bit_cast(s16x4, __builtin_amdgcn_ds_read_tr16_b64_v4i16((LAS v4i16_t*)p)); }
constexpr int ATT_STAGE = 20480;
__device__ __forceinline__ void glds16(const void* gsrc, unsigned lds_dst) { unsigned keep;
    asm volatile("s_mov_b32 %0, m0\n\ts_mov_b32 m0, %2\n\ts_nop 0\n\tglobal_load_lds_dwordx4 %1, off\n\ts_mov_b32 m0, %0" : "=&s"(keep) : "v"(gsrc), "s"(lds_dst) : "memory"); }

__device__ __forceinline__ void attn_unit(const Args& args, Frame& F, int bh, int qb) {
    const int lane = F.lane, r32 = lane & 31, hi = lane >> 5, wid = F.wave;
    const int b = bh >> 4, h = bh & 15;
    const bf16* QR = (const bf16*)(F.ws + A_QRAW); const bf16* Kt = (const bf16*)(F.ws + A_K0) + (size_t)bh * 6144; const bf16* Vt = (const bf16*)F.out + (size_t)bh * NTILE * 4096;
    bf16* O = (bf16*)(F.ws + A_O);
    unsigned char* shm = F.lds + RING_OFF;
    int NT, myT, qrow;
    if (qb >= 0) { NT = 4 * qb + 5; myT = 4 * qb + 1 + (wid >> 1); qrow = b * SEQ + 256 * qb + 32 * wid + r32; }
    else { NT = 1; myT = (wid == 0) ? 0 : -1; qrow = NREAL + b * 64 + 32 + r32; }
#define ATT_LOAD(t, buf) do { const bf16* ks_ = Kt + (size_t)(t) * 6144 + lane * 8; const bf16* vs_ = Vt + (size_t)(t) * 4096 + lane * 8; LAS unsigned char* d_ = (LAS unsigned char*)(shm + (buf) * ATT_STAGE); \
        __builtin_amdgcn_global_load_lds((const unsigned*)(ks_ + wid * 512), (LAS unsigned*)(d_ + wid * 1024), 16, 0, 0); \
        if (wid < 4) __builtin_amdgcn_global_load_lds((const unsigned*)(ks_ + (wid + 8) * 512), (LAS unsigned*)(d_ + (wid + 8) * 1024), 16, 0, 0); \
        __builtin_amdgcn_global_load_lds((const unsigned*)(vs_ + wid * 512), (LAS unsigned*)(d_ + 12288 + wid * 1024), 16, 0, 0); } while (0)
    ATT_LOAD(0, 0);
    bf16x8 qr[6];
    if (myT >= 0) {
        float qf[6][8];
#pragma unroll
        for (int d0 = 0; d0 < 6; ++d0) { const u32x4 w = *(const u32x4*)(QR + (size_t)qrow * 1536 + h * QK + 16 * d0 + 8 * hi);
            qf[d0][0] = bf2f(w.x & 0xffff); qf[d0][1] = bf2f(w.x >> 16); qf[d0][2] = bf2f(w.y & 0xffff); qf[d0][3] = bf2f(w.y >> 16);
            qf[d0][4] = bf2f(w.z & 0xffff); qf[d0][5] = bf2f(w.z >> 16); qf[d0][6] = bf2f(w.w & 0xffff); qf[d0][7] = bf2f(w.w >> 16); }
        float ss = 0.f;
#pragma unroll
        for (int d0 = 0; d0 < 6; ++d0)
#pragma unroll
            for (int j = 0; j < 8; ++j) ss += qf[d0][j] * qf[d0][j];
        ss += __shfl_xor(ss, 32);
        const float rstd = rsqrtf(ss * (1.f / QK) + EPS);
        const float* gqn = FIN(I_MGQN);
#pragma unroll
        for (int d0 = 0; d0 < 6; ++d0)
#pragma unroll
            for (int j = 0; j < 8; ++j) qf[d0][j] *= rstd * gqn[16 * d0 + 8 * hi + j];
        const float pos = (float)row_pos(qrow);
#pragma unroll
        for (int j = 0; j < 8; ++j) { float sn, cs; fast_sincos(pos * ROPE_INV[8 * hi + j], sn, cs); const float x1 = qf[4][j], x2 = qf[5][j]; qf[4][j] = x1 * cs - x2 * sn; qf[5][j] = x2 * cs + x1 * sn; }
        const float sc = 0.10206207261596575f * 1.4426950408889634f;
#pragma unroll
        for (int d0 = 0; d0 < 6; ++d0) { u32x4 w; w.x = pk2(qf[d0][0] * sc, qf[d0][1] * sc); w.y = pk2(qf[d0][2] * sc, qf[d0][3] * sc); w.z = pk2(qf[d0][4] * sc, qf[d0][5] * sc); w.w = pk2(qf[d0][6] * sc, qf[d0][7] * sc); qr[d0] = __builtin_bit_cast(bf16x8, w); }
    } else {
#pragma unroll
        for (int d0 = 0; d0 < 6; ++d0) qr[d0] = (bf16x8){0, 0, 0, 0, 0, 0, 0, 0};
    }
    f32x16 o0 = {}, o1 = {};
    float mhat = 0.f, lsum = 0.f;
    f32x16 negm = {};
    VM_WAIT(); __syncthreads();
    for (int t = 0; t < NT; ++t) {
        if (t + 1 < NT) ATT_LOAD(t + 1, (t + 1) & 1);
        if (t <= myT) {
            const LAS char* Kb = (const LAS char*)(shm + (t & 1) * ATT_STAGE) + hi * 1024 + r32 * 16;
            const LAS char* Vb = (const LAS char*)(shm + (t & 1) * ATT_STAGE) + 12288 + ((lane >> 4) & 1) * 32 + (lane & 3) * 8 + (4 * hi + ((lane & 15) >> 2)) * 64;
            f32x16 p0 = negm, p1 = negm;
#pragma unroll
            for (int d0 = 0; d0 < 6; ++d0) {
                const bf16x8 a0 = *(const LAS bf16x8*)(Kb + d0 * 2048), a1 = *(const LAS bf16x8*)(Kb + d0 * 2048 + 512);
                p0 = __builtin_amdgcn_mfma_f32_32x32x16_bf16(a0, qr[d0], p0, 0, 0, 0);
                p1 = __builtin_amdgcn_mfma_f32_32x32x16_bf16(a1, qr[d0], p1, 0, 0, 0);
            }
            if (t == 0) {
#pragma unroll
                for (int r = 0; r < 16; ++r) { p0[r] = -INFINITY; if (r < 8) p1[r] = -INFINITY; }
            }
            float ra = max3f(p0[0], p0[1], p1[0]), rb = max3f(p0[2], p0[3], p1[1]); ra = max3f(ra, p1[2], p1[3]);
#pragma unroll
            for (int r = 4; r < 16; r += 4) { ra = max3f(ra, p0[r], p0[r + 1]); rb = max3f(rb, p0[r + 2], p0[r + 3]); ra = max3f(ra, p1[r], p1[r + 1]); rb = max3f(rb, p1[r + 2], p1[r + 3]); }
            float rm = max2f(ra, rb);
            { auto rr = __builtin_amdgcn_permlane32_swap(__float_as_uint(rm), __float_as_uint(rm), false, false); rm = max2f(__uint_as_float(rr[0]), __uint_as_float(rr[1])); }
            if (__builtin_expect(__any(rm > 8.f), 0)) {
                const float dl = fmaxf(rm, 0.f); mhat += dl;
#pragma unroll
                for (int r = 0; r < 16; ++r) { p0[r] -= dl; p1[r] -= dl; }
#pragma unroll
                for (int r = 0; r < 16; ++r) negm[r] = -mhat;
                const float f = __builtin_amdgcn_exp2f(-dl); lsum *= f;
#pragma unroll
                for (int r = 0; r < 16; ++r) { o0[r] *= f; o1[r] *= f; }
            }
            float ps = 0.f;
#pragma unroll
            for (int r = 0; r < 16; ++r) { p0[r] = __builtin_amdgcn_exp2f(p0[r]); p1[r] = __builtin_amdgcn_exp2f(p1[r]); ps += p0[r] + p1[r]; }
            lsum += ps;
            u32x4 pw[4];
            pw[0] = (u32x4){pk2(p0[0], p0[1]), pk2(p0[2], p0[3]), pk2(p0[4], p0[5]), pk2(p0[6], p0[7])};
            pw[1] = (u32x4){pk2(p0[8], p0[9]), pk2(p0[10], p0[11]), pk2(p0[12], p0[13]), pk2(p0[14], p0[15])};
            pw[2] = (u32x4){pk2(p1[0], p1[1]), pk2(p1[2], p1[3]), pk2(p1[4], p1[5]), pk2(p1[6], p1[7])};
            pw[3] = (u32x4){pk2(p1[8], p1[9]), pk2(p1[10], p1[11]), pk2(p1[12], p1[13]), pk2(p1[14], p1[15])};
#pragma unroll
            for (int ks = 0; ks < 4; ++ks) {
                const s16x4 l0 = vtr(Vb + ks * 1024), h0 = vtr(Vb + ks * 1024 + 512), l1 = vtr(Vb + 4096 + ks * 1024), h1 = vtr(Vb + 4096 + ks * 1024 + 512);
                const bf16x8 v0 = (bf16x8){l0[0], l0[1], l0[2], l0[3], h0[0], h0[1], h0[2], h0[3]}, v1 = (bf16x8){l1[0], l1[1], l1[2], l1[3], h1[0], h1[1], h1[2], h1[3]};
                const bf16x8 pb = __builtin_bit_cast(bf16x8, pw[ks]);
                o0 = __builtin_amdgcn_mfma_f32_32x32x16_bf16(v0, pb, o0, 0, 0, 0);
                o1 = __builtin_amdgcn_mfma_f32_32x32x16_bf16(v1, pb, o1, 0, 0, 0);
            }
        }
        VM_WAIT(); __syncthreads();
    }
#undef ATT_LOAD
    if (myT >= 0) {
        lsum += __shfl_xor(lsum, 32);
        const float inv = 1.f / lsum;
        bf16* orow = O + (size_t)qrow * 1024 + h * 64;
#pragma unroll
        for (int g = 0; g < 4; ++g) {
            u32x2 w0, w1; w0.x = pk2(o0[4 * g] * inv, o0[4 * g + 1] * inv); w0.y = pk2(o0[4 * g + 2] * inv, o0[4 * g + 3] * inv);
            w1.x = pk2(o1[4 * g] * inv, o1[4 * g + 1] * inv); w1.y = pk2(o1[4 * g + 2] * inv, o1[4 * g + 3] * inv);
            *(u32x2*)(orow + 8 * g + 4 * hi) = w0; *(u32x2*)(orow + 32 + 8 * g + 4 * hi) = w1;
        }
    }
}

namespace fa {
constexpr int SLOTK = 8192, SLOTV = 4096, NSLOTK = 4, NSLOT = 3;
constexpr int LDS_K = 0, LDS_V = NSLOTK * SLOTK, LDS_WS = LDS_V + NSLOT * SLOTV, LDS_OST = LDS_WS + NWAVES * 64 * 4, LDS_BYTES_ = LDS_OST + NWAVES * 4096;
typedef int v8i_t __attribute__((ext_vector_type(8)));
typedef const LAS char* lds_cptr;
#define FA_SBAR() __builtin_amdgcn_sched_barrier(0)
#define FA_WAIT_BAR(N) asm volatile("s_waitcnt vmcnt(" #N ") lgkmcnt(0)\n\ts_barrier" ::: "memory")
__device__ __forceinline__ v8i_t kload8(lds_cptr kp, int kb, int j) {
    const u32x4 a = *(const LAS u32x4*)(kp + j * 4096 + kb * 512), b = *(const LAS u32x4*)(kp + j * 4096 + kb * 512 + 1024);
    return (v8i_t){(int)a.x, (int)a.y, (int)a.z, (int)a.w, (int)b.x, (int)b.y, (int)b.z, (int)b.w};
}
__device__ __forceinline__ void attn_unit_fast(const Args& args, Frame& F, int bh, int qb) {
    const int lane = F.lane, r32 = lane & 31, hi = lane >> 5, wid = F.wave;
    const int b = bh >> 4, h = bh & 15;
    const bf16* QR = (const bf16*)(F.ws + A_QRAW); const unsigned char* Kt = (const unsigned char*)(F.ws + A_K) + (size_t)bh * NTILE * 8192; const unsigned char* Vt = (const unsigned char*)F.out + V8_OFF + (size_t)bh * NTILE * 4096;
    bf16* O = (bf16*)(F.ws + A_O);
    char* shm = (char*)(F.lds + RING_OFF);
    const unsigned lds0 = (unsigned)(uintptr_t)shm;
    const int NT = 4 * qb + 5;
    const int qrow = b * SEQ + 256 * qb + 32 * wid + r32;
    const int myband = wid >> 1;
    float* wsf = (float*)(shm + LDS_WS) + wid * 64;
    const unsigned char* ksrc = Kt + lane * 16 + wid * 1024; const unsigned char* vsrc = Vt + (lane & 31) * 16 + wid * 512;
    const unsigned kdst = lds0 + LDS_K + wid * 1024, vdst = lds0 + LDS_V + wid * 512;
#define FA_DMA_K(t, slot) glds16(ksrc + (size_t)(t) * 8192, (unsigned)__builtin_amdgcn_readfirstlane(kdst + (slot) * SLOTK))
#define FA_DMA_V(t, slot) do { const unsigned vd_ = (unsigned)__builtin_amdgcn_readfirstlane(vdst + (slot) * SLOTV); if (lane < 32) glds16(vsrc + (size_t)(t) * 4096, vd_); } while (0)
    const lds_cptr shm3 = (lds_cptr)shm; const lds_cptr kp0 = shm3 + LDS_K + hi * 2048 + r32 * 16; const lds_cptr vp0 = shm3 + LDS_V + hi * 1024 + r32 * 16;
    v8i_t kf[4];
    FA_DMA_K(0, 0); FA_DMA_V(0, 0); FA_DMA_K(1, 1);
    v8i_t qr[2];
    {
        float qa[32], qb_[32];
        const bf16* qsrc = QR + (size_t)qrow * 1536 + h * QK;
#pragma unroll
        for (int c = 0; c < 4; ++c) { const u32x4 w = *(const u32x4*)(qsrc + 32 * hi + 8 * c), w2 = *(const u32x4*)(qsrc + 64 + 8 * c);
            qa[8 * c + 0] = bf2f(w.x & 0xffff); qa[8 * c + 1] = bf2f(w.x >> 16); qa[8 * c + 2] = bf2f(w.y & 0xffff); qa[8 * c + 3] = bf2f(w.y >> 16);
            qa[8 * c + 4] = bf2f(w.z & 0xffff); qa[8 * c + 5] = bf2f(w.z >> 16); qa[8 * c + 6] = bf2f(w.w & 0xffff); qa[8 * c + 7] = bf2f(w.w >> 16);
            qb_[8 * c + 0] = bf2f(w2.x & 0xffff); qb_[8 * c + 1] = bf2f(w2.x >> 16); qb_[8 * c + 2] = bf2f(w2.y & 0xffff); qb_[8 * c + 3] = bf2f(w2.y >> 16);
            qb_[8 * c + 4] = bf2f(w2.z & 0xffff); qb_[8 * c + 5] = bf2f(w2.z >> 16); qb_[8 * c + 6] = bf2f(w2.w & 0xffff); qb_[8 * c + 7] = bf2f(w2.w >> 16); }
        float ss = 0.f, sr = 0.f;
#pragma unroll
        for (int j = 0; j < 32; ++j) { ss += qa[j] * qa[j]; sr += qb_[j] * qb_[j]; }
        ss += __shfl_xor(ss, 32);
        const float rstd = rsqrtf((ss + sr) * (1.f / QK) + EPS) * KQ_SC;
        const float* gqn = FIN(I_MGQN);
#pragma unroll
        for (int j = 0; j < 32; ++j) { qa[j] *= rstd * gqn[32 * hi + j]; qb_[j] *= rstd * gqn[64 + j]; }
        const float pos = (float)row_pos(qrow);
#pragma unroll
        for (int j = 0; j < 16; ++j) { float sn, cs; fast_sincos(pos * ROPE_INV[j], sn, cs); const float x1 = qb_[j], x2 = qb_[16 + j]; qb_[j] = x1 * cs - x2 * sn; qb_[16 + j] = x2 * cs + x1 * sn; }
#pragma unroll
        for (int c = 0; c < 8; ++c) { qr[0][c] = (int)pk4_e4m3(qa[4 * c], qa[4 * c + 1], qa[4 * c + 2], qa[4 * c + 3]);
            const unsigned rb = pk4_e4m3(qb_[4 * c], qb_[4 * c + 1], qb_[4 * c + 2], qb_[4 * c + 3]); qr[1][c] = hi ? 0 : (int)rb; }
    }
    f32x16 o[2], o2; o[0] = f32x16{}; o[1] = f32x16{}; o2 = f32x16{};
    v8i_t ones8; { int one_ = 0x38383838; asm volatile("" : "+v"(one_)); ones8 = (v8i_t){one_, one_, one_, one_, one_, one_, one_, one_}; }
#define FA_CMASK(P0, P1, t) do { if (FA_CMASK_ON && (t) - (NT - 4) > myband) { _Pragma("unroll") for (int r = 0; r < 16; ++r) { P0[r] = -INFINITY; P1[r] = -INFINITY; } } } while (0)
    f32x16 pA0, pA1, pB0, pB1;
    int sk_cur = 0, sk_next = 1, sk_prev = 2;
#define FA_ROT() do { const int tmp_ = sk_prev; sk_prev = sk_cur; sk_cur = sk_next; sk_next = tmp_; } while (0)
    FA_DMA_K(2, 2); FA_DMA_K(3, 3);
    FA_WAIT_BAR(4);
#define FA_MF8(a, b, c) __builtin_amdgcn_mfma_scale_f32_32x32x64_f8f6f4(a, b, c, 0, 0, 0, 0, 0, 0)
    { const f32x16 z = {};
      pA0 = FA_MF8(kload8(kp0, 0, 0), qr[0], z); pA1 = FA_MF8(kload8(kp0, 1, 0), qr[0], z); pA0 = FA_MF8(kload8(kp0, 0, 1), qr[1], pA0); pA1 = FA_MF8(kload8(kp0, 1, 1), qr[1], pA1); }
#pragma unroll
    for (int r = 0; r < 16; ++r) { pA0[r] = -INFINITY; if (r < 8) pA1[r] = -INFINITY; }
#pragma unroll
    for (int r = 0; r < 16; ++r) { pA0[r] = __builtin_amdgcn_exp2f(pA0[r]); pA1[r] = __builtin_amdgcn_exp2f(pA1[r]); }
    FA_WAIT_BAR(0);
    FA_DMA_V(1, 1);
    FA_ROT();
    kf[0] = kload8(kp0 + 1 * SLOTK, 0, 0); kf[1] = kload8(kp0 + 1 * SLOTK, 1, 0);
    FA_WAIT_BAR(1);
    v8i_t vf[2], pq;
#define FA_PKW(P, B) pk2(P[B], P[B + 1])
#define FA_PAF(k) __builtin_bit_cast(bf16x8, pw##k)
#define FA_VFR(i) (bf16x8){vlo[i][0], vlo[i][1], vlo[i][2], vlo[i][3], vhi[i][0], vhi[i][1], vhi[i][2], vhi[i][3]}
#define FA_PIN(x) asm volatile("" : "+v"(x))
#define FA_GAPA(MF, A0, A1, A2, A3, W0, W1, PW) do { MF; sacc += A0; sacc += A1; sacc += A2; sacc += A3; FA_PIN(sacc); W0; W1; FA_PIN(PW); FA_SBAR(); } while (0)
#define FA_GAPA0(MF) do { MF; FA_SBAR(); } while (0)
#define FA_GAPA8(MF, A0, A1, A2, A3, A4, A5, A6, A7, W0, W1) do { MF; W0; W1; FA_SBAR(); } while (0)
#define FA_GAPB8(MF, X, B) do { MF; _Pragma("unroll") for (int e_ = 0; e_ < 8; ++e_) X[(B) + e_] = FA_EX(X[(B) + e_]); FA_PIN(X); FA_SBAR(); } while (0)
#define FA_GAPA2(MF, A0, A1, W0, W1, PW) do { MF; sacc += A0; sacc += A1; FA_PIN(sacc); W0; W1; FA_PIN(PW); FA_SBAR(); } while (0)
#define FA_GAPA4(MF, A0, A1, A2, A3) do { MF; sacc += A0; sacc += A1; sacc += A2; sacc += A3; FA_PIN(sacc); FA_SBAR(); } while (0)
#define FA_EX(v) __builtin_amdgcn_exp2f(v)
#define FA_GAPB(MF, X, B) do { MF; X[B] = FA_EX(X[B]); X[B + 1] = FA_EX(X[B + 1]); X[B + 2] = FA_EX(X[B + 2]); X[B + 3] = FA_EX(X[B + 3]); FA_PIN(X); FA_SBAR(); } while (0)
#define FA_VRD(dvb_) do { const u32x4 a_ = *(const LAS u32x4*)(vp_ + (dvb_) * 2048), b_ = *(const LAS u32x4*)(vp_ + (dvb_) * 2048 + 512); vf[dvb_] = (v8i_t){(int)a_.x, (int)a_.y, (int)a_.z, (int)a_.w, (int)b_.x, (int)b_.y, (int)b_.z, (int)b_.w}; } while (0)
#define FA_PQ(P, B) (int)pk4_bf8(P[B], P[(B) + 1], P[(B) + 2], P[(B) + 3])
#define FA_MFPV(d_) o[d_] = __builtin_amdgcn_mfma_scale_f32_32x32x64_f8f6f4(pq, vf[d_], o[d_], 1, 0, 0, 0, 0, 0)
#define FA_KRD(G, kb_, t) do { if (G) { kf[kb_] = kload8(kp0 + (((t) + 1) & 3) * SLOTK, kb_, 0); FA_SBAR(); } } while (0)
#define FA_MF(a, b, c) __builtin_amdgcn_mfma_f32_32x32x16_bf16(a, b, c, 0, 0, 0)
#define FA_KJ(kb_, t) do { kf[2 + (kb_)] = kload8(kp0 + ((t) & 3) * SLOTK, kb_, 1); FA_SBAR(); } while (0)
#define FA_STEP(C0, C1, P0, P1, t, GK, GV, GL) do { FA_SBAR(); \
    const lds_cptr vp_ = vp0 + sk_prev * SLOTV; const f32x16 z_ = {}; \
    FA_KJ(0, t); FA_KJ(1, t); \
    FA_GAPA8(C0 = FA_MF8(kf[0], qr[0], z_), P0[2], P0[3], P0[4], P0[5], P0[6], P0[7], P0[8], P0[9],         pq[0] = FA_PQ(P0, 0), pq[1] = FA_PQ(P0, 4)); \
    FA_GAPA8(C1 = FA_MF8(kf[1], qr[0], z_), P0[10], P0[11], P0[12], P0[13], P0[14], P0[15], P1[0], P1[1],   pq[2] = FA_PQ(P0, 8), pq[3] = FA_PQ(P0, 12)); \
    FA_VRD(0); FA_SBAR(); \
    FA_GAPA8(C0 = FA_MF8(kf[2], qr[1], C0), P1[2], P1[3], P1[4], P1[5], P1[6], P1[7], P1[8], P1[9],         pq[4] = FA_PQ(P1, 0), pq[5] = FA_PQ(P1, 4)); \
    FA_VRD(1); FA_SBAR(); \
    FA_GAPA8(C1 = FA_MF8(kf[3], qr[1], C1), P1[10], P1[11], P1[12], P1[13], P1[14], P1[15], 0.f, 0.f,       pq[6] = FA_PQ(P1, 8), pq[7] = FA_PQ(P1, 12)); FA_PIN(pq); \
    if (GK) { FA_DMA_K((t) + 3, ((t) + 3) & 3); } if (GV) { FA_DMA_V((t) + 1, sk_next); } \
    FA_CMASK(C0, C1, t); \
    FA_SBAR(); \
    FA_GAPB8(FA_MFPV(0), C0, 0); \
    FA_KRD(GL, 0, t); FA_GAPB8(FA_MFPV(1), C0, 8); \
    FA_KRD(GL, 1, t); FA_GAPB8(o2 = __builtin_amdgcn_mfma_scale_f32_32x32x64_f8f6f4(pq, ones8, o2, 1, 0, 0, 0, 0, 0), C1, 0); \
    FA_GAPB8((void)0, C1, 8); \
    } while (0)
#define FA_ENDW(tt) do { if ((tt) + 3 < NT) { FA_WAIT_BAR(2); } else if ((tt) + 1 < NT) { FA_WAIT_BAR(1); } else { FA_WAIT_BAR(0); } } while (0)
    int t = 1;
#define FA_CMASK_ON 0
    for (; t + 5 < NT; t += 2) {
        FA_STEP(pB0, pB1, pA0, pA1, t, true, true, true);     FA_WAIT_BAR(2); FA_ROT();
        FA_STEP(pA0, pA1, pB0, pB1, t + 1, true, true, true); FA_WAIT_BAR(2); FA_ROT();
    }
#undef FA_CMASK_ON
#define FA_CMASK_ON 1
    for (; t + 1 < NT; t += 2) {
        FA_STEP(pB0, pB1, pA0, pA1, t, (t + 3 < NT), (t + 1 < NT), (t + 1 < NT));     FA_ENDW(t);     FA_ROT();
        FA_STEP(pA0, pA1, pB0, pB1, t + 1, (t + 4 < NT), (t + 2 < NT), (t + 2 < NT)); FA_ENDW(t + 1); FA_ROT();
    }
#undef FA_CMASK_ON
    {
      pq = (v8i_t){FA_PQ(pA0, 0), FA_PQ(pA0, 4), FA_PQ(pA0, 8), FA_PQ(pA0, 12), FA_PQ(pA1, 0), FA_PQ(pA1, 4), FA_PQ(pA1, 8), FA_PQ(pA1, 12)};
      const lds_cptr vp_ = vp0 + sk_prev * SLOTV;
      FA_VRD(0); FA_VRD(1);
      FA_MFPV(0); FA_MFPV(1); o2 = __builtin_amdgcn_mfma_scale_f32_32x32x64_f8f6f4(pq, ones8, o2, 1, 0, 0, 0, 0, 0); }
    float rli[16];
#pragma unroll
    for (int r = 0; r < 16; ++r) rli[r] = __builtin_amdgcn_rcpf(o2[r]);
    bf16* Ow = O + (size_t)(b * SEQ + 256 * qb + wid * 32) * 1024 + h * 64;
    { bf16* stg = (bf16*)(shm + LDS_OST) + wid * 2048;
#pragma unroll
      for (int r = 0; r < 16; ++r) { const int orow = crow(r, hi);
#pragma unroll
          for (int d0 = 0; d0 < 2; ++d0) stg[orow * 64 + d0 * 32 + r32] = (bf16)f2bf(o[d0][r] * rli[r]); }
      asm volatile("s_waitcnt lgkmcnt(0)" ::: "memory");
#pragma unroll
      for (int i = 0; i < 4; ++i) { const int row = i * 8 + (lane >> 3), ch = lane & 7; const u32x4 v = *(const u32x4*)(stg + row * 64 + ch * 8); *(u32x4*)(Ow + (size_t)row * 1024 + ch * 8) = v; } }
    asm volatile("s_waitcnt vmcnt(0) lgkmcnt(0)\n\ts_barrier" ::: "memory");
#undef FA_DMA_K
#undef FA_DMA_V
#undef FA_CMASK
#undef FA_ROT
#undef FA_PKW
#undef FA_PAF
#undef FA_VFR
#undef FA_PIN
#undef FA_GAPA
#undef FA_GAPA0
#undef FA_GAPA8
#undef FA_MF8
#undef FA_GAPA2
#undef FA_GAPA4
#undef FA_EX
#undef FA_GAPB
#undef FA_VRD
#undef FA_PQ
#undef FA_MFPV
#undef FA_GAPB8
#undef FA_KRD
#undef FA_KJ
#undef FA_MF
#undef FA_STEP
#undef FA_ENDW
}
#undef FA_SBAR
#undef FA_WAIT_BAR
}

__device__ __forceinline__ void attn_phase(const Args& args, Frame& F) {
    const int v = F.vcu, s4 = v & 3;
    for (int i = 0; ; ++i) {
        int bh, qb;
        if (F.G == 256) { if (i > 8 || (i == 8 && s4 != 0)) break; bh = v >> 2; const int j = i >> 1; qb = (i == 8) ? -1 : ((i & 1) ? 31 - (4 * j + s4) : 4 * j + s4); }
        else { const int u = blockIdx.x + i * F.G; if (u >= 64 * 33) break; bh = u / 33; qb = (u % 33) - 1; }
        if (qb >= 0) fa::attn_unit_fast(args, F, bh, qb); else attn_unit(args, F, bh, qb);
    }
}

__device__ __forceinline__ void route_phase(const Args& args, Frame& F, int layer, const bf16* hb, unsigned* gcnt, int* list, float* wts, unsigned* epos, float* rsl) {
    const int lane = F.lane, wave = F.wave, tid = F.tid, l15 = lane & 15, kq = lane >> 4;
    const float* gain = FIN(I_NFFN) + layer * 1024; const float* wrg = FIN(I_RWG) + (size_t)layer * 1024 * 4; const float* wre = FIN(I_RWE) + (size_t)layer * 1024 * 32;
    const float* brg = FIN(I_RBG) + layer * 4; const float* bre = FIN(I_RBE) + layer * 32;
    float* part_lg = (float*)(F.lds + RING_OFF);
    float* part_ss = (float*)(F.lds + RING_OFF + 49152);
    float* logit_s = (float*)(F.lds + RING_OFF + 50176);
    float* rstd_s = (float*)(F.lds + RING_OFF + 56320);
    int* dec_e = (int*)(F.lds + RING_OFF + 57344);
    float* dec_w = (float*)(F.lds + RING_OFF + 57344 + 2048);
    int* dec_rank = (int*)(F.lds + RING_OFF + 57344 + 4096);
    int* lcnt = (int*)(F.lds + RING_OFF + 57344 + 6144);
    int* lbase = (int*)(F.lds + RING_OFF + 57344 + 6144 + 128);
    float* rstd_all = (float*)(F.lds + RING_OFF + 57344 + 6144 + 256);
    const int RPB = (MROWS + F.G - 1) / F.G;
    const int r0 = blockIdx.x * RPB, r1 = (r0 + RPB < MROWS) ? r0 + RPB : MROWS;
    if (tid < 32) lcnt[tid] = 0;
    const int kbase = 128 * wave;
    bf16x8 wh[4][3], wl[4][3];
#pragma unroll
    for (int s4 = 0; s4 < 4; ++s4)
#pragma unroll
        for (int cb = 0; cb < 3; ++cb) {
            float w[8]; const int col = 16 * cb + l15;
#pragma unroll
            for (int j = 0; j < 8; ++j) { const int k = kbase + 32 * s4 + 8 * kq + j; float v = 0.f; if (col < 4) v = wrg[k * 4 + col]; else if (col < 36) v = wre[k * 32 + (col - 4)]; w[j] = v * gain[k]; }
            u32x4 ph, pl; unsigned hw[4], lw[4];
#pragma unroll
            for (int j = 0; j < 4; ++j) { const unsigned hb_ = pk2(w[2 * j], w[2 * j + 1]); hw[j] = hb_; lw[j] = pk2(w[2 * j] - bf2f(hb_ & 0xffff), w[2 * j + 1] - bf2f(hb_ >> 16)); }
            ph = (u32x4){hw[0], hw[1], hw[2], hw[3]}; pl = (u32x4){lw[0], lw[1], lw[2], lw[3]};
            wh[s4][cb] = __builtin_bit_cast(bf16x8, ph); wl[s4][cb] = __builtin_bit_cast(bf16x8, pl);
        }
    __syncthreads();
    const int ngroups = (RPB + 31) / 32;
    u32x4 xa[2][4];
    auto load_rows = [&](int g) {
#pragma unroll
        for (int rb = 0; rb < 2; ++rb) { const int lr = 32 * g + 16 * rb + l15, r = r0 + lr; const bool ok = lr < RPB && r < r1 && !row_is_dummy(r);
#pragma unroll
            for (int s4 = 0; s4 < 4; ++s4) xa[rb][s4] = ok ? *(const u32x4*)(hb + (size_t)r * 1024 + kbase + 32 * s4 + 8 * kq) : (u32x4){0u, 0u, 0u, 0u}; }
    };
    load_rows(0);
    for (int g = 0; g < ngroups; ++g) {
        u32x4 xc[2][4];
#pragma unroll
        for (int rb = 0; rb < 2; ++rb)
#pragma unroll
            for (int s4 = 0; s4 < 4; ++s4) xc[rb][s4] = xa[rb][s4];
        if (g + 1 < ngroups) load_rows(g + 1);
#pragma unroll
        for (int rb = 0; rb < 2; ++rb) {
            float ss = 0.f; f32x4 acc[3] = {};
#pragma unroll
            for (int s4 = 0; s4 < 4; ++s4) {
                const u32x4 q = xc[rb][s4]; const unsigned qw[4] = {q.x, q.y, q.z, q.w};
#pragma unroll
                for (int j = 0; j < 4; ++j) { const float a = bf2f(qw[j] & 0xffff), b = bf2f(qw[j] >> 16); ss += a * a + b * b; }
                const bf16x8 xh = __builtin_bit_cast(bf16x8, q);
#pragma unroll
                for (int cb = 0; cb < 3; ++cb) {
                    acc[cb] = __builtin_amdgcn_mfma_f32_16x16x32_bf16(xh, wh[s4][cb], acc[cb], 0, 0, 0);
                    acc[cb] = __builtin_amdgcn_mfma_f32_16x16x32_bf16(xh, wl[s4][cb], acc[cb], 0, 0, 0);
                }
            }
            ss += __shfl_xor(ss, 16); ss += __shfl_xor(ss, 32);
#pragma unroll
            for (int cb = 0; cb < 3; ++cb)
#pragma unroll
                for (int rg = 0; rg < 4; ++rg) part_lg[(wave * 32 + 16 * rb + 4 * kq + rg) * 48 + 16 * cb + l15] = acc[cb][rg];
            if (kq == 0) part_ss[wave * 32 + 16 * rb + l15] = ss;
        }
        __syncthreads();
        for (int i = tid; i < 1536; i += NTHREADS) { float a = 0.f;
#pragma unroll
            for (int w = 0; w < 8; ++w) a += part_lg[w * 1536 + i];
            logit_s[i] = a; }
        if (tid < 32) { float tot = 0.f;
#pragma unroll
            for (int w = 0; w < 8; ++w) tot += part_ss[w * 32 + tid];
            const float rstd = rsqrtf(tot * (1.f / 1024.f) + EPS); rstd_s[tid] = rstd; if (32 * g + tid < RPB) rstd_all[32 * g + tid] = rstd; }
        __syncthreads();
        if (tid < 32) {
            const int lr = 32 * g + tid, r = r0 + lr;
            if (lr < RPB) {
                int e1 = -1, e2 = -1; float w1 = 0.f, w2 = 0.f;
                if (r < r1 && !row_is_dummy(r)) {
                    const float* lg = logit_s + tid * 48; const float rs = rstd_s[tid];
                    float gl[4]; int gs = 0;
#pragma unroll
                    for (int i = 0; i < 4; ++i) gl[i] = lg[i] * rs + brg[i];
#pragma unroll
                    for (int i = 1; i < 4; ++i) if (gl[i] > gl[gs]) gs = i;
                    float den = 0.f;
#pragma unroll
                    for (int i = 0; i < 4; ++i) den += __expf(gl[i] - gl[gs]);
                    const float pg = 1.f / den;
                    float el[8]; int i1 = 0;
#pragma unroll
                    for (int i = 0; i < 8; ++i) el[i] = lg[4 + 8 * gs + i] * rs + bre[8 * gs + i];
#pragma unroll
                    for (int i = 1; i < 8; ++i) if (el[i] > el[i1]) i1 = i;
                    int i2 = (i1 == 0) ? 1 : 0;
#pragma unroll
                    for (int i = 0; i < 8; ++i) if (i != i1 && el[i] > el[i2]) i2 = i;
                    float e1v = el[0], e2v = el[0];
#pragma unroll
                    for (int i = 0; i < 8; ++i) { if (i == i1) e1v = el[i]; if (i == i2) e2v = el[i]; }
                    const float ex = __expf(e2v - e1v);
                    w1 = pg / (1.f + ex); w2 = pg * ex / (1.f + ex); e1 = 8 * gs + i1; e2 = 8 * gs + i2;
                }
                dec_e[2 * lr] = e1; dec_e[2 * lr + 1] = e2; dec_w[2 * lr] = w1; dec_w[2 * lr + 1] = w2;
                dec_rank[2 * lr] = e1 >= 0 ? atomicAdd(&lcnt[e1], 1) : 0; dec_rank[2 * lr + 1] = e2 >= 0 ? atomicAdd(&lcnt[e2], 1) : 0;
            }
        }
    }
    __syncthreads();
    if (tid < 32) lbase[tid] = (int)atomicAdd(gcnt + tid, (unsigned)lcnt[tid]);
    __syncthreads();
    for (int i = tid; i < 2 * RPB; i += NTHREADS) {
        const int e = dec_e[i]; if (e < 0) continue;
        const int slot = 2 * (r0 + (i >> 1)) + (i & 1); const int pos = lbase[e] + dec_rank[i];
        list[(size_t)e * MROWS + pos] = slot; wts[slot] = dec_w[i]; epos[slot] = ((unsigned)e << 20) | (unsigned)pos; rsl[(size_t)e * MROWS + pos] = rstd_all[i >> 1];
    }
    __syncthreads();
}

constexpr int G1_QT = 0, G1_KM = 17408, G1_KH = 34816, G1_VT = 55296, G1_BL = 92160, G1_GLR = 124928, G1_SCR = 129024;
constexpr int PQ = 272, PKH = 320, PV = 576;
__device__ __forceinline__ float logsigmoid_f(float x) { const float e = __builtin_amdgcn_exp2f(-1.4426950408889634f * fabsf(x)); return fminf(x, 0.f) - 0.6931471805599453f * __builtin_amdgcn_logf(1.f + e); }

__device__ __forceinline__ bf16x8 tr_frag(const LAS char* tile, int pitch, int col0, int ks, int lane) {
    const int hi = lane >> 5, q = (lane & 15) >> 2, p = lane & 3, h16 = (lane >> 4) & 1;
    const LAS char* a = tile + (16 * ks + 8 * hi + q) * pitch + (col0 + 16 * h16 + 4 * p) * 2;
    const s16x4 lo = vtr(a), hi4 = vtr(a + 4 * pitch);
    return (bf16x8){lo[0], lo[1], lo[2], lo[3], hi4[0], hi4[1], hi4[2], hi4[3]};
}

__device__ __forceinline__ void g1_phase(const Args& args, Frame& F) {
    const int tid = F.tid, lane = F.lane, wave = F.wave, r32 = lane & 31, hi = lane >> 5;
    unsigned char* shm = F.lds + RING_OFF;
    const bf16* ZQK = (const bf16*)(F.ws + A_ZQK); const bf16* ZV = (const bf16*)(F.ws + A_ZV); const float* GLR = (const float*)(F.ws + S_GLR);
    bf16* QT = (bf16*)(F.ws + A_QT);
    float* bL = (float*)(shm + G1_BL); float* scr = (float*)(shm + G1_SCR);
    constexpr int NPAIR = NB * GH * 16;
    int pair = blockIdx.x; if (pair >= NPAIR) return;
    int ci = 0;
    int bh = pair & 15, c = 8 * (pair >> 4), b = bh >> 2, h = bh & 3;
    f32x16 acc[4]; float pcum = 1.f;
    u32x4 qp[2], kp[2], vp[4]; f32x4 gl0 = {}, gl1 = {}; int prow[2], pd[2];
    const int tbw = wave & 1, dbw = wave >> 1;
#pragma unroll
    for (int j = 0; j < 2; ++j) { const int p = tid + 512 * j; prow[j] = p >> 4; pd[j] = (p & 15) * 8; }
#define G1_LOAD_QK(b_, c_, h_) do { _Pragma("unroll") for (int j = 0; j < 2; ++j) { const int row = row_of(b_, c_, prow[j]); const bool dz_ = (c_) == 0 && prow[j] < 48;     \
            qp[j] = dz_ ? (u32x4){0u, 0u, 0u, 0u} : *(const u32x4*)(ZQK + (size_t)row * 1024 + (h_) * 128 + pd[j]); kp[j] = dz_ ? (u32x4){0u, 0u, 0u, 0u} : *(const u32x4*)(ZQK + (size_t)row * 1024 + 512 + (h_) * 128 + pd[j]); } } while (0)
#define G1_LOAD_V(b_, c_, h_) do { _Pragma("unroll") for (int j = 0; j < 4; ++j) { const int p = tid + 512 * j, i = p >> 5, dc = (p & 31) * 8; vp[j] = ((c_) == 0 && i < 48) ? (u32x4){0u, 0u, 0u, 0u} : *(const u32x4*)(ZV + (size_t)row_of(b_, c_, i) * 1024 + (h_) * 256 + dc); } \
        { const float* gp_ = GLR + (size_t)row_of(b_, c_, 32 * tbw + r32) * 16 + 8 * hi; gl0 = *(const f32x4*)gp_; gl1 = *(const f32x4*)(gp_ + 4); } } while (0)
    G1_LOAD_V(b, c, h); G1_LOAD_QK(b, c, h);
    int wh_ = -1; bf16x8 wfh = {}, wfl = {}; float bg = 0.f;
    for (;;) {
        const int unit = bh * NTILE + c;
        bf16* ATT = (bf16*)(F.ws + A_ATT) + (size_t)unit * 4096; unsigned char* DST = (unsigned char*)F.out + (size_t)(bh * (NTILE - 1) + c) * 32768;     float* GAM = (float*)(F.ws + S_GAM) + (size_t)unit * 128;
        if (h != wh_) { const float* wgu = FIN(I_GWGU); unsigned hw[4], lw[4];
#pragma unroll
            for (int j = 0; j < 4; ++j) { const float w0 = wgu[(8 * hi + 2 * j) * GNK + h * 128 + 32 * dbw + r32], w1 = wgu[(8 * hi + 2 * j + 1) * GNK + h * 128 + 32 * dbw + r32];
                const unsigned hb_ = pk2(w0, w1); hw[j] = hb_; lw[j] = pk2(w0 - bf2f(hb_ & 0xffff), w1 - bf2f(hb_ >> 16)); }
            wfh = __builtin_bit_cast(bf16x8, (u32x4){hw[0], hw[1], hw[2], hw[3]}); wfl = __builtin_bit_cast(bf16x8, (u32x4){lw[0], lw[1], lw[2], lw[3]});
            bg = FIN(I_GBG)[h * 128 + 32 * dbw + r32]; wh_ = h; }
#pragma unroll
        for (int j = 0; j < 4; ++j) { const int p = tid + 512 * j, i = p >> 5, dc = (p & 31) * 8; *(u32x4*)(shm + G1_VT + i * PV + dc * 2) = vp[j]; }
        f32x16 gx;
        { const float gv[8] = {gl0.x, gl0.y, gl0.z, gl0.w, gl1.x, gl1.y, gl1.z, gl1.w}; unsigned hw[4], lw[4];
#pragma unroll
          for (int j = 0; j < 4; ++j) { const unsigned hb_ = pk2(gv[2 * j], gv[2 * j + 1]); hw[j] = hb_; lw[j] = pk2(gv[2 * j] - bf2f(hb_ & 0xffff), gv[2 * j + 1] - bf2f(hb_ >> 16)); }
          const bf16x8 xh = __builtin_bit_cast(bf16x8, (u32x4){hw[0], hw[1], hw[2], hw[3]}), xl = __builtin_bit_cast(bf16x8, (u32x4){lw[0], lw[1], lw[2], lw[3]});
#pragma unroll
          for (int r = 0; r < 16; ++r) gx[r] = bg;
          gx = __builtin_amdgcn_mfma_f32_32x32x16_bf16(xh, wfh, gx, 0, 0, 0); gx = __builtin_amdgcn_mfma_f32_32x32x16_bf16(xl, wfh, gx, 0, 0, 0); gx = __builtin_amdgcn_mfma_f32_32x32x16_bf16(xh, wfl, gx, 0, 0, 0); }
        const int nci = ((pair >> 4) == 15) ? 9 : 8; const bool same = ci + 1 < nci; const int pairn = same ? pair : pair + F.G; const bool more = same || pairn < NPAIR;
        const int bhn = pairn & 15, cn = same ? c + 1 : 8 * (pairn >> 4);
        if (more) G1_LOAD_V(bhn >> 2, cn, bhn & 3);
        { const int d = 32 * dbw + r32; float t0[4], t1[4];
#pragma unroll
          for (int g = 0; g < 4; ++g) { float run = 0.f;
#pragma unroll
              for (int e = 0; e < 4; ++e) { run += logsigmoid_f(gx[4 * g + e]) * (1.f / 16.f); gx[4 * g + e] = run; }
              const auto rr = __builtin_amdgcn_permlane32_swap(__float_as_uint(run), __float_as_uint(run), false, false); t0[g] = __uint_as_float(rr[0]); t1[g] = __uint_as_float(rr[1]); }
          float off[4], run = 0.f;
#pragma unroll
          for (int g = 0; g < 4; ++g) { const float o1 = run + t0[g]; off[g] = hi ? o1 : run; run = o1 + t1[g]; }
          if (tbw == 0 && hi == 0) scr[d] = run;
          __syncthreads();
          const float base = tbw ? scr[d] : 0.f;
#pragma unroll
          for (int g = 0; g < 4; ++g)
#pragma unroll
              for (int e = 0; e < 4; ++e) bL[(32 * tbw + 8 * g + 4 * hi + e) * 128 + d] = gx[4 * g + e] + (off[g] + base);
          if (tbw == 1 && hi == 0) { const float gam = __expf(run + base); scr[512 + d] = gam; pcum = (ci == 0) ? gam : pcum * gam; GAM[d] = pcum; } }
        __syncthreads();
#pragma unroll
        for (int j = 0; j < 2; ++j) {
            const int i = prow[j], d0 = pd[j]; const unsigned qw[4] = {qp[j].x, qp[j].y, qp[j].z, qp[j].w}, kw[4] = {kp[j].x, kp[j].y, kp[j].z, kp[j].w};
            float qt[8], km[8], kh[8];
#pragma unroll
            for (int e = 0; e < 8; ++e) { const float bb = bL[i * 128 + d0 + e], gam = scr[512 + d0 + e];
                const float qv = bf2f((e & 1) ? (qw[e >> 1] >> 16) : (qw[e >> 1] & 0xffff)), kv = bf2f((e & 1) ? (kw[e >> 1] >> 16) : (kw[e >> 1] & 0xffff));
                qt[e] = qv * 0.08838834764831845f * __expf(bb); km[e] = kv * __expf(-bb); kh[e] = km[e] * gam; }
            u32x4 wq, wm, wh; wq.x = pk2(qt[0], qt[1]); wq.y = pk2(qt[2], qt[3]); wq.z = pk2(qt[4], qt[5]); wq.w = pk2(qt[6], qt[7]);
            wm.x = pk2(km[0], km[1]); wm.y = pk2(km[2], km[3]); wm.z = pk2(km[4], km[5]); wm.w = pk2(km[6], km[7]);
            wh.x = pk2(kh[0], kh[1]); wh.y = pk2(kh[2], kh[3]); wh.z = pk2(kh[4], kh[5]); wh.w = pk2(kh[6], kh[7]);
            *(u32x4*)(shm + G1_QT + i * PQ + d0 * 2) = wq; *(u32x4*)(shm + G1_KM + i * PQ + d0 * 2) = wm; *(u32x4*)(shm + G1_KH + i * PKH + d0 * 2) = wh;
            *(u32x4*)(QT + (size_t)row_of(b, c, i) * 512 + h * 128 + d0) = wq;
        }
        if (more) G1_LOAD_QK(bhn >> 2, cn, bhn & 3);
        __syncthreads();
        if (wave < 4) {
            const int sb = wave & 1, tb = wave >> 1; f32x16 a = {};
            if (!(sb == 1 && tb == 0)) {
#pragma unroll
                for (int ks = 0; ks < 8; ++ks) { const bf16x8 fa = *(const LAS bf16x8*)((const LAS char*)(shm + G1_KM) + (32 * sb + r32) * PQ + (16 * ks + 8 * hi) * 2), fb = *(const LAS bf16x8*)((const LAS char*)(shm + G1_QT) + (32 * tb + r32) * PQ + (16 * ks + 8 * hi) * 2);
                    a = __builtin_amdgcn_mfma_f32_32x32x16_bf16(fa, fb, a, 0, 0, 0); }
            }
            const int t = 32 * tb + r32;
#pragma unroll
            for (int g = 0; g < 4; ++g) { const int s0 = 32 * sb + 8 * g + 4 * hi; float v[4];
#pragma unroll
                for (int e = 0; e < 4; ++e) v[e] = (s0 + e <= t) ? a[4 * g + e] : 0.f;
                u32x2 w; w.x = pk2(v[0], v[1]); w.y = pk2(v[2], v[3]); *(u32x2*)(ATT + t * 64 + s0) = w; }
        }
        if (c < NTILE - 1) {
          if (ci == 0) {
#pragma unroll
              for (int kb = 0; kb < 4; ++kb) acc[kb] = f32x16{};
          } else {
#pragma unroll
              for (int kb = 0; kb < 4; ++kb)
#pragma unroll
                  for (int g = 0; g < 4; ++g) { const f32x4 gm = *(const f32x4*)(scr + 512 + 32 * kb + 8 * g + 4 * hi); acc[kb][4 * g] *= gm.x; acc[kb][4 * g + 1] *= gm.y; acc[kb][4 * g + 2] *= gm.z; acc[kb][4 * g + 3] *= gm.w; }
          }
#pragma unroll
          for (int ks = 0; ks < 4; ++ks) {
              const bf16x8 fv = tr_frag((const LAS char*)(shm + G1_VT), PV, 32 * wave, ks, lane);
#pragma unroll
              for (int kb = 0; kb < 4; ++kb) { const bf16x8 fk = tr_frag((const LAS char*)(shm + G1_KH), PKH, 32 * kb, ks, lane); acc[kb] = __builtin_amdgcn_mfma_f32_32x32x16_bf16(fk, fv, acc[kb], 0, 0, 0); }
          }
          const int dv = 32 * wave + r32;
#pragma unroll
          for (int kb = 0; kb < 4; ++kb) {
              unsigned g0 = pk4_e4m3(acc[kb][0], acc[kb][1], acc[kb][2], acc[kb][3]), g1 = pk4_e4m3(acc[kb][4], acc[kb][5], acc[kb][6], acc[kb][7]);
              unsigned g2 = pk4_e4m3(acc[kb][8], acc[kb][9], acc[kb][10], acc[kb][11]), g3 = pk4_e4m3(acc[kb][12], acc[kb][13], acc[kb][14], acc[kb][15]);
              { const auto r = __builtin_amdgcn_permlane32_swap(g0, g2, false, false); g0 = r[0]; g2 = r[1]; }
              { const auto r = __builtin_amdgcn_permlane32_swap(g1, g3, false, false); g1 = r[0]; g3 = r[1]; }
              *(u32x4*)(DST + dv * 128 + 32 * kb + 16 * hi) = (u32x4){g0, g2, g1, g3};
          } }
        __syncthreads();
        if (!more) break;
        ci = same ? ci + 1 : 0; pair = pairn; bh = bhn; c = cn; b = bh >> 2; h = bh & 3;
    }
#undef G1_LOAD_QK
#undef G1_LOAD_V
}
__device__ __forceinline__ void g2_phase(Frame& F) {
    const unsigned char* LS = (const unsigned char*)F.out; const float* GAM = (const float*)(F.ws + S_GAM); bf16* BST = (bf16*)(F.ws + A_BST);
    for (int e4 = blockIdx.x * NTHREADS + F.tid; e4 < NB * GH * 8192; e4 += F.G * NTHREADS) {
        const int bh = e4 >> 13, idx = e4 & 8191, dk0 = (idx * 4) & 127;
        unsigned dd[15]; f32x4 gg[15];
#pragma unroll
        for (int r = 0; r < 15; ++r) { const size_t j = 8 * r + 7; dd[r] = *(const unsigned*)(LS + ((size_t)bh * (NTILE - 1) + j) * 32768 + idx * 4); gg[r] = *(const f32x4*)(GAM + ((size_t)bh * NTILE + j) * 128 + dk0); }
        float s0 = 0.f, s1 = 0.f, s2 = 0.f, s3 = 0.f;
#pragma unroll
        for (int r = 0; r < 15; ++r) {
            const f32x2_t lo = __builtin_amdgcn_cvt_pk_f32_fp8((int)dd[r], false), hi2 = __builtin_amdgcn_cvt_pk_f32_fp8((int)dd[r], true);
            s0 = gg[r].x * s0 + lo.x; s1 = gg[r].y * s1 + lo.y; s2 = gg[r].z * s2 + hi2.x; s3 = gg[r].w * s3 + hi2.y;
            *(u32x2*)(BST + ((size_t)bh * 15 + r) * 32768 + idx * 4) = (u32x2){pk2(s0, s1), pk2(s2, s3)}; }
    }
}
constexpr int G3_QT = 0, G3_AT = 17408, G3_VT = 26624, G3_PART = 63488, G3_QT2 = 65536;
constexpr int PA = 144;
__device__ __forceinline__ void g3_phase(const Args& args, Frame& F) {
    const int tid = F.tid, lane = F.lane, wave = F.wave, r32 = lane & 31, hi = lane >> 5;
    unsigned char* shm = F.lds + RING_OFF;
    const bf16* QT = (const bf16*)(F.ws + A_QT); const bf16* ZV = (const bf16*)(F.ws + A_ZV); const bf16* ZR = (const bf16*)(F.ws + A_ZR); bf16* OG = (bf16*)(F.ws + A_OG);
    float* part = (float*)(shm + G3_PART);
    const float* gout = FIN(I_GGOUT);
    constexpr int NPAIR = NB * GH * 16;
    const float* GAM = (const float*)(F.ws + S_GAM); const bf16* BST = (const bf16*)(F.ws + A_BST);
    int pair = blockIdx.x; if (pair >= NPAIR) return;
    int ci = 0;
    int bh = pair & 15, c = 8 * (pair >> 4) + 1, b = bh >> 2, h = bh & 3;
    u32x4 qp[2], ap, vp[4]; u32x2 sf[8]; f32x4 pj[2][2];
    bf16x8 bfr[8];
#define G3_LOAD() do { const int unit_ = bh * NTILE + c; const bf16* ATT_ = (const bf16*)(F.ws + A_ATT) + (size_t)unit_ * 4096; const unsigned char* SB_ = (const unsigned char*)F.out + (size_t)(bh * (NTILE - 1) + c - 1) * 32768; \
        _Pragma("unroll") for (int j = 0; j < 2; ++j) { const int p = tid + 512 * j, i = p >> 4, d0 = (p & 15) * 8; qp[j] = *(const u32x4*)(QT + (size_t)row_of(b, c, i) * 512 + h * 128 + d0); } \
        { const int i = tid >> 3, s0 = (tid & 7) * 8; ap = *(const u32x4*)(ATT_ + i * 64 + s0); } \
        _Pragma("unroll") for (int j = 0; j < 4; ++j) { const int p = tid + 512 * j, i = p >> 5, dc = (p & 31) * 8; vp[j] = *(const u32x4*)(ZV + (size_t)row_of(b, c, i) * 1024 + h * 256 + dc); } \
        _Pragma("unroll") for (int j = 0; j < 2; ++j) { const int d0 = ((tid + 512 * j) & 15) * 8; const float* pp_ = GAM + ((size_t)bh * NTILE + c - 1) * 128 + d0; pj[j][0] = *(const f32x4*)pp_; pj[j][1] = *(const f32x4*)(pp_ + 4); } \
        { _Pragma("unroll") for (int ks = 0; ks < 8; ++ks) sf[ks] = *(const u32x2*)(SB_ + (32 * wave + r32) * 128 + 16 * ks + 8 * hi); } } while (0)
#define G3_LOADB() do { if ((pair >> 4) > 0) { const bf16* bp_ = BST + ((size_t)bh * 15 + (pair >> 4) - 1) * 32768 + (32 * wave + r32) * 128 + 8 * hi; _Pragma("unroll") for (int ks = 0; ks < 8; ++ks) bfr[ks] = *(const bf16x8*)(bp_ + 16 * ks); } } while (0)
    G3_LOAD(); G3_LOADB();
    float go[4][4];
#pragma unroll
    for (int g = 0; g < 4; ++g)
#pragma unroll
        for (int e = 0; e < 4; ++e) go[g][e] = gout[32 * wave + 8 * g + 4 * hi + e];
    for (;;) {
#pragma unroll
        for (int j = 0; j < 2; ++j) { const int p = tid + 512 * j, i = p >> 4, d0 = (p & 15) * 8; *(u32x4*)(shm + G3_QT + i * PQ + d0 * 2) = qp[j];
            if ((pair >> 4) > 0) { float x[8]; unpack8(qp[j], x);
                x[0] *= pj[j][0].x; x[1] *= pj[j][0].y; x[2] *= pj[j][0].z; x[3] *= pj[j][0].w; x[4] *= pj[j][1].x; x[5] *= pj[j][1].y; x[6] *= pj[j][1].z; x[7] *= pj[j][1].w;
                *(u32x4*)(shm + G3_QT2 + i * PQ + d0 * 2) = pack8(x); } }
        { const int i = tid >> 3, s0 = (tid & 7) * 8; *(u32x4*)(shm + G3_AT + i * PA + s0 * 2) = ap; }
#pragma unroll
        for (int j = 0; j < 4; ++j) { const int p = tid + 512 * j, i = p >> 5, dc = (p & 31) * 8; *(u32x4*)(shm + G3_VT + i * PV + dc * 2) = vp[j]; }
        u32x2 rw[2][4];
#pragma unroll
        for (int tb = 0; tb < 2; ++tb) { const int row = row_of(b, c, 32 * tb + r32);
#pragma unroll
            for (int g = 0; g < 4; ++g) rw[tb][g] = *(const u32x2*)(ZR + (size_t)row * 1024 + h * 256 + 32 * wave + 8 * g + 4 * hi); }
        __syncthreads();
        f32x16 acc[2] = {};
        {
#pragma unroll
            for (int ks = 0; ks < 8; ++ks) {
                const f32x2_t e0 = __builtin_amdgcn_cvt_pk_f32_fp8((int)sf[ks].x, false), e1 = __builtin_amdgcn_cvt_pk_f32_fp8((int)sf[ks].x, true), e2 = __builtin_amdgcn_cvt_pk_f32_fp8((int)sf[ks].y, false), e3 = __builtin_amdgcn_cvt_pk_f32_fp8((int)sf[ks].y, true);
                const bf16x8 sfb = __builtin_bit_cast(bf16x8, (u32x4){pk2(e0.x, e0.y), pk2(e1.x, e1.y), pk2(e2.x, e2.y), pk2(e3.x, e3.y)});
#pragma unroll
                for (int tb = 0; tb < 2; ++tb) { const bf16x8 fb = *(const LAS bf16x8*)((const LAS char*)(shm + G3_QT) + (32 * tb + r32) * PQ + (16 * ks + 8 * hi) * 2); acc[tb] = __builtin_amdgcn_mfma_f32_32x32x16_bf16(sfb, fb, acc[tb], 0, 0, 0); }
            }
            if ((pair >> 4) > 0) {
#pragma unroll
                for (int ks = 0; ks < 8; ++ks)
#pragma unroll
                    for (int tb = 0; tb < 2; ++tb) { const bf16x8 fb = *(const LAS bf16x8*)((const LAS char*)(shm + G3_QT2) + (32 * tb + r32) * PQ + (16 * ks + 8 * hi) * 2); acc[tb] = __builtin_amdgcn_mfma_f32_32x32x16_bf16(bfr[ks], fb, acc[tb], 0, 0, 0); }
            }
        }
        const bool same = ci + 1 < 8; const int pairn = same ? pair : pair + F.G; const bool more = same || pairn < NPAIR; const int bhn = pairn & 15, cn = same ? c + 1 : 8 * (pairn >> 4) + 1;
        const int b0 = b, c0 = c, h0 = h, bh0 = bh;
        if (more) { bh = bhn; c = cn; b = bh >> 2; h = bh & 3; G3_LOAD(); bh = bh0; c = c0; b = b0; h = h0; }
#pragma unroll
        for (int ks = 0; ks < 4; ++ks) {
            const bf16x8 fv = tr_frag((const LAS char*)(shm + G3_VT), PV, 32 * wave, ks, lane);
#pragma unroll
            for (int tb = 0; tb < 2; ++tb) { const bf16x8 fb = *(const LAS bf16x8*)((const LAS char*)(shm + G3_AT) + (32 * tb + r32) * PA + (16 * ks + 8 * hi) * 2); acc[tb] = __builtin_amdgcn_mfma_f32_32x32x16_bf16(fv, fb, acc[tb], 0, 0, 0); }
        }
#pragma unroll
        for (int tb = 0; tb < 2; ++tb) { float sq = 0.f;
#pragma unroll
            for (int r = 0; r < 16; ++r) sq += acc[tb][r] * acc[tb][r];
            sq += __shfl_xor(sq, 32);
            if (hi == 0) part[wave * 64 + 32 * tb + r32] = sq; }
        __syncthreads();
#pragma unroll
        for (int tb = 0; tb < 2; ++tb) {
            const int t = 32 * tb + r32; float tot = 0.f;
#pragma unroll
            for (int w = 0; w < 8; ++w) tot += part[w * 64 + t];
            const float rstd = rsqrtf(tot * (1.f / GDV) + EPS);
            const int row = row_of(b, c, t);
#pragma unroll
            for (int g = 0; g < 4; ++g) {
                const int dv = 32 * wave + 8 * g + 4 * hi; const u32x2 rwv = rw[tb][g];
                const float rv[4] = {bf2f(rwv.x & 0xffff), bf2f(rwv.x >> 16), bf2f(rwv.y & 0xffff), bf2f(rwv.y >> 16)}; float o[4];
#pragma unroll
                for (int e = 0; e < 4; ++e) o[e] = acc[tb][4 * g + e] * rstd * go[g][e] * (rv[e] * __builtin_amdgcn_rcpf(1.f + __expf(-rv[e])));
                u32x2 w; w.x = pk2(o[0], o[1]); w.y = pk2(o[2], o[3]); *(u32x2*)(OG + (size_t)row * 1024 + h * 256 + dv) = w;
            }
        }
        __syncthreads();
        if (!more) break;
        ci = same ? ci + 1 : 0; pair = pairn; bh = bhn; c = cn; b = bh >> 2; h = bh & 3;
        if (!same) G3_LOADB();
    }
#undef G3_LOAD
#undef G3_LOADB
}

template <bool FINAL>
__device__ __forceinline__ void combine_rows(const Args& args, Frame& F, const MoeTables& T, float* rs2) {
    const unsigned char* y = (const unsigned char*)(F.ws + A_Y); bf16* hb = (bf16*)(F.ws + A_HB); const unsigned* epos = (const unsigned*)(F.ws + S_EPOS); const unsigned* wtsu = (const unsigned*)(F.ws + S_WTS);
    const int gw = F.vcu * NWAVES + F.wave, NGW = F.G * NWAVES, lane = F.lane;
    const int RMAX = FINAL ? NREAL : MROWS;
#define CB_META(r_) ((lane < 2 ? epos : wtsu)[2 * (size_t)(r_) + (lane & 1)])
#define CB_LOAD(r_, m_, h_, y0_, y1_, w0_, w1_) do { if (!row_is_dummy(r_)) { \
            const unsigned e0_ = (unsigned)__builtin_amdgcn_readlane((int)m_, 0), e1_ = (unsigned)__builtin_amdgcn_readlane((int)m_, 1); \
            w0_ = Y_INV * __uint_as_float((unsigned)__builtin_amdgcn_readlane((int)m_, 2)); w1_ = Y_INV * __uint_as_float((unsigned)__builtin_amdgcn_readlane((int)m_, 3)); \
            const size_t ya_ = (size_t)T.cpre[e0_ >> 20] + (e0_ & 0xfffffu), yb_ = (size_t)T.cpre[e1_ >> 20] + (e1_ & 0xfffffu); \
            _Pragma("unroll") for (int j = 0; j < 4; ++j) { h_[j] = *(const u32x2*)(hb + (size_t)(r_) * 1024 + 4 * lane + 256 * j); \
                y0_[j] = *(const unsigned*)(y + ya_ * 1024 + 4 * lane + 256 * j); y1_[j] = *(const unsigned*)(y + yb_ * 1024 + 4 * lane + 256 * j); } } } while (0)
    u32x2 ha[4], hq[4]; unsigned ya0[4], ya1[4], yb0[4], yb1[4]; float wa0 = 0.f, wa1 = 0.f, wb0 = 0.f, wb1 = 0.f; unsigned mnext = 0u;
    if (gw < RMAX) { unsigned m0 = row_is_dummy(gw) ? 0u : CB_META(gw); CB_LOAD(gw, m0, ha, ya0, ya1, wa0, wa1); if (gw + NGW < RMAX && !row_is_dummy(gw + NGW)) mnext = CB_META(gw + NGW); }
    for (int r = gw; r < RMAX; r += NGW) {
        const int rn = r + NGW, rnn = r + 2 * NGW;
        if (rn < RMAX) CB_LOAD(rn, mnext, hq, yb0, yb1, wb0, wb1);
        if (rnn < RMAX && !row_is_dummy(rnn)) mnext = CB_META(rnn);
        if (row_is_dummy(r)) {
            if (!FINAL && lane == 0) rs2[r] = 0.f;
        } else {
            f32x4 v[4];
#pragma unroll
            for (int j = 0; j < 4; ++j) { const u32x2 q = ha[j];
                const f32x2_t a0 = __builtin_amdgcn_cvt_pk_f32_fp8((int)ya0[j], false), a1 = __builtin_amdgcn_cvt_pk_f32_fp8((int)ya0[j], true), b0 = __builtin_amdgcn_cvt_pk_f32_fp8((int)ya1[j], false), b1 = __builtin_amdgcn_cvt_pk_f32_fp8((int)ya1[j], true);
                v[j].x = bf2f(q.x & 0xffff) + (wa0 * a0.x + wa1 * b0.x); v[j].y = bf2f(q.x >> 16) + (wa0 * a0.y + wa1 * b0.y);
                v[j].z = bf2f(q.y & 0xffff) + (wa0 * a1.x + wa1 * b1.x); v[j].w = bf2f(q.y >> 16) + (wa0 * a1.y + wa1 * b1.y); }
            if (FINAL) {
#pragma unroll
                for (int j = 0; j < 4; ++j) __builtin_nontemporal_store(v[j], (f32x4*)(F.out + (size_t)r * 1024 + 4 * lane + 256 * j));
            } else {
#pragma unroll
                for (int j = 0; j < 4; ++j) { u32x2 o; o.x = pk2(v[j].x, v[j].y); o.y = pk2(v[j].z, v[j].w); *(u32x2*)(hb + (size_t)r * 1024 + 4 * lane + 256 * j) = o;
                    v[j] = (f32x4){bf2f(o.x & 0xffff), bf2f(o.x >> 16), bf2f(o.y & 0xffff), bf2f(o.y >> 16)}; }
                float sq = 0.f;
#pragma unroll
                for (int j = 0; j < 4; ++j) sq += (v[j].x * v[j].x + v[j].y * v[j].y) + (v[j].z * v[j].z + v[j].w * v[j].w);
                const float rstd = rsqrtf(wave_sum(sq) * (1.f / 1024.f) + EPS);
                if (lane == 0) rs2[r] = rstd;
            }
        }
#pragma unroll
        for (int j = 0; j < 4; ++j) { ha[j] = hq[j]; ya0[j] = yb0[j]; ya1[j] = yb1[j]; }
        wa0 = wb0; wa1 = wb1;
    }
#undef CB_META
#undef CB_LOAD
}

__device__ __forceinline__ void glr_skinny(Frame& F, const bf16* hb, const bf16* Wg, const float* rs2, float* GLR) {
    const int tid = F.tid, lane = F.lane, l15 = lane & 15, kq = lane >> 4;
    LAS unsigned char* wl = (LAS unsigned char*)F.lds + RING_OFF;
    __syncthreads();
#pragma unroll
    for (int i = 0; i < 4; ++i) { const int p = tid + 512 * i, n = p >> 7, c = (p & 127) * 16; *(LAS u32x4*)(wl + n * 2064 + c) = *(const u32x4*)((const char*)Wg + (size_t)n * 2048 + c); }
    __syncthreads();
    const int NG = MROWS / 16;
    for (int grp = F.vcu * NWAVES + F.wave; grp < NG; grp += F.G * NWAVES) {
        const bf16* ap = hb + (size_t)(16 * grp + l15) * 1024 + 8 * kq;
        f32x4 acc = {};
#pragma unroll 1
        for (int bt = 0; bt < 4; ++bt) {
            u32x4 a[8];
#pragma unroll
            for (int j = 0; j < 8; ++j) a[j] = *(const u32x4*)(ap + 32 * (8 * bt + j));
#pragma unroll
            for (int j = 0; j < 8; ++j) { const bf16x8 b = *(const LAS bf16x8*)(wl + l15 * 2064 + (8 * bt + j) * 64 + kq * 16); acc = __builtin_amdgcn_mfma_f32_16x16x32_bf16(__builtin_bit_cast(bf16x8, a[j]), b, acc, 0, 0, 0); }
        }
#pragma unroll
        for (int r = 0; r < 4; ++r) { const int row = 16 * grp + 4 * kq + r; GLR[(size_t)row * 16 + l15] = acc[r] * rs2[row]; }
    }
    __syncthreads();
}

template <class EpiF>
__device__ __forceinline__ void meta_gemm(const bf16* A, int lda, const bf16* Bt, int K, int N, Frame& F, EpiF epi) {
    if (F.vcu >= N / 32) return;
    const int lane = F.lane, wave = F.wave, l15 = lane & 15, kq = lane >> 4, kpart = wave & 3;
    const int col0 = 16 * (2 * F.vcu + (wave >> 2)), k0 = kpart * (K / 4), nks = K / 128;
    float* red = (float*)(F.lds + RING_OFF);
    f32x4 acc[4] = {};
#pragma unroll 4
    for (int s4 = 0; s4 < nks; ++s4) {
        const bf16x8 bfr = *(const bf16x8*)(Bt + (size_t)(col0 + l15) * K + k0 + 32 * s4 + 8 * kq);
#pragma unroll
        for (int rb = 0; rb < 4; ++rb) { const bf16x8 afr = *(const bf16x8*)(A + (size_t)(NREAL + rb * 64 + 48 + l15) * lda + k0 + 32 * s4 + 8 * kq); acc[rb] = __builtin_amdgcn_mfma_f32_16x16x32_bf16(afr, bfr, acc[rb], 0, 0, 0); }
    }
#pragma unroll
    for (int rb = 0; rb < 4; ++rb)
#pragma unroll
        for (int rg = 0; rg < 4; ++rg) red[(wave * 16 + rb * 4 + rg) * 64 + lane] = acc[rb][rg];
    __syncthreads();
    if (kpart == 0) {
#pragma unroll
        for (int rb = 0; rb < 4; ++rb)
#pragma unroll
            for (int rg = 0; rg < 4; ++rg) { float v = acc[rb][rg];
#pragma unroll
                for (int w = 1; w < 4; ++w) v += red[((wave + w) * 16 + rb * 4 + rg) * 64 + lane];
                epi(NREAL + rb * 64 + 48 + 4 * kq + rg, col0 + l15, v); }
    }
    __syncthreads();
}

struct MetaEpiQ { bf16* QR; const float* part;
    __device__ __forceinline__ void operator()(int row, int col, float v) const { float ss = 0.f;
#pragma unroll
        for (int i = 0; i < 12; ++i) ss += part[(size_t)row * 24 + i];
        QR[(size_t)row * 1536 + col] = (bf16)f2bf(v * rsqrtf(ss * (1.f / MLA_Q) + EPS)); } };
struct MetaEpiKV { bf16* KN; bf16* VT; const float* part;
    __device__ __forceinline__ void operator()(int row, int col, float v) const { float ss = 0.f;
#pragma unroll
        for (int i = 12; i < 20; ++i) ss += part[(size_t)row * 24 + i];
        const bf16 o = (bf16)f2bf(v * rsqrtf(ss * (1.f / MLA_KV) + EPS));
        int b, tile, r64; row_btr(row, b, tile, r64);
        if (col < 1024) { const int pn = col >> 8, bj = (col >> 7) & 1, wc = (col >> 5) & 3, head = 4 * pn + wc, d = 32 * bj + (col & 31); KN[(size_t)row * 1024 + head * 64 + d] = o; }
        else { const int hv = (col - 1024) >> 6, d = col & 63; VT[((((size_t)(b * NHEAD + hv) * NTILE + tile) * 2 + (d >> 5)) * 64 + r64) * 32 + (d & 31)] = o; } } };
struct MetaEpiRes { const float* meta; bf16* hb;
    __device__ __forceinline__ void operator()(int row, int col, float v) const { const int q = row - NREAL;
        const float sv = meta ? meta[(size_t)((q & 63) - 48) * 1024 + col] : bf2f(hb[(size_t)row * 1024 + col]); hb[(size_t)row * 1024 + col] = (bf16)f2bf(sv + v); } };

struct MetaEpiZgla { bf16* ZQK; bf16* ZV; bf16* ZR; const float* rs2;
    __device__ __forceinline__ void operator()(int row, int col, float v) const { bf16* dst = col < 1024 ? ZQK : (col < 2048 ? ZV : ZR); dst[(size_t)row * 1024 + (col & 1023)] = (bf16)f2bf(v * rs2[row]); } };

#ifndef STOP_AFTER
#define STOP_AFTER 99
#endif
constexpr int N_PHASES = 19;
__global__ void __launch_bounds__(NTHREADS, 2) fwd_kernel(const Args args) {
    extern __shared__ __attribute__((aligned(16))) unsigned char lds_raw[];
    Frame F;
    F.lds = lds_raw; F.MISC = (volatile LAS unsigned*)((LAS unsigned char*)lds_raw + MISC_OFF);
    F.tid = threadIdx.x; F.lane = F.tid & 63; F.wave = __builtin_amdgcn_readfirstlane(F.tid >> 6);
    F.G = gridDim.x; { const int bx = blockIdx.x; F.vcu = (F.G % 8 == 0) ? (bx % 8) * (F.G / 8) + bx / 8 : bx; }
    F.ws = args.ws; F.ctl = (unsigned*)(args.ws + WS_CTL); F.out = args.out;
    for (int u = F.tid; u < (LDS_BYTES - LDSCTL_OFF) / 4; u += NTHREADS) ((LAS unsigned*)((LAS unsigned char*)lds_raw + LDSCTL_OFF))[u] = 0u;
    __syncthreads();
    XcdBarrier bar = xcd_barrier_post(F.ctl + CW_BAR, F.MISC);
    const int lo = args.ph_lo, hi = args.ph_hi;
    LAS unsigned char* ldsl = (LAS unsigned char*)lds_raw + RING_OFF;
    unsigned char* ws = F.ws;
#ifndef ONLY_PHASE
#define ONLY_PHASE -1
#endif
#define IN(k) ((ONLY_PHASE < 0 || ONLY_PHASE == (k)) && lo <= (k) && (k) < hi)
#ifndef DUP_MASK
#define DUP_MASK 0
#endif
#define REP(k) _Pragma("unroll") for (int rep_ = 0; rep_ < 1 + ((DUP_MASK >> (k)) & 1); ++rep_)
#define SEAM(k) do { if (IN(k) && IN((k) + 1)) xcd_barrier(bar); } while (0)

    if (IN(0)) REP(0) { __syncthreads(); p0_prologue(args, F); } SEAM(0);
    if (IN(1)) REP(1) { __syncthreads();
        pg8::DenseSched S; S.init(MROWS, MLA_INP, F.G, (int)blockIdx.x, ws + A_HN, 1024, ws + W_MI, 1024);
        EpiZmla E{(bf16*)(ws + A_ZMLA), (float*)(ws + S_PART)};
        pg8::gemm_phase(ldsl, 1024, S, E);
        if (F.G == 256 && (int)blockIdx.x >= 387 - 256) {
            const int nw = (2 * 256 - 387) * NWAVES, lim = nw * P1_FILL_PER_WAVE < D1_ITEMS ? nw * P1_FILL_PER_WAVE : D1_ITEMS;
            def_convert<1>(args, F, ((int)blockIdx.x - (387 - 256)) * NWAVES + F.wave, nw, lim, P1_FILL_PER_WAVE); }
    } SEAM(1);
    if (IN(2)) REP(2) { __syncthreads();
        { meta_gemm((const bf16*)(ws + A_ZMLA), MLA_INP, (const bf16*)(ws + W_UQ), MLA_Q, 1536, F, MetaEpiQ{(bf16*)(ws + A_QRAW), (const float*)(ws + S_PART)});
          meta_gemm((const bf16*)(ws + A_ZMLA) + MLA_Q, MLA_INP, (const bf16*)(ws + W_UKV), MLA_KV, 2048, F, MetaEpiKV{(bf16*)(ws + A_KNRAW), (bf16*)F.out, (const float*)(ws + S_PART)}); }
        { pg8::DenseSched S; S.init(NREAL, 1536, F.G, (int)blockIdx.x, ws + A_ZMLA, MLA_INP, ws + W_UQ, MLA_Q);
          EpiQ E{(bf16*)(ws + A_QRAW), (const float*)(ws + S_PART)}; pg8::gemm_phase(ldsl, MLA_Q, S, E);
#ifdef DUP_Q
          __syncthreads(); pg8::gemm_phase(ldsl, MLA_Q, S, E);
#endif
        }
        { pg8::DenseSched S; S.init(NREAL, 2048, F.G, (int)blockIdx.x, ws + A_ZMLA + MLA_Q * 2, MLA_INP, ws + W_UKV, MLA_KV);
          EpiKV E{(bf16*)(ws + A_K), (bf16*)F.out, (const float*)(ws + S_PART), (float*)(ws + A_KNRAW), FIN(I_MGKN)}; pg8::gemm_phase(ldsl, MLA_KV, S, E);
#ifdef DUP_KV
          __syncthreads(); pg8::gemm_phase(ldsl, MLA_KV, S, E);
#endif
        }
    } SEAM(2);
    if (IN(3)) REP(3) { __syncthreads(); kprep_phase(args, F); } SEAM(3);
    if (IN(4)) REP(4) { __syncthreads(); attn_phase(args, F); } SEAM(4);
    if (IN(5)) REP(5) { __syncthreads();
        meta_gemm((const bf16*)(ws + A_O), 1024, (const bf16*)(ws + W_OM), 1024, 1024, F, MetaEpiRes{FIN(I_META), (bf16*)(ws + A_HB)});
        pg8::DenseSched S; S.init(NREAL, 1024, F.G, (int)blockIdx.x, ws + A_O, 1024, ws + W_OM, 1024);
        EpiRes E{FIN(I_X), (bf16*)(ws + A_HB)}; pg8::gemm_phase(ldsl, 1024, S, E);
    } SEAM(5);
#if STOP_AFTER >= 6
    if (IN(6)) { route_phase(args, F, 0, (const bf16*)(ws + A_HB), F.ctl + CW_CNT, (int*)(ws + S_LIST), (float*)(ws + S_WTS), (unsigned*)(ws + S_EPOS), (float*)(ws + A_RSL));
 } SEAM(6);
    if (IN(7)) REP(7) { __syncthreads();
        MoeTables T = moe_tables(F, F.ctl + CW_CNT);
        MoeSched S{T, 2, F.G, F.vcu, true, (const char*)(ws + A_HB), 1024, (const char*)(ws + W_GU), 1024, (size_t)512 * 1024 * 2, (const int*)(ws + S_LIST)};
        EpiGU E{(bf16*)(ws + A_HID), (const float*)(ws + A_RSL), T.cnt}; pg8::gemm_phase(ldsl, 1024, S, E);
        def_fill_idle<7>(args, F, (int)T.tpre[32] * 2, WD_ITEMS, P7_FILL_PER_WAVE, true);
        { const int tot = (int)T.tpre[32] * 2, maxu = (tot + F.G - 1) / F.G, thr = tot - (maxu - 1) * F.G, nfill = F.G - thr;
          if (F.vcu >= thr && nfill > 0) { int cov = nfill * NWAVES * P7_FILL2_PER_WAVE; cov = cov < GU_ITEMS ? cov : GU_ITEMS; def_convert<7>(args, F, WD_ITEMS + (F.vcu - thr) * NWAVES + F.wave, nfill * NWAVES, WD_ITEMS + cov, P7_FILL2_PER_WAVE); } }
    } SEAM(7);
    if (IN(8)) REP(8) { __syncthreads();
        MoeTables T = moe_tables(F, F.ctl + CW_CNT);
        MoeSched S{T, 4, F.G, F.vcu, false, (const char*)(ws + A_HID), 256, (const char*)(ws + W_D), 256, (size_t)1024 * 256 * 2, (const int*)(ws + S_LIST)};
        EpiDown E{(unsigned char*)(ws + A_Y), T.cnt, T.cpre}; pg8::gemm_phase(ldsl, 256, S, E);
    } SEAM(8);
#endif
#if STOP_AFTER >= 9
    if (IN(9)) { MoeTables T = moe_tables(F, F.ctl + CW_CNT); combine_rows<false>(args, F, T, (float*)(ws + S_SSQ_Q)); } SEAM(9);
#endif
#if STOP_AFTER >= 10
    if (IN(10)) REP(10) { __syncthreads();
        meta_gemm((const bf16*)(ws + A_HB), 1024, (const bf16*)(ws + W_GI), 1024, 3072, F, MetaEpiZgla{(bf16*)(ws + A_ZQK), (bf16*)(ws + A_ZV), (bf16*)(ws + A_ZR), (const float*)(ws + S_SSQ_Q)});
        pg8::DenseSched S; S.init(NREAL, 3072, F.G, (int)blockIdx.x, ws + A_HB, 1024, ws + W_GI, 1024);
        EpiZgla E{(bf16*)(ws + A_ZQK), (bf16*)(ws + A_ZV), (bf16*)(ws + A_ZR), (float*)(ws + S_GLR), (const float*)(ws + S_SSQ_Q)}; pg8::gemm_phase(ldsl, 1024, S, E);
        glr_skinny(F, (const bf16*)(ws + A_HB), (const bf16*)(ws + W_GI) + (size_t)3072 * 1024, (const float*)(ws + S_SSQ_Q), (float*)(ws + S_GLR));
    } SEAM(10);
    if (IN(11)) REP(11) { __syncthreads(); g1_phase(args, F); } SEAM(11);
    if (IN(12)) { g2_phase(F); } SEAM(12);
    if (IN(13)) REP(13) { __syncthreads(); g3_phase(args, F); } SEAM(13);
    if (IN(14)) {
        pg8::DenseSched S; S.init(NREAL, 1024, F.G, (int)blockIdx.x, ws + A_OG, 1024, ws + W_OG, 1024);
        EpiRes E{nullptr, (bf16*)(ws + A_HB)}; pg8::gemm_phase(ldsl, 1024, S, E);
    } SEAM(14);
#endif
#if STOP_AFTER >= 15
    if (IN(15)) { route_phase(args, F, 1, (const bf16*)(ws + A_HB), F.ctl + CW_CNT + 32, (int*)(ws + S_LIST), (float*)(ws + S_WTS), (unsigned*)(ws + S_EPOS), (float*)(ws + A_RSL));
        { MoeTables T0 = moe_tables(F, F.ctl + CW_CNT);
          const int tot = (int)T0.tpre[32] * 2, maxu = (tot + F.G - 1) / F.G, thr = tot - (maxu - 1) * F.G, nfill = F.G - thr; int cov = nfill > 0 ? nfill * NWAVES * P7_FILL2_PER_WAVE : 0; cov = cov < GU_ITEMS ? cov : GU_ITEMS;
          def_convert<7>(args, F, WD_ITEMS + cov + F.vcu * NWAVES + F.wave, F.G * NWAVES, D7_ITEMS, 1 << 30); }
    } SEAM(15);
    if (IN(16)) REP(16) { __syncthreads();
        MoeTables T = moe_tables(F, F.ctl + CW_CNT + 32);
        MoeSched S{T, 2, F.G, F.vcu, true, (const char*)(ws + A_HB), 1024, (const char*)(ws + W_GU) + (size_t)32 * 512 * 1024 * 2, 1024, (size_t)512 * 1024 * 2, (const int*)(ws + S_LIST)};
        EpiGU E{(bf16*)(ws + A_HID), (const float*)(ws + A_RSL), T.cnt}; pg8::gemm_phase(ldsl, 1024, S, E);
        def_fill_idle<16>(args, F, (int)T.tpre[32] * 2, D16_ITEMS, P7_FILL_PER_WAVE, true);
    } SEAM(16);
    if (IN(17)) REP(17) { __syncthreads();
        MoeTables T = moe_tables(F, F.ctl + CW_CNT + 32);
        MoeSched S{T, 4, F.G, F.vcu, false, (const char*)(ws + A_HID), 256, (const char*)(ws + W_D) + (size_t)32 * 1024 * 256 * 2, 256, (size_t)1024 * 256 * 2, (const int*)(ws + S_LIST)};
        EpiDown E{(unsigned char*)(ws + A_Y), T.cnt, T.cpre}; pg8::gemm_phase(ldsl, 256, S, E);
    } SEAM(17);
    if (IN(18)) { MoeTables T = moe_tables(F, F.ctl + CW_CNT + 32); combine_rows<true>(args, F, T, nullptr); }
#endif
#undef IN
#undef SEAM
}

#ifndef N_LAUNCH_SPLIT
#define N_LAUNCH_SPLIT 0
#endif
extern "C" void kernel_launch(void* const* d_in, const int* in_sizes, int n_in, void* d_out, int out_size, void* d_ws, size_t ws_size, hipStream_t stream) {
    static int grid = 0;
    if (grid == 0) {
        if (n_in != 24 || ws_size < WS_END) { fprintf(stderr, "kernel_launch: needs 24 inputs and %zu bytes of workspace (got %d, %zu)\n", (size_t)WS_END, n_in, ws_size); grid = -1; return; }
        int dev = 0, cus = 0, per_cu = 0;
        if (hipGetDevice(&dev) != hipSuccess || hipDeviceGetAttribute(&cus, hipDeviceAttributeMultiprocessorCount, dev) != hipSuccess) { grid = -1; return; }
        if (hipFuncSetAttribute((const void*)fwd_kernel, hipFuncAttributeMaxDynamicSharedMemorySize, LDS_BYTES) != hipSuccess) { fprintf(stderr, "kernel_launch: hipFuncSetAttribute failed\n"); grid = -1; return; }
        if (hipOccupancyMaxActiveBlocksPerMultiprocessor(&per_cu, (const void*)fwd_kernel, NTHREADS, LDS_BYTES) != hipSuccess || per_cu < 1) fprintf(stderr, "kernel_launch: occupancy query says %d\n", per_cu);
        (void)hipGetLastError();
        grid = cus;
    }
    if (grid < 0) return;
    (void)hipMemsetAsync((char*)d_ws + WS_CTL, 0, CTL_ZERO_BYTES, stream);
    Args a{};
    for (int i = 0; i < 24; ++i) a.in[i] = (const float*)d_in[i];
    a.out = (float*)d_out; a.ws = (unsigned char*)d_ws;
#if N_LAUNCH_SPLIT
    for (int p = 0; p < N_PHASES; ++p) { a.ph_lo = p; a.ph_hi = p + 1; hipLaunchKernelGGL(fwd_kernel, dim3(grid), dim3(NTHREADS), LDS_BYTES, stream, a); }
#else
    a.ph_lo = 0; a.ph_hi = N_PHASES;
    hipLaunchKernelGGL(fwd_kernel, dim3(grid), dim3(NTHREADS), LDS_BYTES, stream, a);
#endif
}
```

```cpp
#include <hip/hip_runtime.h>
#include <cstdio>
#include <cstdint>

#define LAS __attribute__((address_space(3)))
#define GAS __attribute__((address_space(1)))
typedef unsigned short bf16;
typedef short bf16x8 __attribute__((ext_vector_type(8)));
typedef short s16x4 __attribute__((ext_vector_type(4)));
typedef float f32x4 __attribute__((ext_vector_type(4)));
typedef float f32x16 __attribute__((ext_vector_type(16)));
typedef unsigned u32x4 __attribute__((ext_vector_type(4)));
typedef unsigned u32x2 __attribute__((ext_vector_type(2)));
typedef GAS unsigned gu32;

constexpr int NB = 4, SEQ = 8192, DM = 1024;
constexpr int NREAL = NB * SEQ;
constexpr int MROWS = NREAL + 256;
constexpr int NTILE = 129;
constexpr int NHEAD = 16, QK = 96, NOPE = 64, ROPE = 32, VD = 64;
constexpr int MLA_Q = 384, MLA_KV = 256, MLA_IN = 672, MLA_INP = 768;
constexpr int GH = 4, GDK = 128, GDV = 256, GNK = 512, GNV = 1024, GLA_IN = 3088, GLA_INP = 3328;
constexpr int NEXP = 32, DEXP = 256;
constexpr float EPS = 1e-6f;
constexpr int NWAVES = 8, NTHREADS = 512;

__device__ __forceinline__ float bf2f(unsigned short b) { return __uint_as_float(((unsigned)b) << 16); }
__device__ __forceinline__ unsigned f2bf(float f) { unsigned u = __float_as_uint(f); return (u + 0x7fffu + ((u >> 16) & 1u)) >> 16; }
typedef float f32x2_t __attribute__((ext_vector_type(2))); typedef __bf16 bf16x2_t __attribute__((ext_vector_type(2)));
__device__ __forceinline__ unsigned pk2(float lo, float hi) { f32x2_t v = {lo, hi}; bf16x2_t b = __builtin_convertvector(v, bf16x2_t); return __builtin_bit_cast(unsigned, b); }
constexpr float KQ_SC = 0.38372263f;
__device__ __forceinline__ unsigned pk4_e4m3(float a, float b, float c, float d) {
    a = __builtin_amdgcn_fmed3f(a, -448.f, 448.f); b = __builtin_amdgcn_fmed3f(b, -448.f, 448.f); c = __builtin_amdgcn_fmed3f(c, -448.f, 448.f); d = __builtin_amdgcn_fmed3f(d, -448.f, 448.f);
    int w = 0; w = __builtin_amdgcn_cvt_pk_fp8_f32(a, b, w, false); w = __builtin_amdgcn_cvt_pk_fp8_f32(c, d, w, true); return (unsigned)w;
}
__device__ __forceinline__ unsigned pk4_bf8(float a, float b, float c, float d) { int w = 0; w = __builtin_amdgcn_cvt_pk_bf8_f32(a, b, w, false); w = __builtin_amdgcn_cvt_pk_bf8_f32(c, d, w, true); return (unsigned)w; }
__device__ __forceinline__ float max3f(float a, float b, float c) { float r; asm("v_max3_f32 %0, %1, %2, %3" : "=v"(r) : "v"(a), "v"(b), "v"(c)); return r; }
__device__ __forceinline__ float max2f(float a, float b) { float r; asm("v_max_f32_e32 %0, %1, %2" : "=v"(r) : "v"(a), "v"(b)); return r; }
__device__ __forceinline__ float wave_sum(float v) {
#pragma unroll
    for (int o = 1; o < 64; o <<= 1) v += __shfl_xor(v, o);
    return v;
}
#define LDS_WAIT() asm volatile("s_waitcnt lgkmcnt(0)" ::: "memory")
#define VM_WAIT() asm volatile("s_waitcnt vmcnt(0)" ::: "memory")

__device__ const float ROPE_INV[16] = {1.000000000e+00f, 5.623413324e-01f, 3.162277639e-01f, 1.778279394e-01f, 1.000000015e-01f, 5.623412877e-02f, 3.162277862e-02f, 1.778279431e-02f,
                                       9.999999776e-03f, 5.623413250e-03f, 3.162277862e-03f, 1.778279431e-03f, 1.000000047e-03f, 5.623413017e-04f, 3.162277862e-04f, 1.778279402e-04f};


__device__ __forceinline__ void fast_sincos(float a, float& sn, float& cs) {
    const float k = rintf(a * 0.15915494309189535f);
    float r = fmaf(-k, 6.2831854820251465f, a); r = fmaf(-k, -1.7484556e-7f, r);
    const float rev = r * 0.15915494309189535f;
    sn = __builtin_amdgcn_sinf(rev); cs = __builtin_amdgcn_cosf(rev);
}

__device__ __forceinline__ bool row_is_dummy(int r) { return r >= NREAL && ((r - NREAL) & 63) < 48; }
__device__ __forceinline__ int row_pos(int r) { return r < NREAL ? 16 + (r & (SEQ - 1)) : ((r - NREAL) & 63) - 48; }
__device__ __forceinline__ void row_btr(int r, int& b, int& tile, int& r64) {
    if (r < NREAL) { b = r >> 13; const int s = r & (SEQ - 1); tile = 1 + (s >> 6); r64 = s & 63; }
    else { const int q = r - NREAL; b = q >> 6; tile = 0; r64 = q & 63; }
}
__device__ __forceinline__ int row_of(int b, int tile, int r64) { return tile == 0 ? NREAL + b * 64 + r64 : b * SEQ + (tile - 1) * 64 + r64; }

namespace pg8 {
typedef unsigned short bf16_t;
constexpr int BM = 256, BK = 64, HALF = 128, HTB = HALF * BK * 2, STAGE_BYTES = 8 * HTB, NXCD = 8, WGM = 8;
__host__ __device__ __forceinline__ int lds_byte(int r, int c) { const int st = (r >> 4) * 2 + (c >> 5), rr = r & 15, cc = c & 31, ob = rr * 64 + cc * 2; return st * 1024 + (ob ^ (((ob >> 9) & 1) << 5)); }
__host__ __device__ __forceinline__ void stage_rc(int b, int& R, int& C) { const int st = b / 1024, sb = b % 1024, swz = sb ^ (((sb >> 9) & 1) << 5); R = (st >> 1) * 16 + swz / 64; C = (st & 1) * 32 + (swz % 64) / 2; }
__host__ __device__ __forceinline__ int perm32(int rho) { const int n = rho >> 4, i = rho & 15; return 8 * (i >> 2) + 4 * n + (i & 3); }

struct Unit { int pm, pn, e, r0; };

struct DenseSched {
    int nM, nN, nwg, G, c;
    const char* A; int lda; const char* Bt; int K;
    __device__ void init(int M, int N, int G_, int c_, const void* A_, int lda_, const void* Bt_, int K_) { nM = M / BM; nN = N / BM; nwg = nM * nN; G = G_; c = c_; A = (const char*)A_; lda = lda_; Bt = (const char*)Bt_; K = K_; }
    __device__ bool next(int i, Unit& u) const {
        const long L = (long)i * G + c; if (L >= nwg) return false;
        int wgid = (int)L; { const int q = nwg / NXCD, r = nwg % NXCD, xcd = wgid % NXCD, off = wgid / NXCD; wgid = (xcd < r ? xcd * (q + 1) : r * (q + 1) + (xcd - r) * q) + off; }
        const int nig = WGM * nN, gid = wgid / nig, fm = gid * WGM, gsz = (nM - fm) < WGM ? (nM - fm) : WGM;
        u.pm = fm + ((wgid % nig) % gsz); u.pn = (wgid % nig) / gsz; u.e = 0; u.r0 = u.pm; return true;
    }
    __device__ __forceinline__ const char* a_base() const { return A; }
    __device__ __forceinline__ unsigned a_off(const Unit& u, int r, int c_) const { return (unsigned)(((u.pm * BM + r) * lda + c_) * 2); }
    __device__ __forceinline__ const char* b_ptr(const Unit& u) const { return Bt + (size_t)u.pn * BM * K * 2; }
};

template <class Epi, class Sched>
__device__ __forceinline__ void gemm_phase(LAS unsigned char* lds, const int K, const Sched& S, const Epi& E) {
    const int tid = threadIdx.x, wid = __builtin_amdgcn_readfirstlane(tid >> 6), lane = tid & 63, wr = wid >> 2, wc = wid & 3, fr = lane & 15, fq = lane >> 4;
    const int nt = K / BK;
    int sR[2], sC[2]; unsigned voffB[2];
#pragma unroll
    for (int i = 0; i < 2; ++i) { int R, C; stage_rc(tid * 16 + i * 8192, R, C); sR[i] = R; sC[i] = C; const int Rb = Epi::PERM ? ((Epi::ADJ ? (R >> 5) * 64 : (R & ~31)) + perm32(R & 31)) : R; voffB[i] = (unsigned)(Rb * K + C) * 2u; }
    const size_t kstep = (size_t)(BK * 2);
    const size_t hstepB = (size_t)(Epi::ADJ ? 32 : HALF) * K * 2;
    const unsigned ldsw = (unsigned)wid * 1024u;
    const int aoff = lds_byte(wr * 64 + fr, fq * 8), boff = lds_byte(wc * 32 + fr, fq * 8);
#define PG8_SA(b, h) (((b) * 2 + (h)) * HTB)
#define PG8_SB(b, h) ((4 + (b) * 2 + (h)) * HTB)
#define PG8_STAGE(bufoff, gbase, voff) do { _Pragma("unroll") for (int _i = 0; _i < 2; ++_i) \
        __builtin_amdgcn_global_load_lds((const unsigned*)((const char*)(gbase) + (voff)[_i]), (LAS unsigned*)(lds + (bufoff) + ldsw + _i * 8192), 16, 0, 0); } while (0)
#define PG8_LDA(dst, b, h) do { _Pragma("unroll") for (int m = 0; m < 4; ++m) _Pragma("unroll") for (int k = 0; k < 2; ++k) dst[m][k] = *(const LAS bf16x8*)(lds + PG8_SA(b, h) + aoff + m * 2048 + k * 1024); } while (0)
#define PG8_LDB(dst, b, h) do { _Pragma("unroll") for (int n = 0; n < 2; ++n) _Pragma("unroll") for (int k = 0; k < 2; ++k) dst[n][k] = *(const LAS bf16x8*)(lds + PG8_SB(b, h) + boff + n * 2048 + k * 1024); } while (0)
#define PG8_MMA(ai, bj, At, Bt) do { __builtin_amdgcn_s_setprio(1); _Pragma("unroll") for (int m = 0; m < 4; ++m) _Pragma("unroll") for (int n = 0; n < 2; ++n) _Pragma("unroll") for (int k = 0; k < 2; ++k) \
        acc[ai][bj][m][n] = __builtin_amdgcn_mfma_f32_16x16x32_bf16(Bt[n][k], At[m][k], acc[ai][bj][m][n], 0, 0, 0); __builtin_amdgcn_s_setprio(0); } while (0)
#define PG8_WAIT_V(n) asm volatile("s_waitcnt vmcnt(" #n ")" ::: "memory")
#define PG8_WAIT_L(n) asm volatile("s_waitcnt lgkmcnt(" #n ")" ::: "memory")
#define PG8_BAR __builtin_amdgcn_s_barrier()
#define PG8_SCHED __builtin_amdgcn_sched_barrier(0)
    Unit cur, nxt; int ui = 0;
    if (!S.next(0, cur)) return;
    f32x4 acc[2][2][4][2];
#pragma unroll
    for (int a = 0; a < 2; ++a)
#pragma unroll
        for (int b = 0; b < 2; ++b)
#pragma unroll
            for (int m = 0; m < 4; ++m)
#pragma unroll
                for (int n = 0; n < 2; ++n) acc[a][b][m][n] = (f32x4){0.f, 0.f, 0.f, 0.f};
    bf16x8 At[4][2], B0[2][2], B1[2][2];
    const char* const Ab = S.a_base();
    unsigned vc0[2], vc1[2], vn0[2], vn1[2];
#pragma unroll
    for (int i = 0; i < 2; ++i) { vc0[i] = S.a_off(cur, sR[i], sC[i]); vc1[i] = S.a_off(cur, HALF + sR[i], sC[i]); }
    const char* cB = S.b_ptr(cur);
    PG8_STAGE(PG8_SB(0, 0), cB, voffB); PG8_STAGE(PG8_SB(0, 1), cB + hstepB, voffB); PG8_STAGE(PG8_SA(0, 0), Ab, vc0); PG8_STAGE(PG8_SA(0, 1), Ab, vc1);
    if (wr == 1) PG8_BAR;
    PG8_WAIT_V(2); PG8_BAR;
    PG8_STAGE(PG8_SB(1, 0), cB + kstep, voffB); PG8_STAGE(PG8_SA(1, 0), Ab + kstep, vc0); PG8_STAGE(PG8_SB(1, 1), cB + hstepB + kstep, voffB);
    PG8_WAIT_V(6); PG8_BAR;
    for (;;) {
        const bool has_next = S.next(ui + 1, nxt);
        const char* nB = has_next ? S.b_ptr(nxt) : cB;
#pragma unroll
        for (int i = 0; i < 2; ++i) { vn0[i] = has_next ? S.a_off(nxt, sR[i], sC[i]) : vc0[i]; vn1[i] = has_next ? S.a_off(nxt, HALF + sR[i], sC[i]) : vc1[i]; }
#pragma unroll 1
        for (int t = 0; t < nt; t += 2) {
            const bool last = (t == nt - 2);
            const char* a1 = Ab + (size_t)(t + 1) * kstep;
            const char* a2 = last ? Ab : Ab + (size_t)(t + 2) * kstep; const char* b2 = last ? nB : cB + (size_t)(t + 2) * kstep;
            const char* a3 = a2 + kstep; const char* b3 = b2 + kstep;
            unsigned v20[2], v21[2];
#pragma unroll
            for (int i = 0; i < 2; ++i) { v20[i] = last ? vn0[i] : vc0[i]; v21[i] = last ? vn1[i] : vc1[i]; }
            PG8_LDB(B0, 0, 0); PG8_LDB(B1, 0, 1); PG8_SCHED; PG8_LDA(At, 0, 0); PG8_STAGE(PG8_SA(1, 1), a1, vc1);
            PG8_WAIT_V(8); PG8_WAIT_L(0); PG8_BAR; PG8_MMA(0, 0, At, B0); PG8_MMA(0, 1, At, B1); PG8_BAR; PG8_SCHED;
            PG8_LDA(At, 0, 1); PG8_STAGE(PG8_SB(0, 0), b2, voffB); PG8_STAGE(PG8_SB(0, 1), b2 + hstepB, voffB); PG8_STAGE(PG8_SA(0, 0), a2, v20);
            PG8_WAIT_V(8); PG8_WAIT_L(0); PG8_BAR; PG8_MMA(1, 0, At, B0); PG8_MMA(1, 1, At, B1); PG8_BAR; PG8_SCHED;
            PG8_LDB(B0, 1, 0); PG8_LDB(B1, 1, 1); PG8_SCHED; PG8_LDA(At, 1, 0); PG8_STAGE(PG8_SA(0, 1), a2, v21);
            PG8_WAIT_V(8); PG8_WAIT_L(0); PG8_BAR; PG8_MMA(0, 0, At, B0); PG8_MMA(0, 1, At, B1); PG8_BAR; PG8_SCHED;
            PG8_LDA(At, 1, 1); PG8_STAGE(PG8_SB(1, 0), b3, voffB); PG8_STAGE(PG8_SB(1, 1), b3 + hstepB, voffB); PG8_STAGE(PG8_SA(1, 0), a3, v20);
            PG8_WAIT_V(8); PG8_WAIT_L(0); PG8_BAR; PG8_MMA(1, 0, At, B0); PG8_MMA(1, 1, At, B1); PG8_BAR; PG8_SCHED;
        }
        if (wr == 0) PG8_BAR;
        E(acc, cur, wr, wc, fr, fq);
        if (!has_next) break;
#pragma unroll
        for (int a = 0; a < 2; ++a)
#pragma unroll
            for (int b = 0; b < 2; ++b)
#pragma unroll
                for (int m = 0; m < 4; ++m)
#pragma unroll
                    for (int n = 0; n < 2; ++n) acc[a][b][m][n] = (f32x4){0.f, 0.f, 0.f, 0.f};
        cur = nxt; cB = nB; ++ui;
#pragma unroll
        for (int i = 0; i < 2; ++i) { vc0[i] = vn0[i]; vc1[i] = vn1[i]; }
        if (wr == 1) PG8_BAR;
    }
    PG8_WAIT_V(0);
    PG8_BAR;
#undef PG8_SA
#undef PG8_SB
#undef PG8_STAGE
#undef PG8_LDA
#undef PG8_LDB
#undef PG8_MMA
#undef PG8_WAIT_V
#undef PG8_WAIT_L
#undef PG8_BAR
#undef PG8_SCHED
}
}

#define XB_TMO      128
#define XB_XCNT(j)  (256  + 64 * (j))
#define XB_XSUB(j)  (1280 + 64 * (j))
#define XB_XGEN(j)  (2304 + 64 * (j))
#define XB_TOP      3328
#define XB_TOPGEN   3392
#define XCD_BAR_WORDS 3456
#define XB_SPIN_CAP (1u << 21)
__device__ __forceinline__ unsigned xb_ld(unsigned* p)              { return __hip_atomic_load(p, __ATOMIC_RELAXED, __HIP_MEMORY_SCOPE_AGENT); }
__device__ __forceinline__ unsigned xb_add(unsigned* p, unsigned v) { return __hip_atomic_fetch_add(p, v, __ATOMIC_RELAXED, __HIP_MEMORY_SCOPE_AGENT); }
__device__ __forceinline__ unsigned xb_xcc_id() { return (unsigned)__builtin_amdgcn_s_getreg((3 << 11) | 20) & 0xFu; }
#define XB_SPIN(cond, bar) do { unsigned _sp = 0; while (cond) { __builtin_amdgcn_s_sleep(1); \
    if ((++_sp & 255u) == 0u) { if (xb_ld(&(bar)[XB_TMO])) break; if (_sp > XB_SPIN_CAP) { atomicAdd(&(bar)[XB_TMO], 1u); break; } } } } while (0)
struct XcdBarrier { unsigned* bar; unsigned x; volatile LAS unsigned* st; };
__device__ __forceinline__ XcdBarrier xcd_barrier_post(unsigned* bar, volatile LAS unsigned* st) {
    XcdBarrier b; b.bar = bar; b.x = xb_xcc_id(); b.st = st;
    if (threadIdx.x == 0) (void)xb_add(&bar[XB_XCNT(b.x)], 1u);
    return b;
}
__device__ __forceinline__ void xcd_barrier_complete(unsigned* bar, unsigned x, unsigned& nloc, unsigned& nx) {
    const unsigned G = gridDim.x * gridDim.y * gridDim.z;
    unsigned sum, cnt, mine, sp = 0u;
    for (;;) {
        sum = 0u; cnt = 0u; mine = 0u;
#pragma unroll
        for (unsigned j = 0; j < 16; ++j) { const unsigned c = xb_ld(&bar[XB_XCNT(j)]); sum += c; cnt += (c > 0u) ? 1u : 0u; mine = (j == x) ? c : mine; }
        if (sum == G) break;
        __builtin_amdgcn_s_sleep(1);
        if ((++sp & 255u) == 0u) { if (xb_ld(&bar[XB_TMO])) break; if (sp > XB_SPIN_CAP) { atomicAdd(&bar[XB_TMO], 1u); break; } }
    }
    nloc = mine > 0u ? mine : 1u; nx = cnt > 0u ? cnt : 1u;
}
__device__ __forceinline__ void xcd_barrier(const XcdBarrier& b) {
    asm volatile("s_waitcnt vmcnt(0)" ::: "memory");
    __syncthreads();
    if (threadIdx.x == 0) {
        unsigned* bar = b.bar;
        __builtin_amdgcn_s_waitcnt(0);
        unsigned nloc = b.st[0], nx = b.st[1];
        if (nloc == 0u) { xcd_barrier_complete(bar, b.x, nloc, nx); b.st[0] = nloc; b.st[1] = nx; }
        const unsigned old = xb_add(&bar[XB_XSUB(b.x)], 1u);
        const unsigned gen = old / nloc;
        if (old + 1u == (gen + 1u) * nloc) {
            __builtin_amdgcn_fence(__ATOMIC_RELEASE, "agent");
            asm volatile("s_waitcnt vmcnt(0)" ::: "memory");
            const unsigned og = xb_add(&bar[XB_TOP], 1u);
            const unsigned tg = og / nx;
            if (og + 1u == (tg + 1u) * nx) xb_add(&bar[XB_TOPGEN], 1u);
            else XB_SPIN(xb_ld(&bar[XB_TOPGEN]) == tg, bar);
            __builtin_amdgcn_fence(__ATOMIC_ACQUIRE, "agent");
            xb_add(&bar[XB_XGEN(b.x)], 1u);
            asm volatile("s_waitcnt vmcnt(0)" ::: "memory");
        } else {
            XB_SPIN(xb_ld(&bar[XB_XGEN(b.x)]) == gen, bar);
            __builtin_amdgcn_fence(__ATOMIC_ACQUIRE, "agent");
            asm volatile("s_waitcnt vmcnt(0)" ::: "memory");
        }
    }
    __syncthreads();
}

constexpr size_t MiB = 1u << 20;
constexpr size_t UNIT_B = (size_t)MROWS * 1024 * 2;
constexpr size_t WS_CTL = 0, CTL_ZERO_BYTES = 64 * 1024;
constexpr int CW_TMO = 0, CW_BAR = 4096, CW_CNT = 8192;
constexpr size_t W_MI = 1 * MiB;
constexpr size_t W_UQ = W_MI + (size_t)MLA_INP * 1024 * 2;
constexpr size_t W_UKV = W_UQ + (size_t)1536 * 384 * 2;
constexpr size_t W_OM = W_UKV + (size_t)2048 * 256 * 2;
constexpr size_t W_GI = W_OM + (size_t)1024 * 1024 * 2;
constexpr size_t W_OG = W_GI + (size_t)GLA_INP * 1024 * 2;
constexpr size_t W_GU = W_OG + (size_t)1024 * 1024 * 2;
constexpr size_t W_D = W_GU + (size_t)2 * 32 * 512 * 1024 * 2;
constexpr size_t W_END = W_D + (size_t)2 * 32 * 1024 * 256 * 2;
static_assert(W_END <= 112 * MiB, "weights");
constexpr size_t S_SSQ_Q = 112 * MiB;
constexpr size_t S_SSQ_KV = S_SSQ_Q + (size_t)MROWS * 4;
constexpr size_t S_HMETA = S_SSQ_KV + (size_t)MROWS * 4;
constexpr size_t S_GLR = S_HMETA + (size_t)256 * 1024 * 4;
constexpr size_t S_GAM = S_GLR + (size_t)MROWS * 16 * 4;
constexpr size_t S_LIST = S_GAM + (size_t)NB * GH * NTILE * 128 * 4;
constexpr size_t S_WTS = S_LIST + (size_t)NEXP * MROWS * 4;
constexpr size_t S_PART = S_WTS + (size_t)2 * MROWS * 4;
constexpr size_t S_EPOS = S_PART + (size_t)MROWS * 24 * 4;
constexpr size_t S_END = S_EPOS + (size_t)2 * MROWS * 4;
static_assert(S_END <= 124 * MiB, "small buffers");
constexpr size_t ACT0 = 124 * MiB;
constexpr size_t A_HN = ACT0;
constexpr size_t A_K = ACT0;
constexpr size_t V8_OFF = (size_t)NB * NHEAD * NTILE * 8192;
constexpr size_t A_BST = ACT0 + 4 * UNIT_B;
constexpr size_t A_K0 = ACT0 + UNIT_B;
constexpr size_t A_ZMLA = ACT0 + UNIT_B * 3 / 2;
constexpr size_t A_QRAW = ACT0 + UNIT_B * 9 / 4;
constexpr size_t A_KNRAW = ACT0 + UNIT_B * 15 / 4;
constexpr size_t A_O = A_KNRAW;
constexpr size_t A_RSL = ACT0;
constexpr size_t A_HID = ACT0 + UNIT_B;
constexpr size_t A_Y = ACT0 + 2 * UNIT_B;
constexpr size_t A_HN2 = ACT0 + 4 * UNIT_B;
constexpr size_t A_HB = ACT0 + 5 * UNIT_B;
constexpr size_t A_ZQK = ACT0;
constexpr size_t A_ZV = ACT0 + UNIT_B;
constexpr size_t A_ZR = ACT0 + 2 * UNIT_B;
constexpr size_t A_QT = ACT0 + 3 * UNIT_B;
constexpr size_t A_ATT = ACT0 + UNIT_B * 7 / 2;
constexpr size_t A_OG = ACT0;
constexpr size_t WS_END = ACT0 + 6 * UNIT_B;
static_assert(WS_END <= 512 * MiB, "workspace map");
static_assert(A_ATT + (size_t)NB * GH * NTILE * 4096 * 2 <= A_HN2, "att");
static_assert(A_HID + (size_t)74240 * 256 * 2 <= A_Y, "hid");
constexpr int HID_TILES_MAX = 290;

constexpr int RING_OFF = 0;
constexpr int LDSCTL_OFF = 139264, MISC_OFF = LDSCTL_OFF;
constexpr int LDS_BYTES = 147456;

struct Args {
    const float* in[24]; float* out; unsigned char* ws; int ph_lo, ph_hi;
};
struct Frame {
    unsigned char* lds; volatile LAS unsigned* MISC; unsigned* ctl; unsigned char* ws;
    int tid, lane, wave, vcu, G;
    float* out;
};
#define FIN(i) (args.in[i])
enum { I_X = 0, I_META, I_NMIX, I_NFFN, I_MWIN, I_MGQ, I_MWUQ, I_MGKV, I_MWUKV, I_MGQN, I_MGKN, I_MWO, I_GWIN, I_GWGU, I_GBG, I_GGOUT, I_GWO, I_RWG, I_RBG, I_RWE, I_RBE, I_EWG, I_EWU, I_EWD };

struct TrItem { const float* src; int ok; int ldw; const float* gk; int k0; bf16* dst; int Kdst; };
__device__ __forceinline__ TrItem tr_make(const float* W0, int c0, int n0v, const float* W1, int c1, int n1v, int ldw, const float* gk, int k0, bf16* dst, int Kdst, int lane) {
    const int r = lane >> 3, c4 = lane & 7; TrItem t;
    t.src = (c4 < 4 ? W0 + c0 + 4 * c4 : W1 + c1 + 4 * (c4 - 4)) + (size_t)(k0 + r) * ldw; t.ok = c4 < 4 ? (n0v > 0) : (n1v > 0); t.ldw = ldw; t.gk = gk; t.k0 = k0; t.dst = dst; t.Kdst = Kdst; return t;
}
__device__ __forceinline__ TrItem tr_make_plain(const float* W, int K, int N, const float* gk, bf16* dst, int item, int lane) {
    const int kb = item % (K / 64), nb = item / (K / 64); const int c0 = 32 * nb, c1 = c0 + 16;
    int n0v = N - c0; n0v = n0v < 0 ? 0 : (n0v > 16 ? 16 : n0v); int n1v = N - c1; n1v = n1v < 0 ? 0 : (n1v > 16 ? 16 : n1v);
    return tr_make(W, c0, n0v, W, c1, n1v, N, gk, 64 * kb, dst + (size_t)32 * nb * K, K, lane);
}
__device__ __forceinline__ void tr_load(const TrItem& t, f32x4 (&v)[8]) {
#pragma unroll
    for (int i = 0; i < 8; ++i) v[i] = t.ok ? *(const f32x4*)(t.src + (size_t)(8 * i) * t.ldw) : (f32x4){0.f, 0.f, 0.f, 0.f};
}
__device__ __forceinline__ void tr_finish(const TrItem& t, const f32x4 (&v)[8], float* scr, int lane) {
    const int r = lane >> 3, c4 = lane & 7;
#pragma unroll
    for (int i = 0; i < 8; ++i) { const int kk = 8 * i + r; f32x4 w = v[i]; if (t.gk) w = w * t.gk[t.k0 + kk];
        float* d = scr + kk * 33 + 4 * c4; d[0] = w.x; d[1] = w.y; d[2] = w.z; d[3] = w.w; }
    LDS_WAIT(); asm volatile("" ::: "memory");
    int c = lane & 7; asm volatile("" : "+v"(c));
#pragma unroll
    for (int j4 = 0; j4 < 4; ++j4) { const int n = (lane >> 3) + 8 * j4; const float* sp = scr + (8 * c) * 33 + n;
        u32x4 o; o.x = pk2(sp[0 * 33], sp[1 * 33]); o.y = pk2(sp[2 * 33], sp[3 * 33]); o.z = pk2(sp[4 * 33], sp[5 * 33]); o.w = pk2(sp[6 * 33], sp[7 * 33]);
        *(u32x4*)(t.dst + (size_t)n * t.Kdst + t.k0 + 8 * c) = o; }
    LDS_WAIT(); asm volatile("" ::: "memory");
}

template <bool FIRST, bool COMBINE, bool WRITE_HN>
__device__ __forceinline__ void norm_rows(const Args& args, Frame& F, const float* gain, bf16* hn, const bf16* y, bf16* hb) {
    const int gw = F.vcu * NWAVES + F.wave, NGW = F.G * NWAVES, lane = F.lane;
    f32x4 g4[4];
    if (WRITE_HN) {
#pragma unroll
        for (int j = 0; j < 4; ++j) g4[j] = *(const f32x4*)(gain + 4 * lane + 256 * j);
    }
    f32x4 va[4], vb[4]; u32x2 ha[4], hbq[4], ya0[4], ya1[4], yb0[4], yb1[4];
#define NR_LOAD(r_, v_, h_, y0_, y1_) do { if (!row_is_dummy(r_)) { \
            if (FIRST) { const float* src_ = (r_) < NREAL ? FIN(I_X) + (size_t)(r_) * 1024 : FIN(I_META) + (size_t)((((r_) - NREAL) & 63) - 48) * 1024; \
                _Pragma("unroll") for (int j = 0; j < 4; ++j) v_[j] = *(const f32x4*)(src_ + 4 * lane + 256 * j); } \
            else { _Pragma("unroll") for (int j = 0; j < 4; ++j) h_[j] = *(const u32x2*)(hb + (size_t)(r_) * 1024 + 4 * lane + 256 * j); } \
            if (COMBINE) { _Pragma("unroll") for (int j = 0; j < 4; ++j) { y0_[j] = *(const u32x2*)(y + (size_t)(2 * (r_)) * 1024 + 4 * lane + 256 * j); y1_[j] = *(const u32x2*)(y + (size_t)(2 * (r_) + 1) * 1024 + 4 * lane + 256 * j); } } } } while (0)
    if (gw < MROWS) NR_LOAD(gw, va, ha, ya0, ya1);
    for (int r = gw; r < MROWS; r += NGW) {
        const int rn = r + NGW;
        if (rn < MROWS) NR_LOAD(rn, vb, hbq, yb0, yb1);
        if (row_is_dummy(r)) {
            if (WRITE_HN) {
#pragma unroll
                for (int j = 0; j < 4; ++j) *(u32x2*)(hn + (size_t)r * 1024 + 4 * lane + 256 * j) = (u32x2){0u, 0u};
            }
        } else {
            f32x4 v[4];
#pragma unroll
            for (int j = 0; j < 4; ++j) { if (FIRST) v[j] = va[j]; else { const u32x2 q = ha[j]; v[j] = (f32x4){bf2f(q.x & 0xffff), bf2f(q.x >> 16), bf2f(q.y & 0xffff), bf2f(q.y >> 16)}; } }
            if (COMBINE) {
#pragma unroll
                for (int j = 0; j < 4; ++j) { const u32x2 a = ya0[j], b = ya1[j];
                    v[j].x += bf2f(a.x & 0xffff) + bf2f(b.x & 0xffff); v[j].y += bf2f(a.x >> 16) + bf2f(b.x >> 16);
                    v[j].z += bf2f(a.y & 0xffff) + bf2f(b.y & 0xffff); v[j].w += bf2f(a.y >> 16) + bf2f(b.y >> 16); }
#pragma unroll
                for (int j = 0; j < 4; ++j) { u32x2 o; o.x = pk2(v[j].x, v[j].y); o.y = pk2(v[j].z, v[j].w); *(u32x2*)(hb + (size_t)r * 1024 + 4 * lane + 256 * j) = o;
                    v[j] = (f32x4){bf2f(o.x & 0xffff), bf2f(o.x >> 16), bf2f(o.y & 0xffff), bf2f(o.y >> 16)}; }
            }
            if (WRITE_HN) {
                float s = 0.f;
#pragma unroll
                for (int j = 0; j < 4; ++j) s += (v[j].x * v[j].x + v[j].y * v[j].y) + (v[j].z * v[j].z + v[j].w * v[j].w);
                const float rstd = rsqrtf(wave_sum(s) * (1.f / 1024.f) + EPS);
#pragma unroll
                for (int j = 0; j < 4; ++j) { u32x2 o; o.x = pk2(v[j].x * rstd * g4[j].x, v[j].y * rstd * g4[j].y); o.y = pk2(v[j].z * rstd * g4[j].z, v[j].w * rstd * g4[j].w);
                    *(u32x2*)(hn + (size_t)r * 1024 + 4 * lane + 256 * j) = o; }
            }
        }
#pragma unroll
        for (int j = 0; j < 4; ++j) { va[j] = vb[j]; ha[j] = hbq[j]; ya0[j] = yb0[j]; ya1[j] = yb1[j]; }
    }
#undef NR_LOAD
}

constexpr int GU_ITEMS = 32 * 256, WD_ITEMS = 32 * 128, WGI_ITEMS = 16 * 104;
__device__ __forceinline__ TrItem gu_item(const Args& args, unsigned char* ws, int layer, int it, int lane) {
    const int le = layer * 32 + (it >> 8), q = it & 255, kb = q % 16, nb = q / 16; const int pn = nb >> 3, bj = (nb >> 2) & 1, wc = nb & 3, hc0 = 128 * pn + 64 * bj + 16 * wc;
    return tr_make(FIN(I_EWG) + (size_t)le * 1024 * 256, hc0, 16, FIN(I_EWU) + (size_t)le * 1024 * 256, hc0, 16, 256, FIN(I_NFFN) + layer * 1024, 64 * kb, (bf16*)(ws + W_GU) + ((size_t)le * 512 + 32 * nb) * 1024, 1024, lane);
}
__device__ __forceinline__ TrItem wd_item(const Args& args, unsigned char* ws, int layer, int it, int lane) {
    const int le = layer * 32 + it / 128, q = it % 128;
    return tr_make_plain(FIN(I_EWD) + (size_t)le * 256 * 1024, 256, 1024, nullptr, (bf16*)(ws + W_D) + (size_t)le * 1024 * 256, q, lane);
}
__device__ __forceinline__ TrItem wgi_item(const Args& args, unsigned char* ws, int r, int lane) {
    const int kb = r % 16, nb = r / 16; const float* W = FIN(I_GWIN); int c0, n0v, c1, n1v;
    if (nb < 64) { c0 = 32 * nb; n0v = 16; c1 = c0 + 16; n1v = 16; }
    else if (nb < 96) { c0 = 2064 + 32 * (nb - 64); n0v = 16; c1 = c0 + 16; n1v = 16; }
    else if (nb == 96) { c0 = 2048; n0v = 16; c1 = 0; n1v = 0; }
    else { c0 = 0; n0v = 0; c1 = 0; n1v = 0; }
    return tr_make(W, c0, n0v, W, c1, n1v, GLA_IN, FIN(I_NMIX) + 1024, 64 * kb, (bf16*)(ws + W_GI) + (size_t)32 * nb * 1024, 1024, lane);
}
constexpr int D1_ITEMS = GU_ITEMS + WGI_ITEMS, D7_ITEMS = WD_ITEMS + GU_ITEMS, D16_ITEMS = WD_ITEMS;
template <int SET> __device__ __forceinline__ TrItem def_item(const Args& args, unsigned char* ws, int it, int lane) {
    if (SET == 1) return it < GU_ITEMS ? gu_item(args, ws, 0, it, lane) : wgi_item(args, ws, it - GU_ITEMS, lane);
    if (SET == 7) return it < WD_ITEMS ? wd_item(args, ws, 0, it, lane) : gu_item(args, ws, 1, it - WD_ITEMS, lane);
    return wd_item(args, ws, 1, it, lane);
}
template <int SET> __device__ __forceinline__ void def_convert(const Args& args, Frame& F, int first, int stride, int limit, int maxn) {
    float* scr = (float*)(F.lds + RING_OFF + F.wave * 16384); const int lane = F.lane;
    if (first >= limit || maxn <= 0) return;
    TrItem cur = def_item<SET>(args, F.ws, first, lane); f32x4 va[8]; tr_load(cur, va);
    int n = 1;
    for (int it = first; ; ) {
        const int nx = it + stride; const bool more = nx < limit && n < maxn; TrItem nxt = cur; f32x4 vb[8];
        if (more) { nxt = def_item<SET>(args, F.ws, nx, lane); tr_load(nxt, vb); }
        tr_finish(cur, va, scr, lane);
        if (!more) break;
#pragma unroll
        for (int i = 0; i < 8; ++i) va[i] = vb[i];
        cur = nxt; it = nx; ++n;
    }
}
template <int SET> __device__ __forceinline__ void def_fill_idle(const Args& args, Frame& F, int tot, int nitems, int per_wave, bool rest) {
    const int maxu = (tot + F.G - 1) / F.G, thr = tot - (maxu - 1) * F.G, nfill = F.G - thr;
    int cov = nfill > 0 ? nfill * NWAVES * per_wave : 0; cov = cov < nitems ? cov : nitems;
    if (F.vcu >= thr && nfill > 0) def_convert<SET>(args, F, (F.vcu - thr) * NWAVES + F.wave, nfill * NWAVES, cov, per_wave);
    if (rest) def_convert<SET>(args, F, cov + F.vcu * NWAVES + F.wave, F.G * NWAVES, nitems, 1 << 30);
}
constexpr int P1_FILL_PER_WAVE = 10;
constexpr int P7_FILL_PER_WAVE = 4;
constexpr int P7_FILL2_PER_WAVE = 6;

__device__ __forceinline__ void p0_prologue(const Args& args, Frame& F) {
    float* scr = (float*)(F.lds + RING_OFF + F.wave * 16384);
    const int gw = F.vcu * NWAVES + F.wave, NGW = F.G * NWAVES, lane = F.lane;
    unsigned char* ws = F.ws;
    constexpr int I0 = 16 * 24, I1 = 6 * 48, I2 = 4 * 64, I3 = 16 * 32, I5 = 16 * 32;
    const int nfill1 = (F.G == 256) ? (2 * 256 - 387) * NWAVES * P1_FILL_PER_WAVE : 0;
    const int D1_COV = nfill1 < D1_ITEMS ? nfill1 : D1_ITEMS;
    const int NITEMS = I0 + I1 + I2 + I3 + I5 + (D1_ITEMS - D1_COV);
    auto make = [&](int it) -> TrItem {
        int r = it;
        if (r < I0) return tr_make_plain(FIN(I_MWIN), 1024, MLA_IN, nullptr, (bf16*)(ws + W_MI), r, lane); r -= I0;
        if (r < I1) return tr_make_plain(FIN(I_MWUQ), MLA_Q, 1536, FIN(I_MGQ), (bf16*)(ws + W_UQ), r, lane); r -= I1;
        if (r < I2) {
            const int kb = r % 4, nb = r / 4; int c0;
            if (nb < 32) { const int pn = nb >> 3, bj = (nb >> 2) & 1, wc = nb & 3; c0 = (4 * pn + wc) * 128 + 32 * bj; } else { const int j = nb - 32; c0 = (j >> 1) * 128 + 64 + 32 * (j & 1); }
            return tr_make(FIN(I_MWUKV), c0, 16, FIN(I_MWUKV), c0 + 16, 16, 2048, FIN(I_MGKV), 64 * kb, (bf16*)(ws + W_UKV) + (size_t)32 * nb * MLA_KV, MLA_KV, lane); } r -= I2;
        if (r < I3) return tr_make_plain(FIN(I_MWO), 1024, 1024, nullptr, (bf16*)(ws + W_OM), r, lane); r -= I3;
        if (r < I5) return tr_make_plain(FIN(I_GWO), 1024, 1024, nullptr, (bf16*)(ws + W_OG), r, lane); r -= I5;
        return def_item<1>(args, ws, D1_COV + r, lane);
    };
    if (gw < NITEMS) {
        TrItem cur = make(gw); f32x4 va[8]; tr_load(cur, va);
        for (int it = gw; it < NITEMS; it += NGW) {
            const int nx = it + NGW; TrItem nxt = cur; f32x4 vb[8];
            if (nx < NITEMS) { nxt = make(nx); tr_load(nxt, vb); }
            tr_finish(cur, va, scr, lane);
            if (nx < NITEMS) {
#pragma unroll
                for (int i = 0; i < 8; ++i) va[i] = vb[i];
                cur = nxt; }
        }
    }
    { unsigned* vz = (unsigned*)F.out; for (int i = blockIdx.x * NTHREADS + F.tid; i < 64 * 2 * 48 * 16; i += F.G * NTHREADS) { const int w16 = i & 15, r = (i >> 4) % 48, dh = ((i >> 4) / 48) & 1, bh = (i >> 4) / 96;
        vz[((((size_t)bh * NTILE + 0) * 2 + dh) * 64 + r) * 16 + w16] = 0u; } }
    { unsigned* hz = (unsigned*)(ws + A_HB + (size_t)NREAL * 1024 * 2); for (int i = blockIdx.x * NTHREADS + F.tid; i < 256 * 512; i += F.G * NTHREADS) { if (((i >> 9) & 63) < 48) hz[i] = 0u; } }
    norm_rows<true, false, true>(args, F, FIN(I_NMIX), (bf16*)(ws + A_HN), nullptr, (bf16*)(ws + A_HB));
}

struct EpiZmla {
    static constexpr bool PERM = true; static constexpr bool ADJ = false;
    bf16* Z; float* part;
    __device__ __forceinline__ void operator()(const f32x4 (&acc)[2][2][4][2], const pg8::Unit& u, int wr, int wc, int fr, int fq) const {
#pragma unroll
        for (int ai = 0; ai < 2; ++ai)
#pragma unroll
            for (int m = 0; m < 4; ++m) { __builtin_amdgcn_sched_barrier(0);
                const int row = u.pm * 256 + ai * 128 + wr * 64 + m * 16 + fr;
#pragma unroll
                for (int bj = 0; bj < 2; ++bj) {
                    const f32x4 v0 = acc[ai][bj][m][0], v1 = acc[ai][bj][m][1];
                    const int col = u.pn * 256 + bj * 128 + wc * 32 + 8 * fq;
                    u32x4 w; w.x = pk2(v0[0], v0[1]); w.y = pk2(v0[2], v0[3]); w.z = pk2(v1[0], v1[1]); w.w = pk2(v1[2], v1[3]);
                    *(u32x4*)(Z + (size_t)row * MLA_INP + col) = w;
                    const int cb = u.pn * 256 + bj * 128;
                    if (cb < 768) {
                        float s = (v0[0] * v0[0] + v0[1] * v0[1]) + (v0[2] * v0[2] + v0[3] * v0[3]) + (v1[0] * v1[0] + v1[1] * v1[1]) + (v1[2] * v1[2] + v1[3] * v1[3]);
                        s += __shfl_xor(s, 16); s += __shfl_xor(s, 32);
                        if (fq == 0) part[(size_t)row * 24 + (cb >> 7) * 4 + wc] = s;
                    }
                }
            }
    }
};
struct EpiQ {
    static constexpr bool PERM = true; static constexpr bool ADJ = false;
    bf16* Q; const float* ssq;
    __device__ __forceinline__ void operator()(const f32x4 (&acc)[2][2][4][2], const pg8::Unit& u, int wr, int wc, int fr, int fq) const {
        float rsv[8];
#pragma unroll
        for (int i = 0; i < 8; ++i) { const int row = u.pm * 256 + (i >> 2) * 128 + wr * 64 + (i & 3) * 16 + fr;
            const f32x4 pa = *(const f32x4*)(ssq + (size_t)row * 24), pb = *(const f32x4*)(ssq + (size_t)row * 24 + 4), pc = *(const f32x4*)(ssq + (size_t)row * 24 + 8);
            rsv[i] = rsqrtf((((pa[0] + pa[1]) + (pa[2] + pa[3])) + ((pb[0] + pb[1]) + (pb[2] + pb[3])) + ((pc[0] + pc[1]) + (pc[2] + pc[3]))) * (1.f / MLA_Q) + EPS); }
#pragma unroll
        for (int ai = 0; ai < 2; ++ai)
#pragma unroll
            for (int m = 0; m < 4; ++m) { __builtin_amdgcn_sched_barrier(0);
                const int row = u.pm * 256 + ai * 128 + wr * 64 + m * 16 + fr;
                const float rs = rsv[ai * 4 + m];
#pragma unroll
                for (int bj = 0; bj < 2; ++bj) {
                    const f32x4 v0 = acc[ai][bj][m][0] * rs, v1 = acc[ai][bj][m][1] * rs;
                    const int col = u.pn * 256 + bj * 128 + wc * 32 + 8 * fq;
                    u32x4 w; w.x = pk2(v0[0], v0[1]); w.y = pk2(v0[2], v0[3]); w.z = pk2(v1[0], v1[1]); w.w = pk2(v1[2], v1[3]);
                    *(u32x4*)(Q + (size_t)row * 1536 + col) = w;
                }
            }
    }
};
struct EpiKV {
    static constexpr bool PERM = true; static constexpr bool ADJ = false;
    bf16* KT; bf16* V; const float* ssq; float* RH; const float* gkn;
    __device__ __forceinline__ void operator()(const f32x4 (&acc)[2][2][4][2], const pg8::Unit& u, int wr, int wc, int fr, int fq) const {
        if (u.pn < 4) {
            const int head = 4 * u.pn + wc;
#pragma unroll
            for (int ai = 0; ai < 2; ++ai)
#pragma unroll
                for (int m = 0; m < 4; ++m) { __builtin_amdgcn_sched_barrier(0);
                    const int row = u.pm * 256 + ai * 128 + wr * 64 + m * 16 + fr;
                    const int b = row >> 13, sfr = row & (SEQ - 1), tile = 1 + (sfr >> 6), r64 = sfr & 63;
                    const f32x4 pa_ = *(const f32x4*)(ssq + (size_t)row * 24 + 12), pb_ = *(const f32x4*)(ssq + (size_t)row * 24 + 16); const float rs = rsqrtf((((pa_[0] + pa_[1]) + (pa_[2] + pa_[3])) + ((pb_[0] + pb_[1]) + (pb_[2] + pb_[3]))) * (1.f / MLA_KV) + EPS);
                    float sq = 0.f;
#pragma unroll
                    for (int bj = 0; bj < 2; ++bj)
#pragma unroll
                        for (int n = 0; n < 2; ++n) { const f32x4 a = acc[ai][bj][m][n]; sq += (a[0] * a[0] + a[1] * a[1]) + (a[2] * a[2] + a[3] * a[3]); }
                    sq += __shfl_xor(sq, 16); sq += __shfl_xor(sq, 32);
                    const float rh = rsqrtf((sq * rs * rs + ssq[(size_t)row * 24 + 20]) * (1.f / QK) + EPS), rr = rs * rh;
                    unsigned char* kt = (unsigned char*)KT + ((size_t)(b * NHEAD + head) * NTILE + tile) * 8192 + r64 * 16 + (fq & 1) * 8;
                    const float rk = rr * KQ_SC;
#pragma unroll
                    for (int bj = 0; bj < 2; ++bj) { const f32x4 g0 = *(const f32x4*)(gkn + 32 * bj + 8 * fq), g1 = *(const f32x4*)(gkn + 32 * bj + 8 * fq + 4);
                        const f32x4 x0 = acc[ai][bj][m][0] * g0 * rk, x1 = acc[ai][bj][m][1] * g1 * rk;
                        *(u32x2*)(kt + (2 * bj + (fq >> 1)) * 1024) = (u32x2){pk4_e4m3(x0[0], x0[1], x0[2], x0[3]), pk4_e4m3(x1[0], x1[1], x1[2], x1[3])}; }
                    if (fq == 0) RH[(size_t)row * NHEAD + head] = rh;
                }
        } else {
#pragma unroll
            for (int ai = 0; ai < 2; ++ai)
#pragma unroll
                for (int m = 0; m < 4; ++m) { __builtin_amdgcn_sched_barrier(0);
                    const int row = u.pm * 256 + ai * 128 + wr * 64 + m * 16 + fr;
                    const f32x4 pa_ = *(const f32x4*)(ssq + (size_t)row * 24 + 12), pb_ = *(const f32x4*)(ssq + (size_t)row * 24 + 16); const float rs = rsqrtf((((pa_[0] + pa_[1]) + (pa_[2] + pa_[3])) + ((pb_[0] + pb_[1]) + (pb_[2] + pb_[3]))) * (1.f / MLA_KV) + EPS);
                    const int b = row >> 13, sfr = row & (SEQ - 1), tile = 1 + (sfr >> 6), r64 = sfr & 63;
#pragma unroll
                    for (int bj = 0; bj < 2; ++bj) {
                        const f32x4 v0 = acc[ai][bj][m][0] * rs, v1 = acc[ai][bj][m][1] * rs;
                        const int colv = (u.pn - 4) * 256 + bj * 128 + wc * 32 + 8 * fq, hv = colv >> 6, d = colv & 63;
                        *(u32x2*)((unsigned char*)V + ((size_t)(b * NHEAD + hv) * NTILE + tile) * 8192 + r64 * 64 + d) = (u32x2){pk4_e4m3(v0[0], v0[1], v0[2], v0[3]), pk4_e4m3(v1[0], v1[1], v1[2], v1[3])};
                    }
                }
        }
    }
};
struct EpiRes {
    static constexpr bool PERM = true; static constexpr bool ADJ = false;
    const float* x; bf16* hb;
    __device__ __forceinline__ void operator()(const f32x4 (&acc)[2][2][4][2], const pg8::Unit& u, int wr, int wc, int fr, int fq) const {
#pragma unroll
        for (int ai = 0; ai < 2; ++ai)
#pragma unroll
            for (int m = 0; m < 4; ++m) {
                const int row = u.pm * 256 + ai * 128 + wr * 64 + m * 16 + fr;
#pragma unroll
                for (int bj = 0; bj < 2; ++bj) {
                    const int col = u.pn * 256 + bj * 128 + wc * 32 + 8 * fq;
                    f32x4 s0, s1;
                    if (x) { s0 = *(const f32x4*)(x + (size_t)row * 1024 + col); s1 = *(const f32x4*)(x + (size_t)row * 1024 + col + 4); }
                    else { const u32x4 q = *(const u32x4*)(hb + (size_t)row * 1024 + col);
                        s0 = (f32x4){bf2f(q.x & 0xffff), bf2f(q.x >> 16), bf2f(q.y & 0xffff), bf2f(q.y >> 16)}; s1 = (f32x4){bf2f(q.z & 0xffff), bf2f(q.z >> 16), bf2f(q.w & 0xffff), bf2f(q.w >> 16)}; }
                    const f32x4 v0 = s0 + acc[ai][bj][m][0], v1 = s1 + acc[ai][bj][m][1];
                    u32x4 w; w.x = pk2(v0[0], v0[1]); w.y = pk2(v0[2], v0[3]); w.z = pk2(v1[0], v1[1]); w.w = pk2(v1[2], v1[3]);
                    *(u32x4*)(hb + (size_t)row * 1024 + col) = w;
                }
            }
    }
};
struct EpiZgla {
    static constexpr bool PERM = true; static constexpr bool ADJ = false;
    bf16* ZQK; bf16* ZV; bf16* ZR; float* GLR; const float* RS2;
    __device__ __forceinline__ void operator()(const f32x4 (&acc)[2][2][4][2], const pg8::Unit& u, int wr, int wc, int fr, int fq) const {
        bf16* dst = (bf16*)((char*)ZQK + (size_t)(u.pn >> 2) * UNIT_B); const int cbase = (u.pn & 3) * 256;
        float rsv[8];
#pragma unroll
        for (int i = 0; i < 8; ++i) rsv[i] = RS2[u.pm * 256 + (i >> 2) * 128 + wr * 64 + (i & 3) * 16 + fr];
#pragma unroll
        for (int ai = 0; ai < 2; ++ai)
#pragma unroll
            for (int m = 0; m < 4; ++m) { __builtin_amdgcn_sched_barrier(0);
                const int row = u.pm * 256 + ai * 128 + wr * 64 + m * 16 + fr;
#pragma unroll
                for (int bj = 0; bj < 2; ++bj) {
                    const float rs = rsv[ai * 4 + m]; const f32x4 v0 = acc[ai][bj][m][0] * rs, v1 = acc[ai][bj][m][1] * rs;
                    const int c = bj * 128 + wc * 32 + 8 * fq;
                    if (u.pn < 12) { u32x4 w; w.x = pk2(v0[0], v0[1]); w.y = pk2(v0[2], v0[3]); w.z = pk2(v1[0], v1[1]); w.w = pk2(v1[2], v1[3]); *(u32x4*)(dst + (size_t)row * 1024 + cbase + c) = w; }
                    else if (c < 16) { *(f32x4*)(GLR + (size_t)row * 16 + c) = v0; *(f32x4*)(GLR + (size_t)row * 16 + c + 4) = v1; }
                }
            }
    }
};

struct MoeTables { volatile LAS unsigned* tpre; volatile LAS unsigned* cnt; volatile LAS unsigned* cpre; volatile LAS unsigned* t2e; };
__device__ __forceinline__ MoeTables moe_tables(Frame& F, const unsigned* gcnt) {
    MoeTables T; T.tpre = F.MISC + 16; T.cnt = F.MISC + 64; T.cpre = F.MISC + 112; T.t2e = F.MISC + 160;
    __syncthreads();
    if (F.wave == 0) {
        const int e = F.lane & 31;
        const unsigned cn = __hip_atomic_load(gcnt + e, __ATOMIC_RELAXED, __HIP_MEMORY_SCOPE_AGENT), tl = (cn + 255u) >> 8;
        unsigned st = tl, sc = cn;
#pragma unroll
        for (int dlt = 1; dlt < 32; dlt <<= 1) { const unsigned a = __shfl_up(st, dlt, 32), b = __shfl_up(sc, dlt, 32); if (e >= dlt) { st += a; sc += b; } }
        if (F.lane < 32) { T.cnt[e] = cn; T.tpre[e] = st - tl; T.cpre[e] = sc - cn; if (e == 31) { T.tpre[32] = st; T.cpre[32] = sc; }
            for (unsigned t = 0; t < tl; ++t) T.t2e[st - tl + t] = (unsigned)e | (t << 8); }
    }
    __syncthreads();
    return T;
}
struct MoeSched {
    MoeTables T; int nN, G, c; bool gather;
    const char* A; int lda; const char* Bt; int K; size_t bexp; const int* list;
    __device__ bool next(int i, pg8::Unit& u) const {
        const int total = (int)T.tpre[32] * nN; const int L = i * G + c; if (L >= total) return false;
        const int mt = L >> (nN == 4 ? 2 : 1); u.pn = L & (nN - 1); const unsigned v = T.t2e[mt];
        u.e = (int)(v & 255u); u.pm = (int)(v >> 8); u.r0 = mt; return true;
    }
    __device__ __forceinline__ const char* a_base() const { return A; }
    __device__ __forceinline__ unsigned a_off(const pg8::Unit& u, int r, int c_) const {
        if (gather) { const int pos = u.pm * 256 + r; int tok = NREAL; if (pos < (int)T.cnt[u.e]) tok = list[(size_t)u.e * MROWS + pos] >> 1; return (unsigned)((tok * lda + c_) * 2); }
        return (unsigned)(((u.r0 * 256 + r) * lda + c_) * 2);
    }
    __device__ __forceinline__ const char* b_ptr(const pg8::Unit& u) const { return Bt + (size_t)u.e * bexp + (size_t)u.pn * 256 * K * 2; }
};
struct EpiGU {
    static constexpr bool PERM = false; static constexpr bool ADJ = false;
    bf16* HID; const float* RSL; volatile LAS unsigned* cnt;
    __device__ __forceinline__ void operator()(const f32x4 (&acc)[2][2][4][2], const pg8::Unit& u, int wr, int wc, int fr, int fq) const {
        const int n_e = (int)cnt[u.e]; const float* rsp = RSL + (size_t)u.e * MROWS + u.pm * 256 + wr * 64 + fr; float rsv[8];
#pragma unroll
        for (int i = 0; i < 8; ++i) { const int off = (i >> 2) * 128 + (i & 3) * 16; rsv[i] = (u.pm * 256 + wr * 64 + fr + off < n_e) ? rsp[off] : 0.f; }
#pragma unroll
        for (int ai = 0; ai < 2; ++ai)
#pragma unroll
            for (int m = 0; m < 4; ++m) { __builtin_amdgcn_sched_barrier(0);
                const int rr = ai * 128 + wr * 64 + m * 16 + fr; const float rs = rsv[ai * 4 + m];
#pragma unroll
                for (int bj = 0; bj < 2; ++bj) {
                    const f32x4 g = acc[ai][bj][m][0] * rs, up = acc[ai][bj][m][1] * rs; float o[4];
#pragma unroll
                    for (int j = 0; j < 4; ++j) o[j] = g[j] * __builtin_amdgcn_rcpf(1.f + __expf(-g[j])) * up[j];
                    u32x2 w; w.x = pk2(o[0], o[1]); w.y = pk2(o[2], o[3]);
                    *(u32x2*)(HID + ((size_t)u.r0 * 256 + rr) * 256 + u.pn * 128 + bj * 64 + wc * 16 + 4 * fq) = w;
                }
            }
    }
};
constexpr float Y_SCALE = 32.f, Y_INV = 1.f / 32.f;
__device__ __forceinline__ unsigned pk4_fp8(const f32x4 v) {
    const float a = __builtin_amdgcn_fmed3f(v[0] * Y_SCALE, -448.f, 448.f), b = __builtin_amdgcn_fmed3f(v[1] * Y_SCALE, -448.f, 448.f), c = __builtin_amdgcn_fmed3f(v[2] * Y_SCALE, -448.f, 448.f), d = __builtin_amdgcn_fmed3f(v[3] * Y_SCALE, -448.f, 448.f);
    int w = 0; w = __builtin_amdgcn_cvt_pk_fp8_f32(a, b, w, false); w = __builtin_amdgcn_cvt_pk_fp8_f32(c, d, w, true); return (unsigned)w;
}
struct EpiDown {
    static constexpr bool PERM = true; static constexpr bool ADJ = true;
    unsigned char* Y; volatile LAS unsigned* cnt; volatile LAS unsigned* cpre;
    __device__ __forceinline__ void operator()(const f32x4 (&acc)[2][2][4][2], const pg8::Unit& u, int wr, int wc, int fr, int fq) const {
        const int n_e = (int)cnt[u.e]; const size_t base = (size_t)cpre[u.e];
        const bool lo8 = fr < 8;
        unsigned char* const yb = Y + base * 1024 + u.pn * 256 + wc * 64 + (fr >> 3) * 32 + 8 * fq;
#pragma unroll
        for (int ai = 0; ai < 2; ++ai)
#pragma unroll
            for (int m = 0; m < 4; ++m) { __builtin_amdgcn_sched_barrier(0);
                const int pos = u.pm * 256 + ai * 128 + wr * 64 + m * 16 + (fr & 7);
                u32x2 o0, o1, snd, rcv;
                o0.x = pk4_fp8(acc[ai][0][m][0]); o0.y = pk4_fp8(acc[ai][0][m][1]); o1.x = pk4_fp8(acc[ai][1][m][0]); o1.y = pk4_fp8(acc[ai][1][m][1]);
                snd = lo8 ? o1 : o0;
#pragma unroll
                for (int k = 0; k < 2; ++k) rcv[k] = (unsigned)__builtin_amdgcn_update_dpp(0, (int)snd[k], 0x128, 0xf, 0xf, false);
                const u32x2 sa = lo8 ? o0 : rcv, sb = lo8 ? rcv : o1;
                if (pos < n_e) __builtin_nontemporal_store(sa, (u32x2*)(yb + (size_t)pos * 1024));
                if (pos + 8 < n_e) __builtin_nontemporal_store(sb, (u32x2*)(yb + (size_t)(pos + 8) * 1024));
            }
    }
};

__device__ __forceinline__ void unpack8(const u32x4 w, float (&x)[8]) {
    x[0] = bf2f(w.x & 0xffff); x[1] = bf2f(w.x >> 16); x[2] = bf2f(w.y & 0xffff); x[3] = bf2f(w.y >> 16);
    x[4] = bf2f(w.z & 0xffff); x[5] = bf2f(w.z >> 16); x[6] = bf2f(w.w & 0xffff); x[7] = bf2f(w.w >> 16);
}
__device__ __forceinline__ u32x4 pack8(const float (&x)[8]) { u32x4 w; w.x = pk2(x[0], x[1]); w.y = pk2(x[2], x[3]); w.z = pk2(x[4], x[5]); w.w = pk2(x[6], x[7]); return w; }
__device__ __forceinline__ void kprep_phase(const Args& args, Frame& F) {
    const bf16* KN = (const bf16*)(F.ws + A_KNRAW); const bf16* Z = (const bf16*)(F.ws + A_ZMLA); unsigned char* Kt = (unsigned char*)(F.ws + A_K); bf16* K0 = (bf16*)(F.ws + A_K0);
    const float* RH = (const float*)(F.ws + A_KNRAW);
    const float* gkn = FIN(I_MGKN);
    const int gw = F.vcu * NWAVES + F.wave, NGW = F.G * NWAVES, lane = F.lane;
    const u32x4 zero4 = {0u, 0u, 0u, 0u};
    for (int task = gw; task < (NREAL / 64) * NHEAD; task += NGW) {
        const int rt = task / NHEAD, h = task % NHEAD; const int row = rt * 64 + lane;
        const int b = row >> 13, sfr = row & (SEQ - 1), tile = 1 + (sfr >> 6), r64 = sfr & 63;
        u32x4 raw[4];
#pragma unroll
        for (int c = 0; c < 4; ++c) raw[c] = *(const u32x4*)(Z + (size_t)row * MLA_INP + 640 + 8 * c);
        const float rh = RH[(size_t)row * NHEAD + h] * KQ_SC;
        unsigned char* dst = Kt + ((size_t)(b * NHEAD + h) * NTILE + tile) * 8192 + r64 * 16;
        const float pos = (float)(16 + sfr);
        u32x4 c4, c5;
#pragma unroll
        for (int c = 0; c < 2; ++c) {
            float x1[8], x2[8]; unpack8(raw[c], x1); unpack8(raw[2 + c], x2);
#pragma unroll
            for (int e = 0; e < 8; ++e) { const int i = 8 * c + e; float sn, cs; fast_sincos(pos * ROPE_INV[i], sn, cs);
                const float a = x1[e] * rh * gkn[64 + i], bq = x2[e] * rh * gkn[80 + i]; x1[e] = a * cs - bq * sn; x2[e] = bq * cs + a * sn; }
            c4[2 * c] = pk4_e4m3(x1[0], x1[1], x1[2], x1[3]); c4[2 * c + 1] = pk4_e4m3(x1[4], x1[5], x1[6], x1[7]);
            c5[2 * c] = pk4_e4m3(x2[0], x2[1], x2[2], x2[3]); c5[2 * c + 1] = pk4_e4m3(x2[4], x2[5], x2[6], x2[7]); }
        *(u32x4*)(dst + 4 * 1024) = c4; *(u32x4*)(dst + 5 * 1024) = c5; *(u32x4*)(dst + 6 * 1024) = zero4; *(u32x4*)(dst + 7 * 1024) = zero4;
    }
    const int NTASK = 4 * NHEAD;
    for (int task = gw; task < NTASK; task += NGW) {
        const int rt = NREAL / 64 + task / NHEAD, h = task % NHEAD; const int row = rt * 64 + lane;
        int b, tile, r64; row_btr(row, b, tile, r64);
        u32x4 raw[12];
#pragma unroll
        for (int c = 0; c < 8; ++c) raw[c] = *(const u32x4*)(KN + (size_t)row * 1024 + h * 64 + 8 * c);
#pragma unroll
        for (int c = 0; c < 4; ++c) raw[8 + c] = *(const u32x4*)(Z + (size_t)row * MLA_INP + 640 + 8 * c);
        float ss = 0.f;
#pragma unroll
        for (int c = 0; c < 12; ++c) { float x[8]; unpack8(raw[c], x);
#pragma unroll
            for (int e = 0; e < 8; ++e) ss += x[e] * x[e]; }
        const float rstd = rsqrtf(ss * (1.f / QK) + EPS);
        bf16* dst = K0 + (size_t)(b * NHEAD + h) * (12 * 64 * 8) + r64 * 8;
        unsigned char* dst8 = Kt + ((size_t)(b * NHEAD + h) * NTILE + tile) * 8192 + r64 * 16;
#pragma unroll
        for (int c = 0; c < 8; ++c) { float x[8]; unpack8(raw[c], x);
#pragma unroll
            for (int e = 0; e < 8; ++e) x[e] *= rstd * gkn[8 * c + e];
            *(u32x4*)(dst + c * 512) = pack8(x);
            *(u32x2*)(dst8 + (c >> 1) * 1024 + (c & 1) * 8) = (u32x2){pk4_e4m3(x[0] * KQ_SC, x[1] * KQ_SC, x[2] * KQ_SC, x[3] * KQ_SC), pk4_e4m3(x[4] * KQ_SC, x[5] * KQ_SC, x[6] * KQ_SC, x[7] * KQ_SC)}; }
        const float pos = (float)row_pos(row);
#pragma unroll
        for (int c = 0; c < 2; ++c) {
            float x1[8], x2[8]; unpack8(raw[8 + c], x1); unpack8(raw[10 + c], x2);
#pragma unroll
            for (int e = 0; e < 8; ++e) { const int i = 8 * c + e; float sn, cs; fast_sincos(pos * ROPE_INV[i], sn, cs);
                const float a = x1[e] * rstd * gkn[64 + i], bq = x2[e] * rstd * gkn[80 + i]; x1[e] = a * cs - bq * sn; x2[e] = bq * cs + a * sn; }
            *(u32x4*)(dst + (8 + c) * 512) = pack8(x1); *(u32x4*)(dst + (10 + c) * 512) = pack8(x2);
            *(u32x2*)(dst8 + 4 * 1024 + c * 8) = (u32x2){pk4_e4m3(x1[0] * KQ_SC, x1[1] * KQ_SC, x1[2] * KQ_SC, x1[3] * KQ_SC), pk4_e4m3(x1[4] * KQ_SC, x1[5] * KQ_SC, x1[6] * KQ_SC, x1[7] * KQ_SC)};
            *(u32x2*)(dst8 + 5 * 1024 + c * 8) = (u32x2){pk4_e4m3(x2[0] * KQ_SC, x2[1] * KQ_SC, x2[2] * KQ_SC, x2[3] * KQ_SC), pk4_e4m3(x2[4] * KQ_SC, x2[5] * KQ_SC, x2[6] * KQ_SC, x2[7] * KQ_SC)}; }
        *(u32x4*)(dst8 + 6 * 1024) = zero4; *(u32x4*)(dst8 + 7 * 1024) = zero4;
    }
    { const bf16* Vb = (const bf16*)F.out; unsigned char* V8 = (unsigned char*)F.out + V8_OFF;
      LAS unsigned* scr = (LAS unsigned*)((LAS unsigned char*)F.lds + RING_OFF + F.wave * 8192);
      const LAS unsigned char* scr8 = (const LAS unsigned char*)scr;
      const unsigned char* VR = (const unsigned char*)F.out;
      u32x4 raw[8];
#define KP_VLOAD(task_) do { if ((task_) % NTILE == 0) { const bf16* src_ = Vb + (size_t)(task_) * 4096 + lane * 32; \
              _Pragma("unroll") for (int q_ = 0; q_ < 8; ++q_) raw[q_] = *(const u32x4*)(src_ + (q_ >> 2) * 2048 + 8 * (q_ & 3)); } \
          else { const unsigned char* src_ = VR + (size_t)(task_) * 8192 + lane * 64; _Pragma("unroll") for (int q_ = 0; q_ < 4; ++q_) raw[q_] = *(const u32x4*)(src_ + 16 * q_); } } while (0)
      if (gw < NB * NHEAD * NTILE) KP_VLOAD(gw);
      for (int task = gw; task < NB * NHEAD * NTILE; task += NGW) {
          if (task % NTILE == 0) {
#pragma unroll
              for (int q_ = 0; q_ < 8; ++q_) { float x[8]; unpack8(raw[q_], x);
                  scr[lane * 17 + 2 * q_] = pk4_e4m3(x[0], x[1], x[2], x[3]); scr[lane * 17 + 2 * q_ + 1] = pk4_e4m3(x[4], x[5], x[6], x[7]); }
          } else {
#pragma unroll
              for (int q_ = 0; q_ < 4; ++q_) { scr[lane * 17 + 4 * q_] = raw[q_].x; scr[lane * 17 + 4 * q_ + 1] = raw[q_].y; scr[lane * 17 + 4 * q_ + 2] = raw[q_].z; scr[lane * 17 + 4 * q_ + 3] = raw[q_].w; }
          }
          if (task + NGW < NB * NHEAD * NTILE) KP_VLOAD(task + NGW);
          asm volatile("s_waitcnt lgkmcnt(0)" ::: "memory");
#pragma unroll
          for (int i = 0; i < 4; ++i) { const int cell = lane + 64 * i, dvf = 32 * (cell >> 7) + (cell & 31), hf = (cell >> 6) & 1, c = (cell >> 5) & 1;
              unsigned w[4];
#pragma unroll
              for (int j = 0; j < 4; ++j) { unsigned acc = 0u;
#pragma unroll
                  for (int e = 0; e < 4; ++e) { const int r = 4 * j + e; const int key = 32 * c + (r & 3) + 8 * (r >> 2) + 4 * hf; acc |= (unsigned)scr8[key * 68 + dvf] << (8 * e); }
                  w[j] = acc; }
              *(u32x4*)(V8 + (size_t)task * 4096 + cell * 16) = (u32x4){w[0], w[1], w[2], w[3]}; }
          asm volatile("s_waitcnt lgkmcnt(0)" ::: "memory");
      }
#undef KP_VLOAD
    }
}

__device__ __forceinline__ int crow(int r, int hi) { return (r & 3) + 8 * (r >> 2) + 4 * hi; }
__device__ __forceinline__ s16x4 vtr(const LAS char* p) { typedef short v4i16_t __attribute__((ext_vector_type(4))); return __builtin_bit_cast(s16x4, __builtin_amdgcn_ds_read_tr16_b64_v4i16((LAS v4i16_t*)p)); }
constexpr int ATT_STAGE = 20480;
__device__ __forceinline__ void glds16(const void* gsrc, unsigned lds_dst) { unsigned keep;
    asm volatile("s_mov_b32 %0, m0\n\ts_mov_b32 m0, %2\n\ts_nop 0\n\tglobal_load_lds_dwordx4 %1, off\n\ts_mov_b32 m0, %0" : "=&s"(keep) : "v"(gsrc), "s"(lds_dst) : "memory"); }

__device__ __forceinline__ void attn_unit(const Args& args, Frame& F, int bh, int qb) {
    const int lane = F.lane, r32 = lane & 31, hi = lane >> 5, wid = F.wave;
    const int b = bh >> 4, h = bh & 15;
    const bf16* QR = (const bf16*)(F.ws + A_QRAW); const bf16* Kt = (const bf16*)(F.ws + A_K0) + (size_t)bh * 6144; const bf16* Vt = (const bf16*)F.out + (size_t)bh * NTILE * 4096;
    bf16* O = (bf16*)(F.ws + A_O);
    unsigned char* shm = F.lds + RING_OFF;
    int NT, myT, qrow;
    if (qb >= 0) { NT = 4 * qb + 5; myT = 4 * qb + 1 + (wid >> 1); qrow = b * SEQ + 256 * qb + 32 * wid + r32; }
    else { NT = 1; myT = (wid == 0) ? 0 : -1; qrow = NREAL + b * 64 + 32 + r32; }
#define ATT_LOAD(t, buf) do { const bf16* ks_ = Kt + (size_t)(t) * 6144 + lane * 8; const bf16* vs_ = Vt + (size_t)(t) * 4096 + lane * 8; LAS unsigned char* d_ = (LAS unsigned char*)(shm + (buf) * ATT_STAGE); \
        __builtin_amdgcn_global_load_lds((const unsigned*)(ks_ + wid * 512), (LAS unsigned*)(d_ + wid * 1024), 16, 0, 0); \
        if (wid < 4) __builtin_amdgcn_global_load_lds((const unsigned*)(ks_ + (wid + 8) * 512), (LAS unsigned*)(d_ + (wid + 8) * 1024), 16, 0, 0); \
        __builtin_amdgcn_global_load_lds((const unsigned*)(vs_ + wid * 512), (LAS unsigned*)(d_ + 12288 + wid * 1024), 16, 0, 0); } while (0)
    ATT_LOAD(0, 0);
    bf16x8 qr[6];
    if (myT >= 0) {
        float qf[6][8];
#pragma unroll
        for (int d0 = 0; d0 < 6; ++d0) { const u32x4 w = *(const u32x4*)(QR + (size_t)qrow * 1536 + h * QK + 16 * d0 + 8 * hi);
            qf[d0][0] = bf2f(w.x & 0xffff); qf[d0][1] = bf2f(w.x >> 16); qf[d0][2] = bf2f(w.y & 0xffff); qf[d0][3] = bf2f(w.y >> 16);
            qf[d0][4] = bf2f(w.z & 0xffff); qf[d0][5] = bf2f(w.z >> 16); qf[d0][6] = bf2f(w.w & 0xffff); qf[d0][7] = bf2f(w.w >> 16); }
        float ss = 0.f;
#pragma unroll
        for (int d0 = 0; d0 < 6; ++d0)
#pragma unroll
            for (int j = 0; j < 8; ++j) ss += qf[d0][j] * qf[d0][j];
        ss += __shfl_xor(ss, 32);
        const float rstd = rsqrtf(ss * (1.f / QK) + EPS);
        const float* gqn = FIN(I_MGQN);
#pragma unroll
        for (int d0 = 0; d0 < 6; ++d0)
#pragma unroll
            for (int j = 0; j < 8; ++j) qf[d0][j] *= rstd * gqn[16 * d0 + 8 * hi + j];
        const float pos = (float)row_pos(qrow);
#pragma unroll
        for (int j = 0; j < 8; ++j) { float sn, cs; fast_sincos(pos * ROPE_INV[8 * hi + j], sn, cs); const float x1 = qf[4][j], x2 = qf[5][j]; qf[4][j] = x1 * cs - x2 * sn; qf[5][j] = x2 * cs + x1 * sn; }
        const float sc = 0.10206207261596575f * 1.4426950408889634f;
#pragma unroll
        for (int d0 = 0; d0 < 6; ++d0) { u32x4 w; w.x = pk2(qf[d0][0] * sc, qf[d0][1] * sc); w.y = pk2(qf[d0][2] * sc, qf[d0][3] * sc); w.z = pk2(qf[d0][4] * sc, qf[d0][5] * sc); w.w = pk2(qf[d0][6] * sc, qf[d0][7] * sc); qr[d0] = __builtin_bit_cast(bf16x8, w); }
    } else {
#pragma unroll
        for (int d0 = 0; d0 < 6; ++d0) qr[d0] = (bf16x8){0, 0, 0, 0, 0, 0, 0, 0};
    }
    f32x16 o0 = {}, o1 = {};
    float mhat = 0.f, lsum = 0.f;
    f32x16 negm = {};
    VM_WAIT(); __syncthreads();
    for (int t = 0; t < NT; ++t) {
        if (t + 1 < NT) ATT_LOAD(t + 1, (t + 1) & 1);
        if (t <= myT) {
            const LAS char* Kb = (const LAS char*)(shm + (t & 1) * ATT_STAGE) + hi * 1024 + r32 * 16;
            const LAS char* Vb = (const LAS char*)(shm + (t & 1) * ATT_STAGE) + 12288 + ((lane >> 4) & 1) * 32 + (lane & 3) * 8 + (4 * hi + ((lane & 15) >> 2)) * 64;
            f32x16 p0 = negm, p1 = negm;
#pragma unroll
            for (int d0 = 0; d0 < 6; ++d0) {
                const bf16x8 a0 = *(const LAS bf16x8*)(Kb + d0 * 2048), a1 = *(const LAS bf16x8*)(Kb + d0 * 2048 + 512);
                p0 = __builtin_amdgcn_mfma_f32_32x32x16_bf16(a0, qr[d0], p0, 0, 0, 0);
                p1 = __builtin_amdgcn_mfma_f32_32x32x16_bf16(a1, qr[d0], p1, 0, 0, 0);
            }
            if (t == 0) {
#pragma unroll
                for (int r = 0; r < 16; ++r) { p0[r] = -INFINITY; if (r < 8) p1[r] = -INFINITY; }
            }
            float ra = max3f(p0[0], p0[1], p1[0]), rb = max3f(p0[2], p0[3], p1[1]); ra = max3f(ra, p1[2], p1[3]);
#pragma unroll
            for (int r = 4; r < 16; r += 4) { ra = max3f(ra, p0[r], p0[r + 1]); rb = max3f(rb, p0[r + 2], p0[r + 3]); ra = max3f(ra, p1[r], p1[r + 1]); rb = max3f(rb, p1[r + 2], p1[r + 3]); }
            float rm = max2f(ra, rb);
            { auto rr = __builtin_amdgcn_permlane32_swap(__float_as_uint(rm), __float_as_uint(rm), false, false); rm = max2f(__uint_as_float(rr[0]), __uint_as_float(rr[1])); }
            if (__builtin_expect(__any(rm > 8.f), 0)) {
                const float dl = fmaxf(rm, 0.f); mhat += dl;
#pragma unroll
                for (int r = 0; r < 16; ++r) { p0[r] -= dl; p1[r] -= dl; }
#pragma unroll
                for (int r = 0; r < 16; ++r) negm[r] = -mhat;
                const float f = __builtin_amdgcn_exp2f(-dl); lsum *= f;
#pragma unroll
                for (int r = 0; r < 16; ++r) { o0[r] *= f; o1[r] *= f; }
            }
            float ps = 0.f;
#pragma unroll
            for (int r = 0; r < 16; ++r) { p0[r] = __builtin_amdgcn_exp2f(p0[r]); p1[r] = __builtin_amdgcn_exp2f(p1[r]); ps += p0[r] + p1[r]; }
            lsum += ps;
            u32x4 pw[4];
            pw[0] = (u32x4){pk2(p0[0], p0[1]), pk2(p0[2], p0[3]), pk2(p0[4], p0[5]), pk2(p0[6], p0[7])};
            pw[1] = (u32x4){pk2(p0[8], p0[9]), pk2(p0[10], p0[11]), pk2(p0[12], p0[13]), pk2(p0[14], p0[15])};
            pw[2] = (u32x4){pk2(p1[0], p1[1]), pk2(p1[2], p1[3]), pk2(p1[4], p1[5]), pk2(p1[6], p1[7])};
            pw[3] = (u32x4){pk2(p1[8], p1[9]), pk2(p1[10], p1[11]), pk2(p1[12], p1[13]), pk2(p1[14], p1[15])};
#pragma unroll
            for (int ks = 0; ks < 4; ++ks) {
                const s16x4 l0 = vtr(Vb + ks * 1024), h0 = vtr(Vb + ks * 1024 + 512), l1 = vtr(Vb + 4096 + ks * 1024), h1 = vtr(Vb + 4096 + ks * 1024 + 512);
                const bf16x8 v0 = (bf16x8){l0[0], l0[1], l0[2], l0[3], h0[0], h0[1], h0[2], h0[3]}, v1 = (bf16x8){l1[0], l1[1], l1[2], l1[3], h1[0], h1[1], h1[2], h1[3]};
                const bf16x8 pb = __builtin_bit_cast(bf16x8, pw[ks]);
                o0 = __builtin_amdgcn_mfma_f32_32x32x16_bf16(v0, pb, o0, 0, 0, 0);
                o1 = __builtin_amdgcn_mfma_f32_32x32x16_bf16(v1, pb, o1, 0, 0, 0);
            }
        }
        VM_WAIT(); __syncthreads();
    }
#undef ATT_LOAD
    if (myT >= 0) {
        lsum += __shfl_xor(lsum, 32);
        const float inv = 1.f / lsum;
        bf16* orow = O + (size_t)qrow * 1024 + h * 64;
#pragma unroll
        for (int g = 0; g < 4; ++g) {
            u32x2 w0, w1; w0.x = pk2(o0[4 * g] * inv, o0[4 * g + 1] * inv); w0.y = pk2(o0[4 * g + 2] * inv, o0[4 * g + 3] * inv);
            w1.x = pk2(o1[4 * g] * inv, o1[4 * g + 1] * inv); w1.y = pk2(o1[4 * g + 2] * inv, o1[4 * g + 3] * inv);
            *(u32x2*)(orow + 8 * g + 4 * hi) = w0; *(u32x2*)(orow + 32 + 8 * g + 4 * hi) = w1;
        }
    }
}

namespace fa {
constexpr int SLOTK = 8192, SLOTV = 4096, NSLOTK = 4, NSLOT = 3;
constexpr int LDS_K = 0, LDS_V = NSLOTK * SLOTK, LDS_WS = LDS_V + NSLOT * SLOTV, LDS_OST = LDS_WS + NWAVES * 64 * 4, LDS_BYTES_ = LDS_OST + NWAVES * 4096;
typedef int v8i_t __attribute__((ext_vector_type(8)));
typedef const LAS char* lds_cptr;
#define FA_SBAR() __builtin_amdgcn_sched_barrier(0)
#define FA_WAIT_BAR(N) asm volatile("s_waitcnt vmcnt(" #N ") lgkmcnt(0)\n\ts_barrier" ::: "memory")
__device__ __forceinline__ v8i_t kload8(lds_cptr kp, int kb, int j) {
    const u32x4 a = *(const LAS u32x4*)(kp + j * 4096 + kb * 512), b = *(const LAS u32x4*)(kp + j * 4096 + kb * 512 + 1024);
    return (v8i_t){(int)a.x, (int)a.y, (int)a.z, (int)a.w, (int)b.x, (int)b.y, (int)b.z, (int)b.w};
}
__device__ __forceinline__ void attn_unit_fast(const Args& args, Frame& F, int bh, int qb) {
    const int lane = F.lane, r32 = lane & 31, hi = lane >> 5, wid = F.wave;
    const int b = bh >> 4, h = bh & 15;
    const bf16* QR = (const bf16*)(F.ws + A_QRAW); const unsigned char* Kt = (const unsigned char*)(F.ws + A_K) + (size_t)bh * NTILE * 8192; const unsigned char* Vt = (const unsigned char*)F.out + V8_OFF + (size_t)bh * NTILE * 4096;
    bf16* O = (bf16*)(F.ws + A_O);
    char* shm = (char*)(F.lds + RING_OFF);
    const unsigned lds0 = (unsigned)(uintptr_t)shm;
    const int NT = 4 * qb + 5;
    const int qrow = b * SEQ + 256 * qb + 32 * wid + r32;
    const int myband = wid >> 1;
    float* wsf = (float*)(shm + LDS_WS) + wid * 64;
    const unsigned char* ksrc = Kt + lane * 16 + wid * 1024; const unsigned char* vsrc = Vt + (lane & 31) * 16 + wid * 512;
    const unsigned kdst = lds0 + LDS_K + wid * 1024, vdst = lds0 + LDS_V + wid * 512;
#define FA_DMA_K(t, slot) glds16(ksrc + (size_t)(t) * 8192, (unsigned)__builtin_amdgcn_readfirstlane(kdst + (slot) * SLOTK))
#define FA_DMA_V(t, slot) do { const unsigned vd_ = (unsigned)__builtin_amdgcn_readfirstlane(vdst + (slot) * SLOTV); if (lane < 32) glds16(vsrc + (size_t)(t) * 4096, vd_); } while (0)
    const lds_cptr shm3 = (lds_cptr)shm; const lds_cptr kp0 = shm3 + LDS_K + hi * 2048 + r32 * 16; const lds_cptr vp0 = shm3 + LDS_V + hi * 1024 + r32 * 16;
    v8i_t kf[4];
    FA_DMA_K(0, 0); FA_DMA_V(0, 0); FA_DMA_K(1, 1);
    v8i_t qr[2];
    {
        float qa[32], qb_[32];
        const bf16* qsrc = QR + (size_t)qrow * 1536 + h * QK;
#pragma unroll
        for (int c = 0; c < 4; ++c) { const u32x4 w = *(const u32x4*)(qsrc + 32 * hi + 8 * c), w2 = *(const u32x4*)(qsrc + 64 + 8 * c);
            qa[8 * c + 0] = bf2f(w.x & 0xffff); qa[8 * c + 1] = bf2f(w.x >> 16); qa[8 * c + 2] = bf2f(w.y & 0xffff); qa[8 * c + 3] = bf2f(w.y >> 16);
            qa[8 * c + 4] = bf2f(w.z & 0xffff); qa[8 * c + 5] = bf2f(w.z >> 16); qa[8 * c + 6] = bf2f(w.w & 0xffff); qa[8 * c + 7] = bf2f(w.w >> 16);
            qb_[8 * c + 0] = bf2f(w2.x & 0xffff); qb_[8 * c + 1] = bf2f(w2.x >> 16); qb_[8 * c + 2] = bf2f(w2.y & 0xffff); qb_[8 * c + 3] = bf2f(w2.y >> 16);
            qb_[8 * c + 4] = bf2f(w2.z & 0xffff); qb_[8 * c + 5] = bf2f(w2.z >> 16); qb_[8 * c + 6] = bf2f(w2.w & 0xffff); qb_[8 * c + 7] = bf2f(w2.w >> 16); }
        float ss = 0.f, sr = 0.f;
#pragma unroll
        for (int j = 0; j < 32; ++j) { ss += qa[j] * qa[j]; sr += qb_[j] * qb_[j]; }
        ss += __shfl_xor(ss, 32);
        const float rstd = rsqrtf((ss + sr) * (1.f / QK) + EPS) * KQ_SC;
        const float* gqn = FIN(I_MGQN);
#pragma unroll
        for (int j = 0; j < 32; ++j) { qa[j] *= rstd * gqn[32 * hi + j]; qb_[j] *= rstd * gqn[64 + j]; }
        const float pos = (float)row_pos(qrow);
#pragma unroll
        for (int j = 0; j < 16; ++j) { float sn, cs; fast_sincos(pos * ROPE_INV[j], sn, cs); const float x1 = qb_[j], x2 = qb_[16 + j]; qb_[j] = x1 * cs - x2 * sn; qb_[16 + j] = x2 * cs + x1 * sn; }
#pragma unroll
        for (int c = 0; c < 8; ++c) { qr[0][c] = (int)pk4_e4m3(qa[4 * c], qa[4 * c + 1], qa[4 * c + 2], qa[4 * c + 3]);
            const unsigned rb = pk4_e4m3(qb_[4 * c], qb_[4 * c + 1], qb_[4 * c + 2], qb_[4 * c + 3]); qr[1][c] = hi ? 0 : (int)rb; }
    }
    f32x16 o[2], o2; o[0] = f32x16{}; o[1] = f32x16{}; o2 = f32x16{};
    v8i_t ones8; { int one_ = 0x38383838; asm volatile("" : "+v"(one_)); ones8 = (v8i_t){one_, one_, one_, one_, one_, one_, one_, one_}; }
#define FA_CMASK(P0, P1, t) do { if (FA_CMASK_ON && (t) - (NT - 4) > myband) { _Pragma("unroll") for (int r = 0; r < 16; ++r) { P0[r] = -INFINITY; P1[r] = -INFINITY; } } } while (0)
    f32x16 pA0, pA1, pB0, pB1;
    int sk_cur = 0, sk_next = 1, sk_prev = 2;
#define FA_ROT() do { const int tmp_ = sk_prev; sk_prev = sk_cur; sk_cur = sk_next; sk_next = tmp_; } while (0)
    FA_DMA_K(2, 2); FA_DMA_K(3, 3);
    FA_WAIT_BAR(4);
#define FA_MF8(a, b, c) __builtin_amdgcn_mfma_scale_f32_32x32x64_f8f6f4(a, b, c, 0, 0, 0, 0, 0, 0)
    { const f32x16 z = {};
      pA0 = FA_MF8(kload8(kp0, 0, 0), qr[0], z); pA1 = FA_MF8(kload8(kp0, 1, 0), qr[0], z); pA0 = FA_MF8(kload8(kp0, 0, 1), qr[1], pA0); pA1 = FA_MF8(kload8(kp0, 1, 1), qr[1], pA1); }
#pragma unroll
    for (int r = 0; r < 16; ++r) { pA0[r] = -INFINITY; if (r < 8) pA1[r] = -INFINITY; }
#pragma unroll
    for (int r = 0; r < 16; ++r) { pA0[r] = __builtin_amdgcn_exp2f(pA0[r]); pA1[r] = __builtin_amdgcn_exp2f(pA1[r]); }
    FA_WAIT_BAR(0);
    FA_DMA_V(1, 1);
    FA_ROT();
    kf[0] = kload8(kp0 + 1 * SLOTK, 0, 0); kf[1] = kload8(kp0 + 1 * SLOTK, 1, 0);
    FA_WAIT_BAR(1);
    v8i_t vf[2], pq;
#define FA_PKW(P, B) pk2(P[B], P[B + 1])
#define FA_PAF(k) __builtin_bit_cast(bf16x8, pw##k)
#define FA_VFR(i) (bf16x8){vlo[i][0], vlo[i][1], vlo[i][2], vlo[i][3], vhi[i][0], vhi[i][1], vhi[i][2], vhi[i][3]}
#define FA_PIN(x) asm volatile("" : "+v"(x))
#define FA_GAPA(MF, A0, A1, A2, A3, W0, W1, PW) do { MF; sacc += A0; sacc += A1; sacc += A2; sacc += A3; FA_PIN(sacc); W0; W1; FA_PIN(PW); FA_SBAR(); } while (0)
#define FA_GAPA0(MF) do { MF; FA_SBAR(); } while (0)
#define FA_GAPA8(MF, A0, A1, A2, A3, A4, A5, A6, A7, W0, W1) do { MF; W0; W1; FA_SBAR(); } while (0)
#define FA_GAPB8(MF, X, B) do { MF; _Pragma("unroll") for (int e_ = 0; e_ < 8; ++e_) X[(B) + e_] = FA_EX(X[(B) + e_]); FA_PIN(X); FA_SBAR(); } while (0)
#define FA_GAPA2(MF, A0, A1, W0, W1, PW) do { MF; sacc += A0; sacc += A1; FA_PIN(sacc); W0; W1; FA_PIN(PW); FA_SBAR(); } while (0)
#define FA_GAPA4(MF, A0, A1, A2, A3) do { MF; sacc += A0; sacc += A1; sacc += A2; sacc += A3; FA_PIN(sacc); FA_SBAR(); } while (0)
#define FA_EX(v) __builtin_amdgcn_exp2f(v)
#define FA_GAPB(MF, X, B) do { MF; X[B] = FA_EX(X[B]); X[B + 1] = FA_EX(X[B + 1]); X[B + 2] = FA_EX(X[B + 2]); X[B + 3] = FA_EX(X[B + 3]); FA_PIN(X); FA_SBAR(); } while (0)
#define FA_VRD(dvb_) do { const u32x4 a_ = *(const LAS u32x4*)(vp_ + (dvb_) * 2048), b_ = *(const LAS u32x4*)(vp_ + (dvb_) * 2048 + 512); vf[dvb_] = (v8i_t){(int)a_.x, (int)a_.y, (int)a_.z, (int)a_.w, (int)b_.x, (int)b_.y, (int)b_.z, (int)b_.w}; } while (0)
#define FA_PQ(P, B) (int)pk4_bf8(P[B], P[(B) + 1], P[(B) + 2], P[(B) + 3])
#define FA_MFPV(d_) o[d_] = __builtin_amdgcn_mfma_scale_f32_32x32x64_f8f6f4(pq, vf[d_], o[d_], 1, 0, 0, 0, 0, 0)
#define FA_KRD(G, kb_, t) do { if (G) { kf[kb_] = kload8(kp0 + (((t) + 1) & 3) * SLOTK, kb_, 0); FA_SBAR(); } } while (0)
#define FA_MF(a, b, c) __builtin_amdgcn_mfma_f32_32x32x16_bf16(a, b, c, 0, 0, 0)
#define FA_KJ(kb_, t) do { kf[2 + (kb_)] = kload8(kp0 + ((t) & 3) * SLOTK, kb_, 1); FA_SBAR(); } while (0)
#define FA_STEP(C0, C1, P0, P1, t, GK, GV, GL) do { FA_SBAR(); \
    const lds_cptr vp_ = vp0 + sk_prev * SLOTV; const f32x16 z_ = {}; \
    FA_KJ(0, t); FA_KJ(1, t); \
    FA_GAPA8(C0 = FA_MF8(kf[0], qr[0], z_), P0[2], P0[3], P0[4], P0[5], P0[6], P0[7], P0[8], P0[9],         pq[0] = FA_PQ(P0, 0), pq[1] = FA_PQ(P0, 4)); \
    FA_GAPA8(C1 = FA_MF8(kf[1], qr[0], z_), P0[10], P0[11], P0[12], P0[13], P0[14], P0[15], P1[0], P1[1],   pq[2] = FA_PQ(P0, 8), pq[3] = FA_PQ(P0, 12)); \
    FA_VRD(0); FA_SBAR(); \
    FA_GAPA8(C0 = FA_MF8(kf[2], qr[1], C0), P1[2], P1[3], P1[4], P1[5], P1[6], P1[7], P1[8], P1[9],         pq[4] = FA_PQ(P1, 0), pq[5] = FA_PQ(P1, 4)); \
    FA_VRD(1); FA_SBAR(); \
    FA_GAPA8(C1 = FA_MF8(kf[3], qr[1], C1), P1[10], P1[11], P1[12], P1[13], P1[14], P1[15], 0.f, 0.f,       pq[6] = FA_PQ(P1, 8), pq[7] = FA_PQ(P1, 12)); FA_PIN(pq); \
    if (GK) { FA_DMA_K((t) + 3, ((t) + 3) & 3); } if (GV) { FA_DMA_V((t) + 1, sk_next); } \
    FA_CMASK(C0, C1, t); \
    FA_SBAR(); \
    FA_GAPB8(FA_MFPV(0), C0, 0); \
    FA_KRD(GL, 0, t); FA_GAPB8(FA_MFPV(1), C0, 8); \
    FA_KRD(GL, 1, t); FA_GAPB8(o2 = __builtin_amdgcn_mfma_scale_f32_32x32x64_f8f6f4(pq, ones8, o2, 1, 0, 0, 0, 0, 0), C1, 0); \
    FA_GAPB8((void)0, C1, 8); \
    } while (0)
#define FA_ENDW(tt) do { if ((tt) + 3 < NT) { FA_WAIT_BAR(2); } else if ((tt) + 1 < NT) { FA_WAIT_BAR(1); } else { FA_WAIT_BAR(0); } } while (0)
    int t = 1;
#define FA_CMASK_ON 0
    for (; t + 5 < NT; t += 2) {
        FA_STEP(pB0, pB1, pA0, pA1, t, true, true, true);     FA_WAIT_BAR(2); FA_ROT();
        FA_STEP(pA0, pA1, pB0, pB1, t + 1, true, true, true); FA_WAIT_BAR(2); FA_ROT();
    }
#undef FA_CMASK_ON
#define FA_CMASK_ON 1
    for (; t + 1 < NT; t += 2) {
        FA_STEP(pB0, pB1, pA0, pA1, t, (t + 3 < NT), (t + 1 < NT), (t + 1 < NT));     FA_ENDW(t);     FA_ROT();
        FA_STEP(pA0, pA1, pB0, pB1, t + 1, (t + 4 < NT), (t + 2 < NT), (t + 2 < NT)); FA_ENDW(t + 1); FA_ROT();
    }
#undef FA_CMASK_ON
    {
      pq = (v8i_t){FA_PQ(pA0, 0), FA_PQ(pA0, 4), FA_PQ(pA0, 8), FA_PQ(pA0, 12), FA_PQ(pA1, 0), FA_PQ(pA1, 4), FA_PQ(pA1, 8), FA_PQ(pA1, 12)};
      const lds_cptr vp_ = vp0 + sk_prev * SLOTV;
      FA_VRD(0); FA_VRD(1);
      FA_MFPV(0); FA_MFPV(1); o2 = __builtin_amdgcn_mfma_scale_f32_32x32x64_f8f6f4(pq, ones8, o2, 1, 0, 0, 0, 0, 0); }
    float rli[16];
#pragma unroll
    for (int r = 0; r < 16; ++r) rli[r] = __builtin_amdgcn_rcpf(o2[r]);
    bf16* Ow = O + (size_t)(b * SEQ + 256 * qb + wid * 32) * 1024 + h * 64;
    { bf16* stg = (bf16*)(shm + LDS_OST) + wid * 2048;
#pragma unroll
      for (int r = 0; r < 16; ++r) { const int orow = crow(r, hi);
#pragma unroll
          for (int d0 = 0; d0 < 2; ++d0) stg[orow * 64 + d0 * 32 + r32] = (bf16)f2bf(o[d0][r] * rli[r]); }
      asm volatile("s_waitcnt lgkmcnt(0)" ::: "memory");
#pragma unroll
      for (int i = 0; i < 4; ++i) { const int row = i * 8 + (lane >> 3), ch = lane & 7; const u32x4 v = *(const u32x4*)(stg + row * 64 + ch * 8); *(u32x4*)(Ow + (size_t)row * 1024 + ch * 8) = v; } }
    asm volatile("s_waitcnt vmcnt(0) lgkmcnt(0)\n\ts_barrier" ::: "memory");
#undef FA_DMA_K
#undef FA_DMA_V
#undef FA_CMASK
#undef FA_ROT
#undef FA_PKW
#undef FA_PAF
#undef FA_VFR
#undef FA_PIN
#undef FA_GAPA
#undef FA_GAPA0
#undef FA_GAPA8
#undef FA_MF8
#undef FA_GAPA2
#undef FA_GAPA4
#undef FA_EX
#undef FA_GAPB
#undef FA_VRD
#undef FA_PQ
#undef FA_MFPV
#undef FA_GAPB8
#undef FA_KRD
#undef FA_KJ
#undef FA_MF
#undef FA_STEP
#undef FA_ENDW
}
#undef FA_SBAR
#undef FA_WAIT_BAR
}

__device__ __forceinline__ void attn_phase(const Args& args, Frame& F) {
    const int v = F.vcu, xg = v >> 5, j32 = v & 31;
    for (int i = 0; ; ++i) {
        int bh, qb;
        if (F.G == 256) { if (i > 8 || (i == 8 && j32 >= 8)) break;
            if (i == 8) { bh = 8 * xg + j32; qb = -1; } else { bh = 8 * xg + i; qb = (i & 1) ? 31 - j32 : j32; } }
        else { const int u = blockIdx.x + i * F.G; if (u >= 64 * 33) break; bh = u / 33; qb = (u % 33) - 1; }
        if (qb >= 0) fa::attn_unit_fast(args, F, bh, qb); else attn_unit(args, F, bh, qb);
    }
}

__device__ __forceinline__ void route_phase(const Args& args, Frame& F, int layer, const bf16* hb, unsigned* gcnt, int* list, float* wts, unsigned* epos, float* rsl) {
    const int lane = F.lane, wave = F.wave, tid = F.tid, l15 = lane & 15, kq = lane >> 4;
    const float* gain = FIN(I_NFFN) + layer * 1024; const float* wrg = FIN(I_RWG) + (size_t)layer * 1024 * 4; const float* wre = FIN(I_RWE) + (size_t)layer * 1024 * 32;
    const float* brg = FIN(I_RBG) + layer * 4; const float* bre = FIN(I_RBE) + layer * 32;
    float* part_lg = (float*)(F.lds + RING_OFF);
    float* part_ss = (float*)(F.lds + RING_OFF + 49152);
    float* logit_s = (float*)(F.lds + RING_OFF + 50176);
    float* rstd_s = (float*)(F.lds + RING_OFF + 56320);
    int* dec_e = (int*)(F.lds + RING_OFF + 57344);
    float* dec_w = (float*)(F.lds + RING_OFF + 57344 + 2048);
    int* dec_rank = (int*)(F.lds + RING_OFF + 57344 + 4096);
    int* lcnt = (int*)(F.lds + RING_OFF + 57344 + 6144);
    int* lbase = (int*)(F.lds + RING_OFF + 57344 + 6144 + 128);
    float* rstd_all = (float*)(F.lds + RING_OFF + 57344 + 6144 + 256);
    const int RPB = (MROWS + F.G - 1) / F.G;
    const int r0 = blockIdx.x * RPB, r1 = (r0 + RPB < MROWS) ? r0 + RPB : MROWS;
    if (tid < 32) lcnt[tid] = 0;
    const int kbase = 128 * wave;
    bf16x8 wh[4][3], wl[4][3];
#pragma unroll
    for (int s4 = 0; s4 < 4; ++s4)
#pragma unroll
        for (int cb = 0; cb < 3; ++cb) {
            float w[8]; const int col = 16 * cb + l15;
#pragma unroll
            for (int j = 0; j < 8; ++j) { const int k = kbase + 32 * s4 + 8 * kq + j; float v = 0.f; if (col < 4) v = wrg[k * 4 + col]; else if (col < 36) v = wre[k * 32 + (col - 4)]; w[j] = v * gain[k]; }
            u32x4 ph, pl; unsigned hw[4], lw[4];
#pragma unroll
            for (int j = 0; j < 4; ++j) { const unsigned hb_ = pk2(w[2 * j], w[2 * j + 1]); hw[j] = hb_; lw[j] = pk2(w[2 * j] - bf2f(hb_ & 0xffff), w[2 * j + 1] - bf2f(hb_ >> 16)); }
            ph = (u32x4){hw[0], hw[1], hw[2], hw[3]}; pl = (u32x4){lw[0], lw[1], lw[2], lw[3]};
            wh[s4][cb] = __builtin_bit_cast(bf16x8, ph); wl[s4][cb] = __builtin_bit_cast(bf16x8, pl);
        }
    __syncthreads();
    const int ngroups = (RPB + 31) / 32;
    u32x4 xa[2][4];
    auto load_rows = [&](int g) {
#pragma unroll
        for (int rb = 0; rb < 2; ++rb) { const int lr = 32 * g + 16 * rb + l15, r = r0 + lr; const bool ok = lr < RPB && r < r1 && !row_is_dummy(r);
#pragma unroll
            for (int s4 = 0; s4 < 4; ++s4) xa[rb][s4] = ok ? *(const u32x4*)(hb + (size_t)r * 1024 + kbase + 32 * s4 + 8 * kq) : (u32x4){0u, 0u, 0u, 0u}; }
    };
    load_rows(0);
    for (int g = 0; g < ngroups; ++g) {
        u32x4 xc[2][4];
#pragma unroll
        for (int rb = 0; rb < 2; ++rb)
#pragma unroll
            for (int s4 = 0; s4 < 4; ++s4) xc[rb][s4] = xa[rb][s4];
        if (g + 1 < ngroups) load_rows(g + 1);
#pragma unroll
        for (int rb = 0; rb < 2; ++rb) {
            float ss = 0.f; f32x4 acc[3] = {};
#pragma unroll
            for (int s4 = 0; s4 < 4; ++s4) {
                const u32x4 q = xc[rb][s4]; const unsigned qw[4] = {q.x, q.y, q.z, q.w};
#pragma unroll
                for (int j = 0; j < 4; ++j) { const float a = bf2f(qw[j] & 0xffff), b = bf2f(qw[j] >> 16); ss += a * a + b * b; }
                const bf16x8 xh = __builtin_bit_cast(bf16x8, q);
#pragma unroll
                for (int cb = 0; cb < 3; ++cb) {
                    acc[cb] = __builtin_amdgcn_mfma_f32_16x16x32_bf16(xh, wh[s4][cb], acc[cb], 0, 0, 0);
                    acc[cb] = __builtin_amdgcn_mfma_f32_16x16x32_bf16(xh, wl[s4][cb], acc[cb], 0, 0, 0);
                }
            }
            ss += __shfl_xor(ss, 16); ss += __shfl_xor(ss, 32);
#pragma unroll
            for (int cb = 0; cb < 3; ++cb)
#pragma unroll
                for (int rg = 0; rg < 4; ++rg) part_lg[(wave * 32 + 16 * rb + 4 * kq + rg) * 48 + 16 * cb + l15] = acc[cb][rg];
            if (kq == 0) part_ss[wave * 32 + 16 * rb + l15] = ss;
        }
        __syncthreads();
        for (int i = tid; i < 1536; i += NTHREADS) { float a = 0.f;
#pragma unroll
            for (int w = 0; w < 8; ++w) a += part_lg[w * 1536 + i];
            logit_s[i] = a; }
        if (tid < 32) { float tot = 0.f;
#pragma unroll
            for (int w = 0; w < 8; ++w) tot += part_ss[w * 32 + tid];
            const float rstd = rsqrtf(tot * (1.f / 1024.f) + EPS); rstd_s[tid] = rstd; if (32 * g + tid < RPB) rstd_all[32 * g + tid] = rstd; }
        __syncthreads();
        if (tid < 32) {
            const int lr = 32 * g + tid, r = r0 + lr;
            if (lr < RPB) {
                int e1 = -1, e2 = -1; float w1 = 0.f, w2 = 0.f;
                if (r < r1 && !row_is_dummy(r)) {
                    const float* lg = logit_s + tid * 48; const float rs = rstd_s[tid];
                    float gl[4]; int gs = 0;
#pragma unroll
                    for (int i = 0; i < 4; ++i) gl[i] = lg[i] * rs + brg[i];
#pragma unroll
                    for (int i = 1; i < 4; ++i) if (gl[i] > gl[gs]) gs = i;
                    float den = 0.f;
#pragma unroll
                    for (int i = 0; i < 4; ++i) den += __expf(gl[i] - gl[gs]);
                    const float pg = 1.f / den;
                    float el[8]; int i1 = 0;
#pragma unroll
                    for (int i = 0; i < 8; ++i) el[i] = lg[4 + 8 * gs + i] * rs + bre[8 * gs + i];
#pragma unroll
                    for (int i = 1; i < 8; ++i) if (el[i] > el[i1]) i1 = i;
                    int i2 = (i1 == 0) ? 1 : 0;
#pragma unroll
                    for (int i = 0; i < 8; ++i) if (i != i1 && el[i] > el[i2]) i2 = i;
                    float e1v = el[0], e2v = el[0];
#pragma unroll
                    for (int i = 0; i < 8; ++i) { if (i == i1) e1v = el[i]; if (i == i2) e2v = el[i]; }
                    const float ex = __expf(e2v - e1v);
                    w1 = pg / (1.f + ex); w2 = pg * ex / (1.f + ex); e1 = 8 * gs + i1; e2 = 8 * gs + i2;
                }
                dec_e[2 * lr] = e1; dec_e[2 * lr + 1] = e2; dec_w[2 * lr] = w1; dec_w[2 * lr + 1] = w2;
                dec_rank[2 * lr] = e1 >= 0 ? atomicAdd(&lcnt[e1], 1) : 0; dec_rank[2 * lr + 1] = e2 >= 0 ? atomicAdd(&lcnt[e2], 1) : 0;
            }
        }
    }
    __syncthreads();
    if (tid < 32) lbase[tid] = (int)atomicAdd(gcnt + tid, (unsigned)lcnt[tid]);
    __syncthreads();
    for (int i = tid; i < 2 * RPB; i += NTHREADS) {
        const int e = dec_e[i]; if (e < 0) continue;
        const int slot = 2 * (r0 + (i >> 1)) + (i & 1); const int pos = lbase[e] + dec_rank[i];
        list[(size_t)e * MROWS + pos] = slot; wts[slot] = dec_w[i]; epos[slot] = ((unsigned)e << 20) | (unsigned)pos; rsl[(size_t)e * MROWS + pos] = rstd_all[i >> 1];
    }
    __syncthreads();
}

constexpr int G1_QT = 0, G1_KM = 17408, G1_KH = 34816, G1_VT = 55296, G1_BL = 92160, G1_GLR = 124928, G1_SCR = 129024;
constexpr int PQ = 272, PKH = 320, PV = 576;
__device__ __forceinline__ float logsigmoid_f(float x) { const float e = __builtin_amdgcn_exp2f(-1.4426950408889634f * fabsf(x)); return fminf(x, 0.f) - 0.6931471805599453f * __builtin_amdgcn_logf(1.f + e); }

__device__ __forceinline__ bf16x8 tr_frag(const LAS char* tile, int pitch, int col0, int ks, int lane) {
    const int hi = lane >> 5, q = (lane & 15) >> 2, p = lane & 3, h16 = (lane >> 4) & 1;
    const LAS char* a = tile + (16 * ks + 8 * hi + q) * pitch + (col0 + 16 * h16 + 4 * p) * 2;
    const s16x4 lo = vtr(a), hi4 = vtr(a + 4 * pitch);
    return (bf16x8){lo[0], lo[1], lo[2], lo[3], hi4[0], hi4[1], hi4[2], hi4[3]};
}

__device__ __forceinline__ void g1_phase(const Args& args, Frame& F) {
    const int tid = F.tid, lane = F.lane, wave = F.wave, r32 = lane & 31, hi = lane >> 5;
    unsigned char* shm = F.lds + RING_OFF;
    const bf16* ZQK = (const bf16*)(F.ws + A_ZQK); const bf16* ZV = (const bf16*)(F.ws + A_ZV); const float* GLR = (const float*)(F.ws + S_GLR);
    bf16* QT = (bf16*)(F.ws + A_QT);
    float* bL = (float*)(shm + G1_BL); float* scr = (float*)(shm + G1_SCR);
    constexpr int NPAIR = NB * GH * 16;
    int pair = blockIdx.x; if (pair >= NPAIR) return;
    int ci = 0;
    int bh = pair & 15, c = 8 * (pair >> 4), b = bh >> 2, h = bh & 3;
    f32x16 acc[4]; float pcum = 1.f;
    u32x4 qp[2], kp[2], vp[4]; f32x4 gl0 = {}, gl1 = {}; int prow[2], pd[2];
    const int tbw = wave & 1, dbw = wave >> 1;
#pragma unroll
    for (int j = 0; j < 2; ++j) { const int p = tid + 512 * j; prow[j] = p >> 4; pd[j] = (p & 15) * 8; }
#define G1_LOAD_QK(b_, c_, h_) do { _Pragma("unroll") for (int j = 0; j < 2; ++j) { const int row = row_of(b_, c_, prow[j]); const bool dz_ = (c_) == 0 && prow[j] < 48;     \
            qp[j] = dz_ ? (u32x4){0u, 0u, 0u, 0u} : *(const u32x4*)(ZQK + (size_t)row * 1024 + (h_) * 128 + pd[j]); kp[j] = dz_ ? (u32x4){0u, 0u, 0u, 0u} : *(const u32x4*)(ZQK + (size_t)row * 1024 + 512 + (h_) * 128 + pd[j]); } } while (0)
#define G1_LOAD_V(b_, c_, h_) do { _Pragma("unroll") for (int j = 0; j < 4; ++j) { const int p = tid + 512 * j, i = p >> 5, dc = (p & 31) * 8; vp[j] = ((c_) == 0 && i < 48) ? (u32x4){0u, 0u, 0u, 0u} : *(const u32x4*)(ZV + (size_t)row_of(b_, c_, i) * 1024 + (h_) * 256 + dc); } \
        { const float* gp_ = GLR + (size_t)row_of(b_, c_, 32 * tbw + r32) * 16 + 8 * hi; gl0 = *(const f32x4*)gp_; gl1 = *(const f32x4*)(gp_ + 4); } } while (0)
    G1_LOAD_V(b, c, h); G1_LOAD_QK(b, c, h);
    int wh_ = -1; bf16x8 wfh = {}, wfl = {}; float bg = 0.f;
    for (;;) {
        const int unit = bh * NTILE + c;
        bf16* ATT = (bf16*)(F.ws + A_ATT) + (size_t)unit * 4096; unsigned char* DST = (unsigned char*)F.out + (size_t)(bh * (NTILE - 1) + c) * 32768;     float* GAM = (float*)(F.ws + S_GAM) + (size_t)unit * 128;
        if (h != wh_) { const float* wgu = FIN(I_GWGU); unsigned hw[4], lw[4];
#pragma unroll
            for (int j = 0; j < 4; ++j) { const float w0 = wgu[(8 * hi + 2 * j) * GNK + h * 128 + 32 * dbw + r32], w1 = wgu[(8 * hi + 2 * j + 1) * GNK + h * 128 + 32 * dbw + r32];
                const unsigned hb_ = pk2(w0, w1); hw[j] = hb_; lw[j] = pk2(w0 - bf2f(hb_ & 0xffff), w1 - bf2f(hb_ >> 16)); }
            wfh = __builtin_bit_cast(bf16x8, (u32x4){hw[0], hw[1], hw[2], hw[3]}); wfl = __builtin_bit_cast(bf16x8, (u32x4){lw[0], lw[1], lw[2], lw[3]});
            bg = FIN(I_GBG)[h * 128 + 32 * dbw + r32]; wh_ = h; }
#pragma unroll
        for (int j = 0; j < 4; ++j) { const int p = tid + 512 * j, i = p >> 5, dc = (p & 31) * 8; *(u32x4*)(shm + G1_VT + i * PV + dc * 2) = vp[j]; }
        f32x16 gx;
        { const float gv[8] = {gl0.x, gl0.y, gl0.z, gl0.w, gl1.x, gl1.y, gl1.z, gl1.w}; unsigned hw[4], lw[4];
#pragma unroll
          for (int j = 0; j < 4; ++j) { const unsigned hb_ = pk2(gv[2 * j], gv[2 * j + 1]); hw[j] = hb_; lw[j] = pk2(gv[2 * j] - bf2f(hb_ & 0xffff), gv[2 * j + 1] - bf2f(hb_ >> 16)); }
          const bf16x8 xh = __builtin_bit_cast(bf16x8, (u32x4){hw[0], hw[1], hw[2], hw[3]}), xl = __builtin_bit_cast(bf16x8, (u32x4){lw[0], lw[1], lw[2], lw[3]});
#pragma unroll
          for (int r = 0; r < 16; ++r) gx[r] = bg;
          gx = __builtin_amdgcn_mfma_f32_32x32x16_bf16(xh, wfh, gx, 0, 0, 0); gx = __builtin_amdgcn_mfma_f32_32x32x16_bf16(xl, wfh, gx, 0, 0, 0); gx = __builtin_amdgcn_mfma_f32_32x32x16_bf16(xh, wfl, gx, 0, 0, 0); }
        const int nci = ((pair >> 4) == 15) ? 9 : 8; const bool same = ci + 1 < nci; const int pairn = same ? pair : pair + F.G; const bool more = same || pairn < NPAIR;
        const int bhn = pairn & 15, cn = same ? c + 1 : 8 * (pairn >> 4);
        if (more) G1_LOAD_V(bhn >> 2, cn, bhn & 3);
        { const int d = 32 * dbw + r32; float t0[4], t1[4];
#pragma unroll
          for (int g = 0; g < 4; ++g) { float run = 0.f;
#pragma unroll
              for (int e = 0; e < 4; ++e) { run += logsigmoid_f(gx[4 * g + e]) * (1.f / 16.f); gx[4 * g + e] = run; }
              const auto rr = __builtin_amdgcn_permlane32_swap(__float_as_uint(run), __float_as_uint(run), false, false); t0[g] = __uint_as_float(rr[0]); t1[g] = __uint_as_float(rr[1]); }
          float off[4], run = 0.f;
#pragma unroll
          for (int g = 0; g < 4; ++g) { const float o1 = run + t0[g]; off[g] = hi ? o1 : run; run = o1 + t1[g]; }
          if (tbw == 0 && hi == 0) scr[d] = run;
          __syncthreads();
          const float base = tbw ? scr[d] : 0.f;
#pragma unroll
          for (int g = 0; g < 4; ++g)
#pragma unroll
              for (int e = 0; e < 4; ++e) bL[(32 * tbw + 8 * g + 4 * hi + e) * 128 + d] = gx[4 * g + e] + (off[g] + base);
          if (tbw == 1 && hi == 0) { const float gam = __expf(run + base); scr[512 + d] = gam; pcum = (ci == 0) ? gam : pcum * gam; GAM[d] = pcum; } }
        __syncthreads();
#pragma unroll
        for (int j = 0; j < 2; ++j) {
            const int i = prow[j], d0 = pd[j]; const unsigned qw[4] = {qp[j].x, qp[j].y, qp[j].z, qp[j].w}, kw[4] = {kp[j].x, kp[j].y, kp[j].z, kp[j].w};
            float qt[8], km[8], kh[8];
#pragma unroll
            for (int e = 0; e < 8; ++e) { const float bb = bL[i * 128 + d0 + e], gam = scr[512 + d0 + e];
                const float qv = bf2f((e & 1) ? (qw[e >> 1] >> 16) : (qw[e >> 1] & 0xffff)), kv = bf2f((e & 1) ? (kw[e >> 1] >> 16) : (kw[e >> 1] & 0xffff));
                qt[e] = qv * 0.08838834764831845f * __expf(bb); km[e] = kv * __expf(-bb); kh[e] = km[e] * gam; }
            u32x4 wq, wm, wh; wq.x = pk2(qt[0], qt[1]); wq.y = pk2(qt[2], qt[3]); wq.z = pk2(qt[4], qt[5]); wq.w = pk2(qt[6], qt[7]);
            wm.x = pk2(km[0], km[1]); wm.y = pk2(km[2], km[3]); wm.z = pk2(km[4], km[5]); wm.w = pk2(km[6], km[7]);
            wh.x = pk2(kh[0], kh[1]); wh.y = pk2(kh[2], kh[3]); wh.z = pk2(kh[4], kh[5]); wh.w = pk2(kh[6], kh[7]);
            *(u32x4*)(shm + G1_QT + i * PQ + d0 * 2) = wq; *(u32x4*)(shm + G1_KM + i * PQ + d0 * 2) = wm; *(u32x4*)(shm + G1_KH + i * PKH + d0 * 2) = wh;
            *(u32x4*)(QT + (size_t)row_of(b, c, i) * 512 + h * 128 + d0) = wq;
        }
        if (more) G1_LOAD_QK(bhn >> 2, cn, bhn & 3);
        __syncthreads();
        if (wave < 4) {
            const int sb = wave & 1, tb = wave >> 1; f32x16 a = {};
            if (!(sb == 1 && tb == 0)) {
#pragma unroll
                for (int ks = 0; ks < 8; ++ks) { const bf16x8 fa = *(const LAS bf16x8*)((const LAS char*)(shm + G1_KM) + (32 * sb + r32) * PQ + (16 * ks + 8 * hi) * 2), fb = *(const LAS bf16x8*)((const LAS char*)(shm + G1_QT) + (32 * tb + r32) * PQ + (16 * ks + 8 * hi) * 2);
                    a = __builtin_amdgcn_mfma_f32_32x32x16_bf16(fa, fb, a, 0, 0, 0); }
            }
            const int t = 32 * tb + r32;
#pragma unroll
            for (int g = 0; g < 4; ++g) { const int s0 = 32 * sb + 8 * g + 4 * hi; float v[4];
#pragma unroll
                for (int e = 0; e < 4; ++e) v[e] = (s0 + e <= t) ? a[4 * g + e] : 0.f;
                u32x2 w; w.x = pk2(v[0], v[1]); w.y = pk2(v[2], v[3]); *(u32x2*)(ATT + t * 64 + s0) = w; }
        }
        if (c < NTILE - 1) {
          if (ci == 0) {
#pragma unroll
              for (int kb = 0; kb < 4; ++kb) acc[kb] = f32x16{};
          } else {
#pragma unroll
              for (int kb = 0; kb < 4; ++kb)
#pragma unroll
                  for (int g = 0; g < 4; ++g) { const f32x4 gm = *(const f32x4*)(scr + 512 + 32 * kb + 8 * g + 4 * hi); acc[kb][4 * g] *= gm.x; acc[kb][4 * g + 1] *= gm.y; acc[kb][4 * g + 2] *= gm.z; acc[kb][4 * g + 3] *= gm.w; }
          }
#pragma unroll
          for (int ks = 0; ks < 4; ++ks) {
              const bf16x8 fv = tr_frag((const LAS char*)(shm + G1_VT), PV, 32 * wave, ks, lane);
#pragma unroll
              for (int kb = 0; kb < 4; ++kb) { const bf16x8 fk = tr_frag((const LAS char*)(shm + G1_KH), PKH, 32 * kb, ks, lane); acc[kb] = __builtin_amdgcn_mfma_f32_32x32x16_bf16(fk, fv, acc[kb], 0, 0, 0); }
          }
          const int dv = 32 * wave + r32;
#pragma unroll
          for (int kb = 0; kb < 4; ++kb) {
              unsigned g0 = pk4_e4m3(acc[kb][0], acc[kb][1], acc[kb][2], acc[kb][3]), g1 = pk4_e4m3(acc[kb][4], acc[kb][5], acc[kb][6], acc[kb][7]);
              unsigned g2 = pk4_e4m3(acc[kb][8], acc[kb][9], acc[kb][10], acc[kb][11]), g3 = pk4_e4m3(acc[kb][12], acc[kb][13], acc[kb][14], acc[kb][15]);
              { const auto r = __builtin_amdgcn_permlane32_swap(g0, g2, false, false); g0 = r[0]; g2 = r[1]; }
              { const auto r = __builtin_amdgcn_permlane32_swap(g1, g3, false, false); g1 = r[0]; g3 = r[1]; }
              *(u32x4*)(DST + dv * 128 + 32 * kb + 16 * hi) = (u32x4){g0, g2, g1, g3};
          } }
        __syncthreads();
        if (!more) break;
        ci = same ? ci + 1 : 0; pair = pairn; bh = bhn; c = cn; b = bh >> 2; h = bh & 3;
    }
#undef G1_LOAD_QK
#undef G1_LOAD_V
}
__device__ __forceinline__ void g2_phase(Frame& F) {
    const unsigned char* LS = (const unsigned char*)F.out; const float* GAM = (const float*)(F.ws + S_GAM); bf16* BST = (bf16*)(F.ws + A_BST);
    for (int e4 = blockIdx.x * NTHREADS + F.tid; e4 < NB * GH * 8192; e4 += F.G * NTHREADS) {
        const int bh = e4 >> 13, idx = e4 & 8191, dk0 = (idx * 4) & 127;
        unsigned dd[15]; f32x4 gg[15];
#pragma unroll
        for (int r = 0; r < 15; ++r) { const size_t j = 8 * r + 7; dd[r] = *(const unsigned*)(LS + ((size_t)bh * (NTILE - 1) + j) * 32768 + idx * 4); gg[r] = *(const f32x4*)(GAM + ((size_t)bh * NTILE + j) * 128 + dk0); }
        float s0 = 0.f, s1 = 0.f, s2 = 0.f, s3 = 0.f;
#pragma unroll
        for (int r = 0; r < 15; ++r) {
            const f32x2_t lo = __builtin_amdgcn_cvt_pk_f32_fp8((int)dd[r], false), hi2 = __builtin_amdgcn_cvt_pk_f32_fp8((int)dd[r], true);
            s0 = gg[r].x * s0 + lo.x; s1 = gg[r].y * s1 + lo.y; s2 = gg[r].z * s2 + hi2.x; s3 = gg[r].w * s3 + hi2.y;
            *(u32x2*)(BST + ((size_t)bh * 15 + r) * 32768 + idx * 4) = (u32x2){pk2(s0, s1), pk2(s2, s3)}; }
    }
}
constexpr int G3_QT = 0, G3_AT = 17408, G3_VT = 26624, G3_PART = 63488, G3_QT2 = 65536;
constexpr int PA = 144;
__device__ __forceinline__ void g3_phase(const Args& args, Frame& F) {
    const int tid = F.tid, lane = F.lane, wave = F.wave, r32 = lane & 31, hi = lane >> 5;
    unsigned char* shm = F.lds + RING_OFF;
    const bf16* QT = (const bf16*)(F.ws + A_QT); const bf16* ZV = (const bf16*)(F.ws + A_ZV); const bf16* ZR = (const bf16*)(F.ws + A_ZR); bf16* OG = (bf16*)(F.ws + A_OG);
    float* part = (float*)(shm + G3_PART);
    const float* gout = FIN(I_GGOUT);
    constexpr int NPAIR = NB * GH * 16;
    const float* GAM = (const float*)(F.ws + S_GAM); const bf16* BST = (const bf16*)(F.ws + A_BST);
    int pair = blockIdx.x; if (pair >= NPAIR) return;
    int ci = 0;
    int bh = pair & 15, c = 8 * (pair >> 4) + 1, b = bh >> 2, h = bh & 3;
    u32x4 qp[2], ap, vp[4]; u32x2 sf[8]; f32x4 pj[2][2];
    bf16x8 bfr[8];
#define G3_LOAD() do { const int unit_ = bh * NTILE + c; const bf16* ATT_ = (const bf16*)(F.ws + A_ATT) + (size_t)unit_ * 4096; const unsigned char* SB_ = (const unsigned char*)F.out + (size_t)(bh * (NTILE - 1) + c - 1) * 32768; \
        _Pragma("unroll") for (int j = 0; j < 2; ++j) { const int p = tid + 512 * j, i = p >> 4, d0 = (p & 15) * 8; qp[j] = *(const u32x4*)(QT + (size_t)row_of(b, c, i) * 512 + h * 128 + d0); } \
        { const int i = tid >> 3, s0 = (tid & 7) * 8; ap = *(const u32x4*)(ATT_ + i * 64 + s0); } \
        _Pragma("unroll") for (int j = 0; j < 4; ++j) { const int p = tid + 512 * j, i = p >> 5, dc = (p & 31) * 8; vp[j] = *(const u32x4*)(ZV + (size_t)row_of(b, c, i) * 1024 + h * 256 + dc); } \
        _Pragma("unroll") for (int j = 0; j < 2; ++j) { const int d0 = ((tid + 512 * j) & 15) * 8; const float* pp_ = GAM + ((size_t)bh * NTILE + c - 1) * 128 + d0; pj[j][0] = *(const f32x4*)pp_; pj[j][1] = *(const f32x4*)(pp_ + 4); } \
        { _Pragma("unroll") for (int ks = 0; ks < 8; ++ks) sf[ks] = *(const u32x2*)(SB_ + (32 * wave + r32) * 128 + 16 * ks + 8 * hi); } } while (0)
#define G3_LOADB() do { if ((pair >> 4) > 0) { const bf16* bp_ = BST + ((size_t)bh * 15 + (pair >> 4) - 1) * 32768 + (32 * wave + r32) * 128 + 8 * hi; _Pragma("unroll") for (int ks = 0; ks < 8; ++ks) bfr[ks] = *(const bf16x8*)(bp_ + 16 * ks); } } while (0)
    G3_LOAD(); G3_LOADB();
    float go[4][4];
#pragma unroll
    for (int g = 0; g < 4; ++g)
#pragma unroll
        for (int e = 0; e < 4; ++e) go[g][e] = gout[32 * wave + 8 * g + 4 * hi + e];
    for (;;) {
#pragma unroll
        for (int j = 0; j < 2; ++j) { const int p = tid + 512 * j, i = p >> 4, d0 = (p & 15) * 8; *(u32x4*)(shm + G3_QT + i * PQ + d0 * 2) = qp[j];
            if ((pair >> 4) > 0) { float x[8]; unpack8(qp[j], x);
                x[0] *= pj[j][0].x; x[1] *= pj[j][0].y; x[2] *= pj[j][0].z; x[3] *= pj[j][0].w; x[4] *= pj[j][1].x; x[5] *= pj[j][1].y; x[6] *= pj[j][1].z; x[7] *= pj[j][1].w;
                *(u32x4*)(shm + G3_QT2 + i * PQ + d0 * 2) = pack8(x); } }
        { const int i = tid >> 3, s0 = (tid & 7) * 8; *(u32x4*)(shm + G3_AT + i * PA + s0 * 2) = ap; }
#pragma unroll
        for (int j = 0; j < 4; ++j) { const int p = tid + 512 * j, i = p >> 5, dc = (p & 31) * 8; *(u32x4*)(shm + G3_VT + i * PV + dc * 2) = vp[j]; }
        u32x2 rw[2][4];
#pragma unroll
        for (int tb = 0; tb < 2; ++tb) { const int row = row_of(b, c, 32 * tb + r32);
#pragma unroll
            for (int g = 0; g < 4; ++g) rw[tb][g] = *(const u32x2*)(ZR + (size_t)row * 1024 + h * 256 + 32 * wave + 8 * g + 4 * hi); }
        __syncthreads();
        f32x16 acc[2] = {};
        {
#pragma unroll
            for (int ks = 0; ks < 8; ++ks) {
                const f32x2_t e0 = __builtin_amdgcn_cvt_pk_f32_fp8((int)sf[ks].x, false), e1 = __builtin_amdgcn_cvt_pk_f32_fp8((int)sf[ks].x, true), e2 = __builtin_amdgcn_cvt_pk_f32_fp8((int)sf[ks].y, false), e3 = __builtin_amdgcn_cvt_pk_f32_fp8((int)sf[ks].y, true);
                const bf16x8 sfb = __builtin_bit_cast(bf16x8, (u32x4){pk2(e0.x, e0.y), pk2(e1.x, e1.y), pk2(e2.x, e2.y), pk2(e3.x, e3.y)});
#pragma unroll
                for (int tb = 0; tb < 2; ++tb) { const bf16x8 fb = *(const LAS bf16x8*)((const LAS char*)(shm + G3_QT) + (32 * tb + r32) * PQ + (16 * ks + 8 * hi) * 2); acc[tb] = __builtin_amdgcn_mfma_f32_32x32x16_bf16(sfb, fb, acc[tb], 0, 0, 0); }
            }
            if ((pair >> 4) > 0) {
#pragma unroll
                for (int ks = 0; ks < 8; ++ks)
#pragma unroll
                    for (int tb = 0; tb < 2; ++tb) { const bf16x8 fb = *(const LAS bf16x8*)((const LAS char*)(shm + G3_QT2) + (32 * tb + r32) * PQ + (16 * ks + 8 * hi) * 2); acc[tb] = __builtin_amdgcn_mfma_f32_32x32x16_bf16(bfr[ks], fb, acc[tb], 0, 0, 0); }
            }
        }
        const bool same = ci + 1 < 8; const int pairn = same ? pair : pair + F.G; const bool more = same || pairn < NPAIR; const int bhn = pairn & 15, cn = same ? c + 1 : 8 * (pairn >> 4) + 1;
        const int b0 = b, c0 = c, h0 = h, bh0 = bh;
        if (more) { bh = bhn; c = cn; b = bh >> 2; h = bh & 3; G3_LOAD(); bh = bh0; c = c0; b = b0; h = h0; }
#pragma unroll
        for (int ks = 0; ks < 4; ++ks) {
            const bf16x8 fv = tr_frag((const LAS char*)(shm + G3_VT), PV, 32 * wave, ks, lane);
#pragma unroll
            for (int tb = 0; tb < 2; ++tb) { const bf16x8 fb = *(const LAS bf16x8*)((const LAS char*)(shm + G3_AT) + (32 * tb + r32) * PA + (16 * ks + 8 * hi) * 2); acc[tb] = __builtin_amdgcn_mfma_f32_32x32x16_bf16(fv, fb, acc[tb], 0, 0, 0); }
        }
#pragma unroll
        for (int tb = 0; tb < 2; ++tb) { float sq = 0.f;
#pragma unroll
            for (int r = 0; r < 16; ++r) sq += acc[tb][r] * acc[tb][r];
            sq += __shfl_xor(sq, 32);
            if (hi == 0) part[wave * 64 + 32 * tb + r32] = sq; }
        __syncthreads();
#pragma unroll
        for (int tb = 0; tb < 2; ++tb) {
            const int t = 32 * tb + r32; float tot = 0.f;
#pragma unroll
            for (int w = 0; w < 8; ++w) tot += part[w * 64 + t];
            const float rstd = rsqrtf(tot * (1.f / GDV) + EPS);
            const int row = row_of(b, c, t);
#pragma unroll
            for (int g = 0; g < 4; ++g) {
                const int dv = 32 * wave + 8 * g + 4 * hi; const u32x2 rwv = rw[tb][g];
                const float rv[4] = {bf2f(rwv.x & 0xffff), bf2f(rwv.x >> 16), bf2f(rwv.y & 0xffff), bf2f(rwv.y >> 16)}; float o[4];
#pragma unroll
                for (int e = 0; e < 4; ++e) o[e] = acc[tb][4 * g + e] * rstd * go[g][e] * (rv[e] * __builtin_amdgcn_rcpf(1.f + __expf(-rv[e])));
                u32x2 w; w.x = pk2(o[0], o[1]); w.y = pk2(o[2], o[3]); *(u32x2*)(OG + (size_t)row * 1024 + h * 256 + dv) = w;
            }
        }
        __syncthreads();
        if (!more) break;
        ci = same ? ci + 1 : 0; pair = pairn; bh = bhn; c = cn; b = bh >> 2; h = bh & 3;
        if (!same) G3_LOADB();
    }
#undef G3_LOAD
#undef G3_LOADB
}

template <bool FINAL>
__device__ __forceinline__ void combine_rows(const Args& args, Frame& F, const MoeTables& T, float* rs2) {
    const unsigned char* y = (const unsigned char*)(F.ws + A_Y); bf16* hb = (bf16*)(F.ws + A_HB); const unsigned* epos = (const unsigned*)(F.ws + S_EPOS); const unsigned* wtsu = (const unsigned*)(F.ws + S_WTS);
    const int gw = F.vcu * NWAVES + F.wave, NGW = F.G * NWAVES, lane = F.lane;
    const int RMAX = FINAL ? NREAL : MROWS;
#define CB_META(r_) ((lane < 2 ? epos : wtsu)[2 * (size_t)(r_) + (lane & 1)])
#define CB_LOAD(r_, m_, h_, y0_, y1_, w0_, w1_) do { if (!row_is_dummy(r_)) { \
            const unsigned e0_ = (unsigned)__builtin_amdgcn_readlane((int)m_, 0), e1_ = (unsigned)__builtin_amdgcn_readlane((int)m_, 1); \
            w0_ = Y_INV * __uint_as_float((unsigned)__builtin_amdgcn_readlane((int)m_, 2)); w1_ = Y_INV * __uint_as_float((unsigned)__builtin_amdgcn_readlane((int)m_, 3)); \
            const size_t ya_ = (size_t)T.cpre[e0_ >> 20] + (e0_ & 0xfffffu), yb_ = (size_t)T.cpre[e1_ >> 20] + (e1_ & 0xfffffu); \
            _Pragma("unroll") for (int j = 0; j < 4; ++j) { h_[j] = *(const u32x2*)(hb + (size_t)(r_) * 1024 + 4 * lane + 256 * j); \
                y0_[j] = *(const unsigned*)(y + ya_ * 1024 + 4 * lane + 256 * j); y1_[j] = *(const unsigned*)(y + yb_ * 1024 + 4 * lane + 256 * j); } } } while (0)
    u32x2 ha[4], hq[4]; unsigned ya0[4], ya1[4], yb0[4], yb1[4]; float wa0 = 0.f, wa1 = 0.f, wb0 = 0.f, wb1 = 0.f; unsigned mnext = 0u;
    if (gw < RMAX) { unsigned m0 = row_is_dummy(gw) ? 0u : CB_META(gw); CB_LOAD(gw, m0, ha, ya0, ya1, wa0, wa1); if (gw + NGW < RMAX && !row_is_dummy(gw + NGW)) mnext = CB_META(gw + NGW); }
    for (int r = gw; r < RMAX; r += NGW) {
        const int rn = r + NGW, rnn = r + 2 * NGW;
        if (rn < RMAX) CB_LOAD(rn, mnext, hq, yb0, yb1, wb0, wb1);
        if (rnn < RMAX && !row_is_dummy(rnn)) mnext = CB_META(rnn);
        if (row_is_dummy(r)) {
            if (!FINAL && lane == 0) rs2[r] = 0.f;
        } else {
            f32x4 v[4];
#pragma unroll
            for (int j = 0; j < 4; ++j) { const u32x2 q = ha[j];
                const f32x2_t a0 = __builtin_amdgcn_cvt_pk_f32_fp8((int)ya0[j], false), a1 = __builtin_amdgcn_cvt_pk_f32_fp8((int)ya0[j], true), b0 = __builtin_amdgcn_cvt_pk_f32_fp8((int)ya1[j], false), b1 = __builtin_amdgcn_cvt_pk_f32_fp8((int)ya1[j], true);
                v[j].x = bf2f(q.x & 0xffff) + (wa0 * a0.x + wa1 * b0.x); v[j].y = bf2f(q.x >> 16) + (wa0 * a0.y + wa1 * b0.y);
                v[j].z = bf2f(q.y & 0xffff) + (wa0 * a1.x + wa1 * b1.x); v[j].w = bf2f(q.y >> 16) + (wa0 * a1.y + wa1 * b1.y); }
            if (FINAL) {
#pragma unroll
                for (int j = 0; j < 4; ++j) __builtin_nontemporal_store(v[j], (f32x4*)(F.out + (size_t)r * 1024 + 4 * lane + 256 * j));
            } else {
#pragma unroll
                for (int j = 0; j < 4; ++j) { u32x2 o; o.x = pk2(v[j].x, v[j].y); o.y = pk2(v[j].z, v[j].w); *(u32x2*)(hb + (size_t)r * 1024 + 4 * lane + 256 * j) = o;
                    v[j] = (f32x4){bf2f(o.x & 0xffff), bf2f(o.x >> 16), bf2f(o.y & 0xffff), bf2f(o.y >> 16)}; }
                float sq = 0.f;
#pragma unroll
                for (int j = 0; j < 4; ++j) sq += (v[j].x * v[j].x + v[j].y * v[j].y) + (v[j].z * v[j].z + v[j].w * v[j].w);
                const float rstd = rsqrtf(wave_sum(sq) * (1.f / 1024.f) + EPS);
                if (lane == 0) rs2[r] = rstd;
            }
        }
#pragma unroll
        for (int j = 0; j < 4; ++j) { ha[j] = hq[j]; ya0[j] = yb0[j]; ya1[j] = yb1[j]; }
        wa0 = wb0; wa1 = wb1;
    }
#undef CB_META
#undef CB_LOAD
}

__device__ __forceinline__ void glr_skinny(Frame& F, const bf16* hb, const bf16* Wg, const float* rs2, float* GLR) {
    const int tid = F.tid, lane = F.lane, l15 = lane & 15, kq = lane >> 4;
    LAS unsigned char* wl = (LAS unsigned char*)F.lds + RING_OFF;
    __syncthreads();
#pragma unroll
    for (int i = 0; i < 4; ++i) { const int p = tid + 512 * i, n = p >> 7, c = (p & 127) * 16; *(LAS u32x4*)(wl + n * 2064 + c) = *(const u32x4*)((const char*)Wg + (size_t)n * 2048 + c); }
    __syncthreads();
    const int NG = MROWS / 16;
    for (int grp = F.vcu * NWAVES + F.wave; grp < NG; grp += F.G * NWAVES) {
        const bf16* ap = hb + (size_t)(16 * grp + l15) * 1024 + 8 * kq;
        f32x4 acc = {};
#pragma unroll 1
        for (int bt = 0; bt < 4; ++bt) {
            u32x4 a[8];
#pragma unroll
            for (int j = 0; j < 8; ++j) a[j] = *(const u32x4*)(ap + 32 * (8 * bt + j));
#pragma unroll
            for (int j = 0; j < 8; ++j) { const bf16x8 b = *(const LAS bf16x8*)(wl + l15 * 2064 + (8 * bt + j) * 64 + kq * 16); acc = __builtin_amdgcn_mfma_f32_16x16x32_bf16(__builtin_bit_cast(bf16x8, a[j]), b, acc, 0, 0, 0); }
        }
#pragma unroll
        for (int r = 0; r < 4; ++r) { const int row = 16 * grp + 4 * kq + r; GLR[(size_t)row * 16 + l15] = acc[r] * rs2[row]; }
    }
    __syncthreads();
}

template <class EpiF>
__device__ __forceinline__ void meta_gemm(const bf16* A, int lda, const bf16* Bt, int K, int N, Frame& F, EpiF epi) {
    if (F.vcu >= N / 32) return;
    const int lane = F.lane, wave = F.wave, l15 = lane & 15, kq = lane >> 4, kpart = wave & 3;
    const int col0 = 16 * (2 * F.vcu + (wave >> 2)), k0 = kpart * (K / 4), nks = K / 128;
    float* red = (float*)(F.lds + RING_OFF);
    f32x4 acc[4] = {};
#pragma unroll 4
    for (int s4 = 0; s4 < nks; ++s4) {
        const bf16x8 bfr = *(const bf16x8*)(Bt + (size_t)(col0 + l15) * K + k0 + 32 * s4 + 8 * kq);
#pragma unroll
        for (int rb = 0; rb < 4; ++rb) { const bf16x8 afr = *(const bf16x8*)(A + (size_t)(NREAL + rb * 64 + 48 + l15) * lda + k0 + 32 * s4 + 8 * kq); acc[rb] = __builtin_amdgcn_mfma_f32_16x16x32_bf16(afr, bfr, acc[rb], 0, 0, 0); }
    }
#pragma unroll
    for (int rb = 0; rb < 4; ++rb)
#pragma unroll
        for (int rg = 0; rg < 4; ++rg) red[(wave * 16 + rb * 4 + rg) * 64 + lane] = acc[rb][rg];
    __syncthreads();
    if (kpart == 0) {
#pragma unroll
        for (int rb = 0; rb < 4; ++rb)
#pragma unroll
            for (int rg = 0; rg < 4; ++rg) { float v = acc[rb][rg];
#pragma unroll
                for (int w = 1; w < 4; ++w) v += red[((wave + w) * 16 + rb * 4 + rg) * 64 + lane];
                epi(NREAL + rb * 64 + 48 + 4 * kq + rg, col0 + l15, v); }
    }
    __syncthreads();
}

struct MetaEpiQ { bf16* QR; const float* part;
    __device__ __forceinline__ void operator()(int row, int col, float v) const { float ss = 0.f;
#pragma unroll
        for (int i = 0; i < 12; ++i) ss += part[(size_t)row * 24 + i];
        QR[(size_t)row * 1536 + col] = (bf16)f2bf(v * rsqrtf(ss * (1.f / MLA_Q) + EPS)); } };
struct MetaEpiKV { bf16* KN; bf16* VT; const float* part;
    __device__ __forceinline__ void operator()(int row, int col, float v) const { float ss = 0.f;
#pragma unroll
        for (int i = 12; i < 20; ++i) ss += part[(size_t)row * 24 + i];
        const bf16 o = (bf16)f2bf(v * rsqrtf(ss * (1.f / MLA_KV) + EPS));
        int b, tile, r64; row_btr(row, b, tile, r64);
        if (col < 1024) { const int pn = col >> 8, bj = (col >> 7) & 1, wc = (col >> 5) & 3, head = 4 * pn + wc, d = 32 * bj + (col & 31); KN[(size_t)row * 1024 + head * 64 + d] = o; }
        else { const int hv = (col - 1024) >> 6, d = col & 63; VT[((((size_t)(b * NHEAD + hv) * NTILE + tile) * 2 + (d >> 5)) * 64 + r64) * 32 + (d & 31)] = o; } } };
struct MetaEpiRes { const float* meta; bf16* hb;
    __device__ __forceinline__ void operator()(int row, int col, float v) const { const int q = row - NREAL;
        const float sv = meta ? meta[(size_t)((q & 63) - 48) * 1024 + col] : bf2f(hb[(size_t)row * 1024 + col]); hb[(size_t)row * 1024 + col] = (bf16)f2bf(sv + v); } };

struct MetaEpiZgla { bf16* ZQK; bf16* ZV; bf16* ZR; const float* rs2;
    __device__ __forceinline__ void operator()(int row, int col, float v) const { bf16* dst = col < 1024 ? ZQK : (col < 2048 ? ZV : ZR); dst[(size_t)row * 1024 + (col & 1023)] = (bf16)f2bf(v * rs2[row]); } };

#ifndef STOP_AFTER
#define STOP_AFTER 99
#endif
constexpr int N_PHASES = 19;
__global__ void __launch_bounds__(NTHREADS, 2) fwd_kernel(const Args args) {
    extern __shared__ __attribute__((aligned(16))) unsigned char lds_raw[];
    Frame F;
    F.lds = lds_raw; F.MISC = (volatile LAS unsigned*)((LAS unsigned char*)lds_raw + MISC_OFF);
    F.tid = threadIdx.x; F.lane = F.tid & 63; F.wave = __builtin_amdgcn_readfirstlane(F.tid >> 6);
    F.G = gridDim.x; { const int bx = blockIdx.x; F.vcu = (F.G % 8 == 0) ? (bx % 8) * (F.G / 8) + bx / 8 : bx; }
    F.ws = args.ws; F.ctl = (unsigned*)(args.ws + WS_CTL); F.out = args.out;
    for (int u = F.tid; u < (LDS_BYTES - LDSCTL_OFF) / 4; u += NTHREADS) ((LAS unsigned*)((LAS unsigned char*)lds_raw + LDSCTL_OFF))[u] = 0u;
    __syncthreads();
    XcdBarrier bar = xcd_barrier_post(F.ctl + CW_BAR, F.MISC);
    const int lo = args.ph_lo, hi = args.ph_hi;
    LAS unsigned char* ldsl = (LAS unsigned char*)lds_raw + RING_OFF;
    unsigned char* ws = F.ws;
#ifndef ONLY_PHASE
#define ONLY_PHASE -1
#endif
#define IN(k) ((ONLY_PHASE < 0 || ONLY_PHASE == (k)) && lo <= (k) && (k) < hi)
#ifndef DUP_MASK
#define DUP_MASK 0
#endif
#define REP(k) _Pragma("unroll") for (int rep_ = 0; rep_ < 1 + ((DUP_MASK >> (k)) & 1); ++rep_)
#define SEAM(k) do { if (IN(k) && IN((k) + 1)) xcd_barrier(bar); } while (0)

    if (IN(0)) REP(0) { __syncthreads(); p0_prologue(args, F); } SEAM(0);
    if (IN(1)) REP(1) { __syncthreads();
        pg8::DenseSched S; S.init(MROWS, MLA_INP, F.G, (int)blockIdx.x, ws + A_HN, 1024, ws + W_MI, 1024);
        EpiZmla E{(bf16*)(ws + A_ZMLA), (float*)(ws + S_PART)};
        pg8::gemm_phase(ldsl, 1024, S, E);
        if (F.G == 256 && (int)blockIdx.x >= 387 - 256) {
            const int nw = (2 * 256 - 387) * NWAVES, lim = nw * P1_FILL_PER_WAVE < D1_ITEMS ? nw * P1_FILL_PER_WAVE : D1_ITEMS;
            def_convert<1>(args, F, ((int)blockIdx.x - (387 - 256)) * NWAVES + F.wave, nw, lim, P1_FILL_PER_WAVE); }
    } SEAM(1);
    if (IN(2)) REP(2) { __syncthreads();
        { meta_gemm((const bf16*)(ws + A_ZMLA), MLA_INP, (const bf16*)(ws + W_UQ), MLA_Q, 1536, F, MetaEpiQ{(bf16*)(ws + A_QRAW), (const float*)(ws + S_PART)});
          meta_gemm((const bf16*)(ws + A_ZMLA) + MLA_Q, MLA_INP, (const bf16*)(ws + W_UKV), MLA_KV, 2048, F, MetaEpiKV{(bf16*)(ws + A_KNRAW), (bf16*)F.out, (const float*)(ws + S_PART)}); }
        { pg8::DenseSched S; S.init(NREAL, 1536, F.G, (int)blockIdx.x, ws + A_ZMLA, MLA_INP, ws + W_UQ, MLA_Q);
          EpiQ E{(bf16*)(ws + A_QRAW), (const float*)(ws + S_PART)}; pg8::gemm_phase(ldsl, MLA_Q, S, E);
#ifdef DUP_Q
          __syncthreads(); pg8::gemm_phase(ldsl, MLA_Q, S, E);
#endif
        }
        { pg8::DenseSched S; S.init(NREAL, 2048, F.G, (int)blockIdx.x, ws + A_ZMLA + MLA_Q * 2, MLA_INP, ws + W_UKV, MLA_KV);
          EpiKV E{(bf16*)(ws + A_K), (bf16*)F.out, (const float*)(ws + S_PART), (float*)(ws + A_KNRAW), FIN(I_MGKN)}; pg8::gemm_phase(ldsl, MLA_KV, S, E);
#ifdef DUP_KV
          __syncthreads(); pg8::gemm_phase(ldsl, MLA_KV, S, E);
#endif
        }
    } SEAM(2);
    if (IN(3)) REP(3) { __syncthreads(); kprep_phase(args, F); } SEAM(3);
    if (IN(4)) REP(4) { __syncthreads(); attn_phase(args, F); } SEAM(4);
    if (IN(5)) REP(5) { __syncthreads();
        meta_gemm((const bf16*)(ws + A_O), 1024, (const bf16*)(ws + W_OM), 1024, 1024, F, MetaEpiRes{FIN(I_META), (bf16*)(ws + A_HB)});
        pg8::DenseSched S; S.init(NREAL, 1024, F.G, (int)blockIdx.x, ws + A_O, 1024, ws + W_OM, 1024);
        EpiRes E{FIN(I_X), (bf16*)(ws + A_HB)}; pg8::gemm_phase(ldsl, 1024, S, E);
    } SEAM(5);
#if STOP_AFTER >= 6
    if (IN(6)) { route_phase(args, F, 0, (const bf16*)(ws + A_HB), F.ctl + CW_CNT, (int*)(ws + S_LIST), (float*)(ws + S_WTS), (unsigned*)(ws + S_EPOS), (float*)(ws + A_RSL));
 } SEAM(6);
    if (IN(7)) REP(7) { __syncthreads();
        MoeTables T = moe_tables(F, F.ctl + CW_CNT);
        MoeSched S{T, 2, F.G, F.vcu, true, (const char*)(ws + A_HB), 1024, (const char*)(ws + W_GU), 1024, (size_t)512 * 1024 * 2, (const int*)(ws + S_LIST)};
        EpiGU E{(bf16*)(ws + A_HID), (const float*)(ws + A_RSL), T.cnt}; pg8::gemm_phase(ldsl, 1024, S, E);
        def_fill_idle<7>(args, F, (int)T.tpre[32] * 2, WD_ITEMS, P7_FILL_PER_WAVE, true);
        { const int tot = (int)T.tpre[32] * 2, maxu = (tot + F.G - 1) / F.G, thr = tot - (maxu - 1) * F.G, nfill = F.G - thr;
          if (F.vcu >= thr && nfill > 0) { int cov = nfill * NWAVES * P7_FILL2_PER_WAVE; cov = cov < GU_ITEMS ? cov : GU_ITEMS; def_convert<7>(args, F, WD_ITEMS + (F.vcu - thr) * NWAVES + F.wave, nfill * NWAVES, WD_ITEMS + cov, P7_FILL2_PER_WAVE); } }
    } SEAM(7);
    if (IN(8)) REP(8) { __syncthreads();
        MoeTables T = moe_tables(F, F.ctl + CW_CNT);
        MoeSched S{T, 4, F.G, F.vcu, false, (const char*)(ws + A_HID), 256, (const char*)(ws + W_D), 256, (size_t)1024 * 256 * 2, (const int*)(ws + S_LIST)};
        EpiDown E{(unsigned char*)(ws + A_Y), T.cnt, T.cpre}; pg8::gemm_phase(ldsl, 256, S, E);
    } SEAM(8);
#endif
#if STOP_AFTER >= 9
    if (IN(9)) { MoeTables T = moe_tables(F, F.ctl + CW_CNT); combine_rows<false>(args, F, T, (float*)(ws + S_SSQ_Q)); } SEAM(9);
#endif
#if STOP_AFTER >= 10
    if (IN(10)) REP(10) { __syncthreads();
        meta_gemm((const bf16*)(ws + A_HB), 1024, (const bf16*)(ws + W_GI), 1024, 3072, F, MetaEpiZgla{(bf16*)(ws + A_ZQK), (bf16*)(ws + A_ZV), (bf16*)(ws + A_ZR), (const float*)(ws + S_SSQ_Q)});
        pg8::DenseSched S; S.init(NREAL, 3072, F.G, (int)blockIdx.x, ws + A_HB, 1024, ws + W_GI, 1024);
        EpiZgla E{(bf16*)(ws + A_ZQK), (bf16*)(ws + A_ZV), (bf16*)(ws + A_ZR), (float*)(ws + S_GLR), (const float*)(ws + S_SSQ_Q)}; pg8::gemm_phase(ldsl, 1024, S, E);
        glr_skinny(F, (const bf16*)(ws + A_HB), (const bf16*)(ws + W_GI) + (size_t)3072 * 1024, (const float*)(ws + S_SSQ_Q), (float*)(ws + S_GLR));
    } SEAM(10);
    if (IN(11)) REP(11) { __syncthreads(); g1_phase(args, F); } SEAM(11);
    if (IN(12)) { g2_phase(F); } SEAM(12);
    if (IN(13)) REP(13) { __syncthreads(); g3_phase(args, F); } SEAM(13);
    if (IN(14)) {
        pg8::DenseSched S; S.init(NREAL, 1024, F.G, (int)blockIdx.x, ws + A_OG, 1024, ws + W_OG, 1024);
        EpiRes E{nullptr, (bf16*)(ws + A_HB)}; pg8::gemm_phase(ldsl, 1024, S, E);
    } SEAM(14);
#endif
#if STOP_AFTER >= 15
    if (IN(15)) { route_phase(args, F, 1, (const bf16*)(ws + A_HB), F.ctl + CW_CNT + 32, (int*)(ws + S_LIST), (float*)(ws + S_WTS), (unsigned*)(ws + S_EPOS), (float*)(ws + A_RSL));
        { MoeTables T0 = moe_tables(F, F.ctl + CW_CNT);
          const int tot = (int)T0.tpre[32] * 2, maxu = (tot + F.G - 1) / F.G, thr = tot - (maxu - 1) * F.G, nfill = F.G - thr; int cov = nfill > 0 ? nfill * NWAVES * P7_FILL2_PER_WAVE : 0; cov = cov < GU_ITEMS ? cov : GU_ITEMS;
          def_convert<7>(args, F, WD_ITEMS + cov + F.vcu * NWAVES + F.wave, F.G * NWAVES, D7_ITEMS, 1 << 30); }
    } SEAM(15);
    if (IN(16)) REP(16) { __syncthreads();
        MoeTables T = moe_tables(F, F.ctl + CW_CNT + 32);
        MoeSched S{T, 2, F.G, F.vcu, true, (const char*)(ws + A_HB), 1024, (const char*)(ws + W_GU) + (size_t)32 * 512 * 1024 * 2, 1024, (size_t)512 * 1024 * 2, (const int*)(ws + S_LIST)};
        EpiGU E{(bf16*)(ws + A_HID), (const float*)(ws + A_RSL), T.cnt}; pg8::gemm_phase(ldsl, 1024, S, E);
        def_fill_idle<16>(args, F, (int)T.tpre[32] * 2, D16_ITEMS, P7_FILL_PER_WAVE, true);
    } SEAM(16);
    if (IN(17)) REP(17) { __syncthreads();
        MoeTables T = moe_tables(F, F.ctl + CW_CNT + 32);
        MoeSched S{T, 4, F.G, F.vcu, false, (const char*)(ws + A_HID), 256, (const char*)(ws + W_D) + (size_t)32 * 1024 * 256 * 2, 256, (size_t)1024 * 256 * 2, (const int*)(ws + S_LIST)};
        EpiDown E{(unsigned char*)(ws + A_Y), T.cnt, T.cpre}; pg8::gemm_phase(ldsl, 256, S, E);
    } SEAM(17);
    if (IN(18)) { MoeTables T = moe_tables(F, F.ctl + CW_CNT + 32); combine_rows<true>(args, F, T, nullptr); }
#endif
#undef IN
#undef SEAM
}

#ifndef N_LAUNCH_SPLIT
#define N_LAUNCH_SPLIT 0
#endif
extern "C" void kernel_launch(void* const* d_in, const int* in_sizes, int n_in, void* d_out, int out_size, void* d_ws, size_t ws_size, hipStream_t stream) {
    static int grid = 0;
    if (grid == 0) {
        if (n_in != 24 || ws_size < WS_END) { fprintf(stderr, "kernel_launch: needs 24 inputs and %zu bytes of workspace (got %d, %zu)\n", (size_t)WS_END, n_in, ws_size); grid = -1; return; }
        int dev = 0, cus = 0, per_cu = 0;
        if (hipGetDevice(&dev) != hipSuccess || hipDeviceGetAttribute(&cus, hipDeviceAttributeMultiprocessorCount, dev) != hipSuccess) { grid = -1; return; }
        if (hipFuncSetAttribute((const void*)fwd_kernel, hipFuncAttributeMaxDynamicSharedMemorySize, LDS_BYTES) != hipSuccess) { fprintf(stderr, "kernel_launch: hipFuncSetAttribute failed\n"); grid = -1; return; }
        if (hipOccupancyMaxActiveBlocksPerMultiprocessor(&per_cu, (const void*)fwd_kernel, NTHREADS, LDS_BYTES) != hipSuccess || per_cu < 1) fprintf(stderr, "kernel_launch: occupancy query says %d\n", per_cu);
        (void)hipGetLastError();
        grid = cus;
    }
    if (grid < 0) return;
    (void)hipMemsetAsync((char*)d_ws + WS_CTL, 0, CTL_ZERO_BYTES, stream);
    Args a{};
    for (int i = 0; i < 24; ++i) a.in[i] = (const float*)d_in[i];
    a.out = (float*)d_out; a.ws = (unsigned char*)d_ws;
#if N_LAUNCH_SPLIT
    for (int p = 0; p < N_PHASES; ++p) { a.ph_lo = p; a.ph_hi = p + 1; hipLaunchKernelGGL(fwd_kernel, dim3(grid), dim3(NTHREADS), LDS_BYTES, stream, a); }
#else
    a.ph_lo = 0; a.ph_hi = N_PHASES;
    hipLaunchKernelGGL(fwd_kernel, dim3(grid), dim3(NTHREADS), LDS_BYTES, stream, a);
#endif
}
```

```cpp
#include <hip/hip_runtime.h>
#include <cstdio>
#include <cstdint>

#define LAS __attribute__((address_space(3)))
#define GAS __attribute__((address_space(1)))
typedef unsigned short bf16;
typedef short bf16x8 __attribute__((ext_vector_type(8)));
typedef short s16x4 __attribute__((ext_vector_type(4)));
typedef float f32x4 __attribute__((ext_vector_type(4)));
typedef float f32x16 __attribute__((ext_vector_type(16)));
typedef unsigned u32x4 __attribute__((ext_vector_type(4)));
typedef unsigned u32x2 __attribute__((ext_vector_type(2)));
typedef GAS unsigned gu32;

constexpr int NB = 4, SEQ = 8192, DM = 1024;
constexpr int NREAL = NB * SEQ;
constexpr int MROWS = NREAL + 256;
constexpr int NTILE = 129;
constexpr int NHEAD = 16, QK = 96, NOPE = 64, ROPE = 32, VD = 64;
constexpr int MLA_Q = 384, MLA_KV = 256, MLA_IN = 672, MLA_INP = 768;
constexpr int GH = 4, GDK = 128, GDV = 256, GNK = 512, GNV = 1024, GLA_IN = 3088, GLA_INP = 3328;
constexpr int NEXP = 32, DEXP = 256;
constexpr float EPS = 1e-6f;
constexpr int NWAVES = 8, NTHREADS = 512;

__device__ __forceinline__ float bf2f(unsigned short b) { return __uint_as_float(((unsigned)b) << 16); }
__device__ __forceinline__ unsigned f2bf(float f) { unsigned u = __float_as_uint(f); return (u + 0x7fffu + ((u >> 16) & 1u)) >> 16; }
typedef float f32x2_t __attribute__((ext_vector_type(2))); typedef __bf16 bf16x2_t __attribute__((ext_vector_type(2)));
__device__ __forceinline__ unsigned pk2(float lo, float hi) { f32x2_t v = {lo, hi}; bf16x2_t b = __builtin_convertvector(v, bf16x2_t); return __builtin_bit_cast(unsigned, b); }
constexpr float W_SC = 64.f, O_SC = 16.f, WO_INV = 1.f / (64.f * 16.f);
constexpr float KQ_SC = 0.38372263f;
__device__ __forceinline__ unsigned pk4_e4m3(float a, float b, float c, float d) {
    a = __builtin_amdgcn_fmed3f(a, -448.f, 448.f); b = __builtin_amdgcn_fmed3f(b, -448.f, 448.f); c = __builtin_amdgcn_fmed3f(c, -448.f, 448.f); d = __builtin_amdgcn_fmed3f(d, -448.f, 448.f);
    int w = 0; w = __builtin_amdgcn_cvt_pk_fp8_f32(a, b, w, false); w = __builtin_amdgcn_cvt_pk_fp8_f32(c, d, w, true); return (unsigned)w;
}
__device__ __forceinline__ unsigned pk4_bf8(float a, float b, float c, float d) { int w = 0; w = __builtin_amdgcn_cvt_pk_bf8_f32(a, b, w, false); w = __builtin_amdgcn_cvt_pk_bf8_f32(c, d, w, true); return (unsigned)w; }
__device__ __forceinline__ float max3f(float a, float b, float c) { float r; asm("v_max3_f32 %0, %1, %2, %3" : "=v"(r) : "v"(a), "v"(b), "v"(c)); return r; }
__device__ __forceinline__ float max2f(float a, float b) { float r; asm("v_max_f32_e32 %0, %1, %2" : "=v"(r) : "v"(a), "v"(b)); return r; }
__device__ __forceinline__ float wave_sum(float v) {
#pragma unroll
    for (int o = 1; o < 64; o <<= 1) v += __shfl_xor(v, o);
    return v;
}
#define LDS_WAIT() asm volatile("s_waitcnt lgkmcnt(0)" ::: "memory")
#define VM_WAIT() asm volatile("s_waitcnt vmcnt(0)" ::: "memory")

__device__ const float ROPE_INV[16] = {1.000000000e+00f, 5.623413324e-01f, 3.162277639e-01f, 1.778279394e-01f, 1.000000015e-01f, 5.623412877e-02f, 3.162277862e-02f, 1.778279431e-02f,
                                       9.999999776e-03f, 5.623413250e-03f, 3.162277862e-03f, 1.778279431e-03f, 1.000000047e-03f, 5.623413017e-04f, 3.162277862e-04f, 1.778279402e-04f};


__device__ __forceinline__ void fast_sincos(float a, float& sn, float& cs) {
    const float k = rintf(a * 0.15915494309189535f);
    float r = fmaf(-k, 6.2831854820251465f, a); r = fmaf(-k, -1.7484556e-7f, r);
    const float rev = r * 0.15915494309189535f;
    sn = __builtin_amdgcn_sinf(rev); cs = __builtin_amdgcn_cosf(rev);
}

__device__ __forceinline__ bool row_is_dummy(int r) { return r >= NREAL && ((r - NREAL) & 63) < 48; }
__device__ __forceinline__ int row_pos(int r) { return r < NREAL ? 16 + (r & (SEQ - 1)) : ((r - NREAL) & 63) - 48; }
__device__ __forceinline__ void row_btr(int r, int& b, int& tile, int& r64) {
    if (r < NREAL) { b = r >> 13; const int s = r & (SEQ - 1); tile = 1 + (s >> 6); r64 = s & 63; }
    else { const int q = r - NREAL; b = q >> 6; tile = 0; r64 = q & 63; }
}
__device__ __forceinline__ int row_of(int b, int tile, int r64) { return tile == 0 ? NREAL + b * 64 + r64 : b * SEQ + (tile - 1) * 64 + r64; }

namespace pg8 {
typedef unsigned short bf16_t; typedef int v8i_t __attribute__((ext_vector_type(8))); typedef int i32x4_t __attribute__((ext_vector_type(4)));
constexpr int BM = 256, BK = 64, HALF = 128, HTB = HALF * BK * 2, STAGE_BYTES = 8 * HTB, NXCD = 8, WGM = 8;
__host__ __device__ __forceinline__ int lds_byte(int r, int c) { const int st = (r >> 4) * 2 + (c >> 5), rr = r & 15, cc = c & 31, ob = rr * 64 + cc * 2; return st * 1024 + (ob ^ (((ob >> 9) & 1) << 5)); }
__host__ __device__ __forceinline__ void stage_rc(int b, int& R, int& C) { const int st = b / 1024, sb = b % 1024, swz = sb ^ (((sb >> 9) & 1) << 5); R = (st >> 1) * 16 + swz / 64; C = (st & 1) * 32 + (swz % 64) / 2; }
__host__ __device__ __forceinline__ int perm32(int rho) { const int n = rho >> 4, i = rho & 15; return 8 * (i >> 2) + 4 * n + (i & 3); }

struct Unit { int pm, pn, e, r0; };

struct DenseSched {
    int nM, nN, nwg, G, c;
    const char* A; int lda; const char* Bt; int K;
    __device__ void init(int M, int N, int G_, int c_, const void* A_, int lda_, const void* Bt_, int K_) { nM = M / BM; nN = N / BM; nwg = nM * nN; G = G_; c = c_; A = (const char*)A_; lda = lda_; Bt = (const char*)Bt_; K = K_; }
    __device__ bool next(int i, Unit& u) const {
        const long L = (long)i * G + c; if (L >= nwg) return false;
        int wgid = (int)L; { const int q = nwg / NXCD, r = nwg % NXCD, xcd = wgid % NXCD, off = wgid / NXCD; wgid = (xcd < r ? xcd * (q + 1) : r * (q + 1) + (xcd - r) * q) + off; }
        const int nig = WGM * nN, gid = wgid / nig, fm = gid * WGM, gsz = (nM - fm) < WGM ? (nM - fm) : WGM;
        u.pm = fm + ((wgid % nig) % gsz); u.pn = (wgid % nig) / gsz; u.e = 0; u.r0 = u.pm; return true;
    }
    __device__ __forceinline__ const char* a_base() const { return A; }
    __device__ __forceinline__ unsigned a_off(const Unit& u, int r, int c_) const { return (unsigned)(((u.pm * BM + r) * lda + c_) * 2); }
    __device__ __forceinline__ const char* b_ptr(const Unit& u) const { return Bt + (size_t)u.pn * BM * K * 2; }
};

template <class Epi, class Sched>
__device__ __forceinline__ void gemm_phase(LAS unsigned char* lds, const int K, const Sched& S, const Epi& E) {
    const int tid = threadIdx.x, wid = __builtin_amdgcn_readfirstlane(tid >> 6), lane = tid & 63, wr = wid >> 2, wc = wid & 3, fr = lane & 15, fq = lane >> 4;
    const int nt = K / BK;
    int sR[2], sC[2]; unsigned voffB[2];
#pragma unroll
    for (int i = 0; i < 2; ++i) { int R, C; stage_rc(tid * 16 + i * 8192, R, C); sR[i] = R; sC[i] = C; const int Rb = Epi::PERM ? ((Epi::ADJ ? (R >> 5) * 64 : (R & ~31)) + perm32(R & 31)) : R; voffB[i] = (unsigned)(Rb * K + C) * 2u; }
    const size_t kstep = (size_t)(BK * 2);
    const size_t hstepB = (size_t)(Epi::ADJ ? 32 : HALF) * K * 2;
    const unsigned ldsw = (unsigned)wid * 1024u;
    const int aoff = lds_byte(wr * 64 + fr, fq * 8), boff = lds_byte(wc * 32 + fr, fq * 8);
#define PG8_SA(b, h) (((b) * 2 + (h)) * HTB)
#define PG8_SB(b, h) ((4 + (b) * 2 + (h)) * HTB)
#define PG8_STAGE(bufoff, gbase, voff) do { _Pragma("unroll") for (int _i = 0; _i < 2; ++_i) \
        __builtin_amdgcn_global_load_lds((const unsigned*)((const char*)(gbase) + (voff)[_i]), (LAS unsigned*)(lds + (bufoff) + ldsw + _i * 8192), 16, 0, 0); } while (0)
#define PG8_LDA(dst, b, h) do { _Pragma("unroll") for (int m = 0; m < 4; ++m) _Pragma("unroll") for (int k = 0; k < 2; ++k) dst[m][k] = *(const LAS bf16x8*)(lds + PG8_SA(b, h) + aoff + m * 2048 + k * 1024); } while (0)
#define PG8_LDB(dst, b, h) do { _Pragma("unroll") for (int n = 0; n < 2; ++n) _Pragma("unroll") for (int k = 0; k < 2; ++k) dst[n][k] = *(const LAS bf16x8*)(lds + PG8_SB(b, h) + boff + n * 2048 + k * 1024); } while (0)
#define PG8_F8(x0, x1) __builtin_shufflevector(__builtin_bit_cast(i32x4_t, x0), __builtin_bit_cast(i32x4_t, x1), 0, 1, 2, 3, 4, 5, 6, 7)
#define PG8_MMA(ai, bj, At, Bt) do { __builtin_amdgcn_s_setprio(1); _Pragma("unroll") for (int m = 0; m < 4; ++m) _Pragma("unroll") for (int n = 0; n < 2; ++n) { \
        if (Epi::F8) { const v8i_t b8_ = PG8_F8(Bt[n][0], Bt[n][1]), a8_ = PG8_F8(At[m][0], At[m][1]); asm volatile("v_mfma_f32_16x16x128_f8f6f4 %0, %1, %2, %0" : "+v"(acc[ai][bj][m][n]) : "v"(b8_), "v"(a8_)); } \
        else { _Pragma("unroll") for (int k = 0; k < 2; ++k) acc[ai][bj][m][n] = __builtin_amdgcn_mfma_f32_16x16x32_bf16(Bt[n][k], At[m][k], acc[ai][bj][m][n], 0, 0, 0); } } __builtin_amdgcn_s_setprio(0); } while (0)
#define PG8_WAIT_V(n) asm volatile("s_waitcnt vmcnt(" #n ")" ::: "memory")
#define PG8_WAIT_L(n) asm volatile("s_waitcnt lgkmcnt(" #n ")" ::: "memory")
#define PG8_BAR __builtin_amdgcn_s_barrier()
#define PG8_SCHED __builtin_amdgcn_sched_barrier(0)
    Unit cur, nxt; int ui = 0;
    if (!S.next(0, cur)) return;
    f32x4 acc[2][2][4][2];
#pragma unroll
    for (int a = 0; a < 2; ++a)
#pragma unroll
        for (int b = 0; b < 2; ++b)
#pragma unroll
            for (int m = 0; m < 4; ++m)
#pragma unroll
                for (int n = 0; n < 2; ++n) acc[a][b][m][n] = (f32x4){0.f, 0.f, 0.f, 0.f};
    bf16x8 At[4][2], B0[2][2], B1[2][2];
    const char* const Ab = S.a_base();
    unsigned vc0[2], vc1[2], vn0[2], vn1[2];
#pragma unroll
    for (int i = 0; i < 2; ++i) { vc0[i] = S.a_off(cur, sR[i], sC[i]); vc1[i] = S.a_off(cur, HALF + sR[i], sC[i]); }
    const char* cB = S.b_ptr(cur);
    PG8_STAGE(PG8_SB(0, 0), cB, voffB); PG8_STAGE(PG8_SB(0, 1), cB + hstepB, voffB); PG8_STAGE(PG8_SA(0, 0), Ab, vc0); PG8_STAGE(PG8_SA(0, 1), Ab, vc1);
    if (wr == 1) PG8_BAR;
    PG8_WAIT_V(2); PG8_BAR;
    PG8_STAGE(PG8_SB(1, 0), cB + kstep, voffB); PG8_STAGE(PG8_SA(1, 0), Ab + kstep, vc0); PG8_STAGE(PG8_SB(1, 1), cB + hstepB + kstep, voffB);
    PG8_WAIT_V(6); PG8_BAR;
    for (;;) {
        const bool has_next = S.next(ui + 1, nxt);
        const char* nB = has_next ? S.b_ptr(nxt) : cB;
#pragma unroll
        for (int i = 0; i < 2; ++i) { vn0[i] = has_next ? S.a_off(nxt, sR[i], sC[i]) : vc0[i]; vn1[i] = has_next ? S.a_off(nxt, HALF + sR[i], sC[i]) : vc1[i]; }
#pragma unroll 1
        for (int t = 0; t < nt; t += 2) {
            const bool last = (t == nt - 2);
            const char* a1 = Ab + (size_t)(t + 1) * kstep;
            const char* a2 = last ? Ab : Ab + (size_t)(t + 2) * kstep; const char* b2 = last ? nB : cB + (size_t)(t + 2) * kstep;
            const char* a3 = a2 + kstep; const char* b3 = b2 + kstep;
            unsigned v20[2], v21[2];
#pragma unroll
            for (int i = 0; i < 2; ++i) { v20[i] = last ? vn0[i] : vc0[i]; v21[i] = last ? vn1[i] : vc1[i]; }
            PG8_LDB(B0, 0, 0); PG8_LDB(B1, 0, 1); PG8_SCHED; PG8_LDA(At, 0, 0); PG8_STAGE(PG8_SA(1, 1), a1, vc1);
            PG8_WAIT_V(8); PG8_WAIT_L(0); PG8_BAR; PG8_MMA(0, 0, At, B0); PG8_MMA(0, 1, At, B1); PG8_BAR; PG8_SCHED;
            PG8_LDA(At, 0, 1); PG8_STAGE(PG8_SB(0, 0), b2, voffB); PG8_STAGE(PG8_SB(0, 1), b2 + hstepB, voffB); PG8_STAGE(PG8_SA(0, 0), a2, v20);
            PG8_WAIT_V(8); PG8_WAIT_L(0); PG8_BAR; PG8_MMA(1, 0, At, B0); PG8_MMA(1, 1, At, B1); PG8_BAR; PG8_SCHED;
            PG8_LDB(B0, 1, 0); PG8_LDB(B1, 1, 1); PG8_SCHED; PG8_LDA(At, 1, 0); PG8_STAGE(PG8_SA(0, 1), a2, v21);
            PG8_WAIT_V(8); PG8_WAIT_L(0); PG8_BAR; PG8_MMA(0, 0, At, B0); PG8_MMA(0, 1, At, B1); PG8_BAR; PG8_SCHED;
            PG8_LDA(At, 1, 1); PG8_STAGE(PG8_SB(1, 0), b3, voffB); PG8_STAGE(PG8_SB(1, 1), b3 + hstepB, voffB); PG8_STAGE(PG8_SA(1, 0), a3, v20);
            PG8_WAIT_V(8); PG8_WAIT_L(0); PG8_BAR; PG8_MMA(1, 0, At, B0); PG8_MMA(1, 1, At, B1); PG8_BAR; PG8_SCHED;
        }
        if (wr == 0) PG8_BAR;
        E(acc, cur, wr, wc, fr, fq);
        if (!has_next) break;
#pragma unroll
        for (int a = 0; a < 2; ++a)
#pragma unroll
            for (int b = 0; b < 2; ++b)
#pragma unroll
                for (int m = 0; m < 4; ++m)
#pragma unroll
                    for (int n = 0; n < 2; ++n) acc[a][b][m][n] = (f32x4){0.f, 0.f, 0.f, 0.f};
        cur = nxt; cB = nB; ++ui;
#pragma unroll
        for (int i = 0; i < 2; ++i) { vc0[i] = vn0[i]; vc1[i] = vn1[i]; }
        if (wr == 1) PG8_BAR;
    }
    PG8_WAIT_V(0);
    PG8_BAR;
#undef PG8_SA
#undef PG8_SB
#undef PG8_STAGE
#undef PG8_LDA
#undef PG8_LDB
#undef PG8_MMA
#undef PG8_F8
#undef PG8_WAIT_V
#undef PG8_WAIT_L
#undef PG8_BAR
#undef PG8_SCHED
}
}

#define XB_TMO      128
#define XB_XCNT(j)  (256  + 64 * (j))
#define XB_XSUB(j)  (1280 + 64 * (j))
#define XB_XGEN(j)  (2304 + 64 * (j))
#define XB_TOP      3328
#define XB_TOPGEN   3392
#define XCD_BAR_WORDS 3456
#define XB_SPIN_CAP (1u << 21)
__device__ __forceinline__ unsigned xb_ld(unsigned* p)              { return __hip_atomic_load(p, __ATOMIC_RELAXED, __HIP_MEMORY_SCOPE_AGENT); }
__device__ __forceinline__ unsigned xb_add(unsigned* p, unsigned v) { return __hip_atomic_fetch_add(p, v, __ATOMIC_RELAXED, __HIP_MEMORY_SCOPE_AGENT); }
__device__ __forceinline__ unsigned xb_xcc_id() { return (unsigned)__builtin_amdgcn_s_getreg((3 << 11) | 20) & 0xFu; }
#define XB_SPIN(cond, bar) do { unsigned _sp = 0; while (cond) { __builtin_amdgcn_s_sleep(1); \
    if ((++_sp & 255u) == 0u) { if (xb_ld(&(bar)[XB_TMO])) break; if (_sp > XB_SPIN_CAP) { atomicAdd(&(bar)[XB_TMO], 1u); break; } } } } while (0)
struct XcdBarrier { unsigned* bar; unsigned x; volatile LAS unsigned* st; };
__device__ __forceinline__ XcdBarrier xcd_barrier_post(unsigned* bar, volatile LAS unsigned* st) {
    XcdBarrier b; b.bar = bar; b.x = xb_xcc_id(); b.st = st;
    if (threadIdx.x == 0) (void)xb_add(&bar[XB_XCNT(b.x)], 1u);
    return b;
}
__device__ __forceinline__ void xcd_barrier_complete(unsigned* bar, unsigned x, unsigned& nloc, unsigned& nx) {
    const unsigned G = gridDim.x * gridDim.y * gridDim.z;
    unsigned sum, cnt, mine, sp = 0u;
    for (;;) {
        sum = 0u; cnt = 0u; mine = 0u;
#pragma unroll
        for (unsigned j = 0; j < 16; ++j) { const unsigned c = xb_ld(&bar[XB_XCNT(j)]); sum += c; cnt += (c > 0u) ? 1u : 0u; mine = (j == x) ? c : mine; }
        if (sum == G) break;
        __builtin_amdgcn_s_sleep(1);
        if ((++sp & 255u) == 0u) { if (xb_ld(&bar[XB_TMO])) break; if (sp > XB_SPIN_CAP) { atomicAdd(&bar[XB_TMO], 1u); break; } }
    }
    nloc = mine > 0u ? mine : 1u; nx = cnt > 0u ? cnt : 1u;
}
__device__ __forceinline__ void xcd_barrier(const XcdBarrier& b) {
    asm volatile("s_waitcnt vmcnt(0)" ::: "memory");
    __syncthreads();
    if (threadIdx.x == 0) {
        unsigned* bar = b.bar;
        __builtin_amdgcn_s_waitcnt(0);
        unsigned nloc = b.st[0], nx = b.st[1];
        if (nloc == 0u) { xcd_barrier_complete(bar, b.x, nloc, nx); b.st[0] = nloc; b.st[1] = nx; }
        const unsigned old = xb_add(&bar[XB_XSUB(b.x)], 1u);
        const unsigned gen = old / nloc;
        if (old + 1u == (gen + 1u) * nloc) {
            __builtin_amdgcn_fence(__ATOMIC_RELEASE, "agent");
            asm volatile("s_waitcnt vmcnt(0)" ::: "memory");
            const unsigned og = xb_add(&bar[XB_TOP], 1u);
            const unsigned tg = og / nx;
            if (og + 1u == (tg + 1u) * nx) xb_add(&bar[XB_TOPGEN], 1u);
            else XB_SPIN(xb_ld(&bar[XB_TOPGEN]) == tg, bar);
            __builtin_amdgcn_fence(__ATOMIC_ACQUIRE, "agent");
            xb_add(&bar[XB_XGEN(b.x)], 1u);
            asm volatile("s_waitcnt vmcnt(0)" ::: "memory");
        } else {
            XB_SPIN(xb_ld(&bar[XB_XGEN(b.x)]) == gen, bar);
            __builtin_amdgcn_fence(__ATOMIC_ACQUIRE, "agent");
            asm volatile("s_waitcnt vmcnt(0)" ::: "memory");
        }
    }
    __syncthreads();
}

constexpr size_t MiB = 1u << 20;
constexpr size_t UNIT_B = (size_t)MROWS * 1024 * 2;
constexpr size_t WS_CTL = 0, CTL_ZERO_BYTES = 64 * 1024;
constexpr int CW_TMO = 0, CW_BAR = 4096, CW_CNT = 8192;
constexpr size_t W_MI = 1 * MiB;
constexpr size_t W_UQ = W_MI + (size_t)MLA_INP * 1024 * 2;
constexpr size_t W_UKV = W_UQ + (size_t)1536 * 384 * 2;
constexpr size_t W_OM = W_UKV + (size_t)2048 * 256 * 2;
constexpr size_t W_GI = W_OM + (size_t)1024 * 1024 * 2;
constexpr size_t W_OG = W_GI + (size_t)GLA_INP * 1024 * 2;
constexpr size_t W_GU = W_OG + (size_t)1024 * 1024 * 2;
constexpr size_t W_D = W_GU + (size_t)2 * 32 * 512 * 1024 * 2;
constexpr size_t W_END = W_D + (size_t)2 * 32 * 1024 * 256 * 2;
static_assert(W_END <= 112 * MiB, "weights");
constexpr size_t S_SSQ_Q = 112 * MiB;
constexpr size_t S_SSQ_KV = S_SSQ_Q + (size_t)MROWS * 4;
constexpr size_t S_HMETA = S_SSQ_KV + (size_t)MROWS * 4;
constexpr size_t S_GLR = S_HMETA + (size_t)256 * 1024 * 4;
constexpr size_t S_GAM = S_GLR + (size_t)MROWS * 16 * 4;
constexpr size_t S_LIST = S_GAM + (size_t)NB * GH * NTILE * 128 * 4;
constexpr size_t S_WTS = S_LIST + (size_t)NEXP * MROWS * 4;
constexpr size_t S_PART = S_WTS + (size_t)2 * MROWS * 4;
constexpr size_t S_EPOS = S_PART + (size_t)MROWS * 24 * 4;
constexpr size_t S_END = S_EPOS + (size_t)2 * MROWS * 4;
static_assert(S_END <= 124 * MiB, "small buffers");
constexpr size_t ACT0 = 124 * MiB;
constexpr size_t A_HN = ACT0;
constexpr size_t A_K = ACT0;
constexpr size_t V8_OFF = (size_t)NB * NHEAD * NTILE * 8192;
constexpr size_t A_BST = ACT0 + 4 * UNIT_B;
constexpr size_t A_WOM8 = ACT0 + UNIT_B * 19 / 4;
constexpr size_t A_O8 = ACT0 + UNIT_B * 15 / 4;
constexpr size_t A_K0 = ACT0 + UNIT_B;
constexpr size_t A_ZMLA = ACT0 + UNIT_B * 3 / 2;
constexpr size_t A_QRAW = ACT0 + UNIT_B * 9 / 4;
constexpr size_t A_KNRAW = ACT0 + UNIT_B * 15 / 4;
constexpr size_t A_O = A_KNRAW;
constexpr size_t A_RSL = ACT0;
constexpr size_t A_HID = ACT0 + UNIT_B;
constexpr size_t A_Y = ACT0 + 2 * UNIT_B;
constexpr size_t A_HN2 = ACT0 + 4 * UNIT_B;
constexpr size_t A_HB = ACT0 + 5 * UNIT_B;
constexpr size_t A_ZQK = ACT0;
constexpr size_t A_ZV = ACT0 + UNIT_B;
constexpr size_t A_ZR = ACT0 + 2 * UNIT_B;
constexpr size_t A_QT = ACT0 + 3 * UNIT_B;
constexpr size_t A_ATT = ACT0 + UNIT_B * 7 / 2;
constexpr size_t A_OG = ACT0;
constexpr size_t WS_END = ACT0 + 6 * UNIT_B;
static_assert(WS_END <= 512 * MiB, "workspace map");
static_assert(A_ATT + (size_t)NB * GH * NTILE * 4096 * 2 <= A_HN2, "att");
static_assert(A_HID + (size_t)74240 * 256 * 2 <= A_Y, "hid");
constexpr int HID_TILES_MAX = 290;

constexpr int RING_OFF = 0;
constexpr int LDSCTL_OFF = 139264, MISC_OFF = LDSCTL_OFF;
constexpr int LDS_BYTES = 147456;

struct Args {
    const float* in[24]; float* out; unsigned char* ws; int ph_lo, ph_hi;
};
struct Frame {
    unsigned char* lds; volatile LAS unsigned* MISC; unsigned* ctl; unsigned char* ws;
    int tid, lane, wave, vcu, G;
    float* out;
};
#define FIN(i) (args.in[i])
enum { I_X = 0, I_META, I_NMIX, I_NFFN, I_MWIN, I_MGQ, I_MWUQ, I_MGKV, I_MWUKV, I_MGQN, I_MGKN, I_MWO, I_GWIN, I_GWGU, I_GBG, I_GGOUT, I_GWO, I_RWG, I_RBG, I_RWE, I_RBE, I_EWG, I_EWU, I_EWD };

struct TrItem { const float* src; int ok; int ldw; const float* gk; int k0; bf16* dst; int Kdst; float f8; };
__device__ __forceinline__ TrItem tr_make(const float* W0, int c0, int n0v, const float* W1, int c1, int n1v, int ldw, const float* gk, int k0, bf16* dst, int Kdst, int lane) {
    const int r = lane >> 3, c4 = lane & 7; TrItem t;
    t.src = (c4 < 4 ? W0 + c0 + 4 * c4 : W1 + c1 + 4 * (c4 - 4)) + (size_t)(k0 + r) * ldw; t.ok = c4 < 4 ? (n0v > 0) : (n1v > 0); t.ldw = ldw; t.gk = gk; t.k0 = k0; t.dst = dst; t.Kdst = Kdst; t.f8 = 0.f; return t;
}
__device__ __forceinline__ TrItem tr_make_plain(const float* W, int K, int N, const float* gk, bf16* dst, int item, int lane) {
    const int kb = item % (K / 64), nb = item / (K / 64); const int c0 = 32 * nb, c1 = c0 + 16;
    int n0v = N - c0; n0v = n0v < 0 ? 0 : (n0v > 16 ? 16 : n0v); int n1v = N - c1; n1v = n1v < 0 ? 0 : (n1v > 16 ? 16 : n1v);
    return tr_make(W, c0, n0v, W, c1, n1v, N, gk, 64 * kb, dst + (size_t)32 * nb * K, K, lane);
}
__device__ __forceinline__ void tr_load(const TrItem& t, f32x4 (&v)[8]) {
#pragma unroll
    for (int i = 0; i < 8; ++i) v[i] = t.ok ? *(const f32x4*)(t.src + (size_t)(8 * i) * t.ldw) : (f32x4){0.f, 0.f, 0.f, 0.f};
}
__device__ __forceinline__ void tr_finish(const TrItem& t, const f32x4 (&v)[8], float* scr, int lane) {
    const int r = lane >> 3, c4 = lane & 7;
#pragma unroll
    for (int i = 0; i < 8; ++i) { const int kk = 8 * i + r; f32x4 w = v[i]; if (t.gk) w = w * t.gk[t.k0 + kk];
        float* d = scr + kk * 33 + 4 * c4; d[0] = w.x; d[1] = w.y; d[2] = w.z; d[3] = w.w; }
    LDS_WAIT(); asm volatile("" ::: "memory");
    int c = lane & 7; asm volatile("" : "+v"(c));
#pragma unroll
    for (int j4 = 0; j4 < 4; ++j4) { const int n = (lane >> 3) + 8 * j4; const float* sp = scr + (8 * c) * 33 + n;
        if (t.f8 > 0.f) { const float f = t.f8; *(u32x2*)((unsigned char*)t.dst + (size_t)n * t.Kdst + t.k0 + 8 * c) = (u32x2){pk4_e4m3(sp[0 * 33] * f, sp[1 * 33] * f, sp[2 * 33] * f, sp[3 * 33] * f), pk4_e4m3(sp[4 * 33] * f, sp[5 * 33] * f, sp[6 * 33] * f, sp[7 * 33] * f)}; }
        else { u32x4 o; o.x = pk2(sp[0 * 33], sp[1 * 33]); o.y = pk2(sp[2 * 33], sp[3 * 33]); o.z = pk2(sp[4 * 33], sp[5 * 33]); o.w = pk2(sp[6 * 33], sp[7 * 33]);
            *(u32x4*)(t.dst + (size_t)n * t.Kdst + t.k0 + 8 * c) = o; } }
    LDS_WAIT(); asm volatile("" ::: "memory");
}

template <bool FIRST, bool COMBINE, bool WRITE_HN>
__device__ __forceinline__ void norm_rows(const Args& args, Frame& F, const float* gain, bf16* hn, const bf16* y, bf16* hb) {
    const int gw = F.vcu * NWAVES + F.wave, NGW = F.G * NWAVES, lane = F.lane;
    f32x4 g4[4];
    if (WRITE_HN) {
#pragma unroll
        for (int j = 0; j < 4; ++j) g4[j] = *(const f32x4*)(gain + 4 * lane + 256 * j);
    }
    f32x4 va[4], vb[4]; u32x2 ha[4], hbq[4], ya0[4], ya1[4], yb0[4], yb1[4];
#define NR_LOAD(r_, v_, h_, y0_, y1_) do { if (!row_is_dummy(r_)) { \
            if (FIRST) { const float* src_ = (r_) < NREAL ? FIN(I_X) + (size_t)(r_) * 1024 : FIN(I_META) + (size_t)((((r_) - NREAL) & 63) - 48) * 1024; \
                _Pragma("unroll") for (int j = 0; j < 4; ++j) v_[j] = *(const f32x4*)(src_ + 4 * lane + 256 * j); } \
            else { _Pragma("unroll") for (int j = 0; j < 4; ++j) h_[j] = *(const u32x2*)(hb + (size_t)(r_) * 1024 + 4 * lane + 256 * j); } \
            if (COMBINE) { _Pragma("unroll") for (int j = 0; j < 4; ++j) { y0_[j] = *(const u32x2*)(y + (size_t)(2 * (r_)) * 1024 + 4 * lane + 256 * j); y1_[j] = *(const u32x2*)(y + (size_t)(2 * (r_) + 1) * 1024 + 4 * lane + 256 * j); } } } } while (0)
    if (gw < MROWS) NR_LOAD(gw, va, ha, ya0, ya1);
    for (int r = gw; r < MROWS; r += NGW) {
        const int rn = r + NGW;
        if (rn < MROWS) NR_LOAD(rn, vb, hbq, yb0, yb1);
        if (row_is_dummy(r)) {
            if (WRITE_HN) {
#pragma unroll
                for (int j = 0; j < 4; ++j) *(u32x2*)(hn + (size_t)r * 1024 + 4 * lane + 256 * j) = (u32x2){0u, 0u};
            }
        } else {
            f32x4 v[4];
#pragma unroll
            for (int j = 0; j < 4; ++j) { if (FIRST) v[j] = va[j]; else { const u32x2 q = ha[j]; v[j] = (f32x4){bf2f(q.x & 0xffff), bf2f(q.x >> 16), bf2f(q.y & 0xffff), bf2f(q.y >> 16)}; } }
            if (COMBINE) {
#pragma unroll
                for (int j = 0; j < 4; ++j) { const u32x2 a = ya0[j], b = ya1[j];
                    v[j].x += bf2f(a.x & 0xffff) + bf2f(b.x & 0xffff); v[j].y += bf2f(a.x >> 16) + bf2f(b.x >> 16);
                    v[j].z += bf2f(a.y & 0xffff) + bf2f(b.y & 0xffff); v[j].w += bf2f(a.y >> 16) + bf2f(b.y >> 16); }
#pragma unroll
                for (int j = 0; j < 4; ++j) { u32x2 o; o.x = pk2(v[j].x, v[j].y); o.y = pk2(v[j].z, v[j].w); *(u32x2*)(hb + (size_t)r * 1024 + 4 * lane + 256 * j) = o;
                    v[j] = (f32x4){bf2f(o.x & 0xffff), bf2f(o.x >> 16), bf2f(o.y & 0xffff), bf2f(o.y >> 16)}; }
            }
            if (WRITE_HN) {
                float s = 0.f;
#pragma unroll
                for (int j = 0; j < 4; ++j) s += (v[j].x * v[j].x + v[j].y * v[j].y) + (v[j].z * v[j].z + v[j].w * v[j].w);
                const float rstd = rsqrtf(wave_sum(s) * (1.f / 1024.f) + EPS);
#pragma unroll
                for (int j = 0; j < 4; ++j) { u32x2 o; o.x = pk2(v[j].x * rstd * g4[j].x, v[j].y * rstd * g4[j].y); o.y = pk2(v[j].z * rstd * g4[j].z, v[j].w * rstd * g4[j].w);
                    *(u32x2*)(hn + (size_t)r * 1024 + 4 * lane + 256 * j) = o; }
            }
        }
#pragma unroll
        for (int j = 0; j < 4; ++j) { va[j] = vb[j]; ha[j] = hbq[j]; ya0[j] = yb0[j]; ya1[j] = yb1[j]; }
    }
#undef NR_LOAD
}

constexpr int GU_ITEMS = 32 * 256, WD_ITEMS = 32 * 128, WGI_ITEMS = 16 * 104;
__device__ __forceinline__ TrItem gu_item(const Args& args, unsigned char* ws, int layer, int it, int lane) {
    const int le = layer * 32 + (it >> 8), q = it & 255, kb = q % 16, nb = q / 16; const int pn = nb >> 3, bj = (nb >> 2) & 1, wc = nb & 3, hc0 = 128 * pn + 64 * bj + 16 * wc;
    return tr_make(FIN(I_EWG) + (size_t)le * 1024 * 256, hc0, 16, FIN(I_EWU) + (size_t)le * 1024 * 256, hc0, 16, 256, FIN(I_NFFN) + layer * 1024, 64 * kb, (bf16*)(ws + W_GU) + ((size_t)le * 512 + 32 * nb) * 1024, 1024, lane);
}
__device__ __forceinline__ TrItem wd_item(const Args& args, unsigned char* ws, int layer, int it, int lane) {
    const int le = layer * 32 + it / 128, q = it % 128;
    return tr_make_plain(FIN(I_EWD) + (size_t)le * 256 * 1024, 256, 1024, nullptr, (bf16*)(ws + W_D) + (size_t)le * 1024 * 256, q, lane);
}
__device__ __forceinline__ TrItem wgi_item(const Args& args, unsigned char* ws, int r, int lane) {
    const int kb = r % 16, nb = r / 16; const float* W = FIN(I_GWIN); int c0, n0v, c1, n1v;
    if (nb < 64) { c0 = 32 * nb; n0v = 16; c1 = c0 + 16; n1v = 16; }
    else if (nb < 96) { c0 = 2064 + 32 * (nb - 64); n0v = 16; c1 = c0 + 16; n1v = 16; }
    else if (nb == 96) { c0 = 2048; n0v = 16; c1 = 0; n1v = 0; }
    else { c0 = 0; n0v = 0; c1 = 0; n1v = 0; }
    return tr_make(W, c0, n0v, W, c1, n1v, GLA_IN, FIN(I_NMIX) + 1024, 64 * kb, (bf16*)(ws + W_GI) + (size_t)32 * nb * 1024, 1024, lane);
}
constexpr int D1_ITEMS = GU_ITEMS + WGI_ITEMS, D7_ITEMS = WD_ITEMS + GU_ITEMS, D16_ITEMS = WD_ITEMS;
template <int SET> __device__ __forceinline__ TrItem def_item(const Args& args, unsigned char* ws, int it, int lane) {
    if (SET == 1) return it < GU_ITEMS ? gu_item(args, ws, 0, it, lane) : wgi_item(args, ws, it - GU_ITEMS, lane);
    if (SET == 7) return it < WD_ITEMS ? wd_item(args, ws, 0, it, lane) : gu_item(args, ws, 1, it - WD_ITEMS, lane);
    return wd_item(args, ws, 1, it, lane);
}
template <int SET> __device__ __forceinline__ void def_convert(const Args& args, Frame& F, int first, int stride, int limit, int maxn) {
    float* scr = (float*)(F.lds + RING_OFF + F.wave * 16384); const int lane = F.lane;
    if (first >= limit || maxn <= 0) return;
    TrItem cur = def_item<SET>(args, F.ws, first, lane); f32x4 va[8]; tr_load(cur, va);
    int n = 1;
    for (int it = first; ; ) {
        const int nx = it + stride; const bool more = nx < limit && n < maxn; TrItem nxt = cur; f32x4 vb[8];
        if (more) { nxt = def_item<SET>(args, F.ws, nx, lane); tr_load(nxt, vb); }
        tr_finish(cur, va, scr, lane);
        if (!more) break;
#pragma unroll
        for (int i = 0; i < 8; ++i) va[i] = vb[i];
        cur = nxt; it = nx; ++n;
    }
}
template <int SET> __device__ __forceinline__ void def_fill_idle(const Args& args, Frame& F, int tot, int nitems, int per_wave, bool rest) {
    const int maxu = (tot + F.G - 1) / F.G, thr = tot - (maxu - 1) * F.G, nfill = F.G - thr;
    int cov = nfill > 0 ? nfill * NWAVES * per_wave : 0; cov = cov < nitems ? cov : nitems;
    if (F.vcu >= thr && nfill > 0) def_convert<SET>(args, F, (F.vcu - thr) * NWAVES + F.wave, nfill * NWAVES, cov, per_wave);
    if (rest) def_convert<SET>(args, F, cov + F.vcu * NWAVES + F.wave, F.G * NWAVES, nitems, 1 << 30);
}
constexpr int P1_FILL_PER_WAVE = 10;
constexpr int P7_FILL_PER_WAVE = 4;
constexpr int P7_FILL2_PER_WAVE = 6;

__device__ __forceinline__ void p0_prologue(const Args& args, Frame& F) {
    float* scr = (float*)(F.lds + RING_OFF + F.wave * 16384);
    const int gw = F.vcu * NWAVES + F.wave, NGW = F.G * NWAVES, lane = F.lane;
    unsigned char* ws = F.ws;
    constexpr int I0 = 16 * 24, I1 = 6 * 48, I2 = 4 * 64, I3 = 16 * 32, I5 = 16 * 32, I6 = 16 * 32;
    const int nfill1 = (F.G == 256) ? (2 * 256 - 387) * NWAVES * P1_FILL_PER_WAVE : 0;
    const int D1_COV = nfill1 < D1_ITEMS ? nfill1 : D1_ITEMS;
    const int NITEMS = I0 + I1 + I2 + I3 + I5 + I6 + (D1_ITEMS - D1_COV);
    auto make = [&](int it) -> TrItem {
        int r = it;
        if (r < I0) return tr_make_plain(FIN(I_MWIN), 1024, MLA_IN, nullptr, (bf16*)(ws + W_MI), r, lane); r -= I0;
        if (r < I1) return tr_make_plain(FIN(I_MWUQ), MLA_Q, 1536, FIN(I_MGQ), (bf16*)(ws + W_UQ), r, lane); r -= I1;
        if (r < I2) {
            const int kb = r % 4, nb = r / 4; int c0;
            if (nb < 32) { const int pn = nb >> 3, bj = (nb >> 2) & 1, wc = nb & 3; c0 = (4 * pn + wc) * 128 + 32 * bj; } else { const int j = nb - 32; c0 = (j >> 1) * 128 + 64 + 32 * (j & 1); }
            return tr_make(FIN(I_MWUKV), c0, 16, FIN(I_MWUKV), c0 + 16, 16, 2048, FIN(I_MGKV), 64 * kb, (bf16*)(ws + W_UKV) + (size_t)32 * nb * MLA_KV, MLA_KV, lane); } r -= I2;
        if (r < I3) return tr_make_plain(FIN(I_MWO), 1024, 1024, nullptr, (bf16*)(ws + W_OM), r, lane); r -= I3;
        if (r < I5) return tr_make_plain(FIN(I_GWO), 1024, 1024, nullptr, (bf16*)(ws + W_OG), r, lane); r -= I5;
        if (r < I6) { const int kb = r % 16, nb = r / 16; TrItem t8 = tr_make(FIN(I_MWO), 32 * nb, 16, FIN(I_MWO), 32 * nb + 16, 16, 1024, nullptr, 64 * kb, (bf16*)(ws + A_WOM8 + (size_t)32 * nb * 1024), 1024, lane); t8.f8 = W_SC; return t8; } r -= I6;
        return def_item<1>(args, ws, D1_COV + r, lane);
    };
    if (gw < NITEMS) {
        TrItem cur = make(gw); f32x4 va[8]; tr_load(cur, va);
        for (int it = gw; it < NITEMS; it += NGW) {
            const int nx = it + NGW; TrItem nxt = cur; f32x4 vb[8];
            if (nx < NITEMS) { nxt = make(nx); tr_load(nxt, vb); }
            tr_finish(cur, va, scr, lane);
            if (nx < NITEMS) {
#pragma unroll
                for (int i = 0; i < 8; ++i) va[i] = vb[i];
                cur = nxt; }
        }
    }
    { unsigned* vz = (unsigned*)F.out; for (int i = blockIdx.x * NTHREADS + F.tid; i < 64 * 2 * 48 * 16; i += F.G * NTHREADS) { const int w16 = i & 15, r = (i >> 4) % 48, dh = ((i >> 4) / 48) & 1, bh = (i >> 4) / 96;
        vz[((((size_t)bh * NTILE + 0) * 2 + dh) * 64 + r) * 16 + w16] = 0u; } }
    { unsigned* hz = (unsigned*)(ws + A_HB + (size_t)NREAL * 1024 * 2); for (int i = blockIdx.x * NTHREADS + F.tid; i < 256 * 512; i += F.G * NTHREADS) { if (((i >> 9) & 63) < 48) hz[i] = 0u; } }
    norm_rows<true, false, true>(args, F, FIN(I_NMIX), (bf16*)(ws + A_HN), nullptr, (bf16*)(ws + A_HB));
}

struct EpiZmla {
    static constexpr bool PERM = true; static constexpr bool ADJ = false; static constexpr bool F8 = false;
    bf16* Z; float* part;
    __device__ __forceinline__ void operator()(const f32x4 (&acc)[2][2][4][2], const pg8::Unit& u, int wr, int wc, int fr, int fq) const {
#pragma unroll
        for (int ai = 0; ai < 2; ++ai)
#pragma unroll
            for (int m = 0; m < 4; ++m) { __builtin_amdgcn_sched_barrier(0);
                const int row = u.pm * 256 + ai * 128 + wr * 64 + m * 16 + fr;
#pragma unroll
                for (int bj = 0; bj < 2; ++bj) {
                    const f32x4 v0 = acc[ai][bj][m][0], v1 = acc[ai][bj][m][1];
                    const int col = u.pn * 256 + bj * 128 + wc * 32 + 8 * fq;
                    u32x4 w; w.x = pk2(v0[0], v0[1]); w.y = pk2(v0[2], v0[3]); w.z = pk2(v1[0], v1[1]); w.w = pk2(v1[2], v1[3]);
                    *(u32x4*)(Z + (size_t)row * MLA_INP + col) = w;
                    const int cb = u.pn * 256 + bj * 128;
                    if (cb < 768) {
                        float s = (v0[0] * v0[0] + v0[1] * v0[1]) + (v0[2] * v0[2] + v0[3] * v0[3]) + (v1[0] * v1[0] + v1[1] * v1[1]) + (v1[2] * v1[2] + v1[3] * v1[3]);
                        s += __shfl_xor(s, 16); s += __shfl_xor(s, 32);
                        if (fq == 0) part[(size_t)row * 24 + (cb >> 7) * 4 + wc] = s;
                    }
                }
            }
    }
};
struct EpiQ {
    static constexpr bool PERM = true; static constexpr bool ADJ = false; static constexpr bool F8 = false;
    bf16* Q; const float* ssq;
    __device__ __forceinline__ void operator()(const f32x4 (&acc)[2][2][4][2], const pg8::Unit& u, int wr, int wc, int fr, int fq) const {
        float rsv[8];
#pragma unroll
        for (int i = 0; i < 8; ++i) { const int row = u.pm * 256 + (i >> 2) * 128 + wr * 64 + (i & 3) * 16 + fr;
            const f32x4 pa = *(const f32x4*)(ssq + (size_t)row * 24), pb = *(const f32x4*)(ssq + (size_t)row * 24 + 4), pc = *(const f32x4*)(ssq + (size_t)row * 24 + 8);
            rsv[i] = rsqrtf((((pa[0] + pa[1]) + (pa[2] + pa[3])) + ((pb[0] + pb[1]) + (pb[2] + pb[3])) + ((pc[0] + pc[1]) + (pc[2] + pc[3]))) * (1.f / MLA_Q) + EPS); }
#pragma unroll
        for (int ai = 0; ai < 2; ++ai)
#pragma unroll
            for (int m = 0; m < 4; ++m) { __builtin_amdgcn_sched_barrier(0);
                const int row = u.pm * 256 + ai * 128 + wr * 64 + m * 16 + fr;
                const float rs = rsv[ai * 4 + m];
#pragma unroll
                for (int bj = 0; bj < 2; ++bj) {
                    const f32x4 v0 = acc[ai][bj][m][0] * rs, v1 = acc[ai][bj][m][1] * rs;
                    const int col = u.pn * 256 + bj * 128 + wc * 32 + 8 * fq;
                    u32x4 w; w.x = pk2(v0[0], v0[1]); w.y = pk2(v0[2], v0[3]); w.z = pk2(v1[0], v1[1]); w.w = pk2(v1[2], v1[3]);
                    *(u32x4*)(Q + (size_t)row * 1536 + col) = w;
                }
            }
    }
};
struct EpiKV {
    static constexpr bool PERM = true; static constexpr bool ADJ = false; static constexpr bool F8 = false;
    bf16* KT; bf16* V; const float* ssq; float* RH; const float* gkn;
    __device__ __forceinline__ void operator()(const f32x4 (&acc)[2][2][4][2], const pg8::Unit& u, int wr, int wc, int fr, int fq) const {
        if (u.pn < 4) {
            const int head = 4 * u.pn + wc;
#pragma unroll
            for (int ai = 0; ai < 2; ++ai)
#pragma unroll
                for (int m = 0; m < 4; ++m) { __builtin_amdgcn_sched_barrier(0);
                    const int row = u.pm * 256 + ai * 128 + wr * 64 + m * 16 + fr;
                    const int b = row >> 13, sfr = row & (SEQ - 1), tile = 1 + (sfr >> 6), r64 = sfr & 63;
                    const f32x4 pa_ = *(const f32x4*)(ssq + (size_t)row * 24 + 12), pb_ = *(const f32x4*)(ssq + (size_t)row * 24 + 16); const float rs = rsqrtf((((pa_[0] + pa_[1]) + (pa_[2] + pa_[3])) + ((pb_[0] + pb_[1]) + (pb_[2] + pb_[3]))) * (1.f / MLA_KV) + EPS);
                    float sq = 0.f;
#pragma unroll
                    for (int bj = 0; bj < 2; ++bj)
#pragma unroll
                        for (int n = 0; n < 2; ++n) { const f32x4 a = acc[ai][bj][m][n]; sq += (a[0] * a[0] + a[1] * a[1]) + (a[2] * a[2] + a[3] * a[3]); }
                    sq += __shfl_xor(sq, 16); sq += __shfl_xor(sq, 32);
                    const float rh = rsqrtf((sq * rs * rs + ssq[(size_t)row * 24 + 20]) * (1.f / QK) + EPS), rr = rs * rh;
                    unsigned char* kt = (unsigned char*)KT + ((size_t)(b * NHEAD + head) * NTILE + tile) * 8192 + r64 * 16 + (fq & 1) * 8;
                    const float rk = rr * KQ_SC;
#pragma unroll
                    for (int bj = 0; bj < 2; ++bj) { const f32x4 g0 = *(const f32x4*)(gkn + 32 * bj + 8 * fq), g1 = *(const f32x4*)(gkn + 32 * bj + 8 * fq + 4);
                        const f32x4 x0 = acc[ai][bj][m][0] * g0 * rk, x1 = acc[ai][bj][m][1] * g1 * rk;
                        *(u32x2*)(kt + (2 * bj + (fq >> 1)) * 1024) = (u32x2){pk4_e4m3(x0[0], x0[1], x0[2], x0[3]), pk4_e4m3(x1[0], x1[1], x1[2], x1[3])}; }
                    if (fq == 0) RH[(size_t)row * NHEAD + head] = rh;
                }
        } else {
#pragma unroll
            for (int ai = 0; ai < 2; ++ai)
#pragma unroll
                for (int m = 0; m < 4; ++m) { __builtin_amdgcn_sched_barrier(0);
                    const int row = u.pm * 256 + ai * 128 + wr * 64 + m * 16 + fr;
                    const f32x4 pa_ = *(const f32x4*)(ssq + (size_t)row * 24 + 12), pb_ = *(const f32x4*)(ssq + (size_t)row * 24 + 16); const float rs = rsqrtf((((pa_[0] + pa_[1]) + (pa_[2] + pa_[3])) + ((pb_[0] + pb_[1]) + (pb_[2] + pb_[3]))) * (1.f / MLA_KV) + EPS);
                    const int b = row >> 13, sfr = row & (SEQ - 1), tile = 1 + (sfr >> 6), r64 = sfr & 63;
#pragma unroll
                    for (int bj = 0; bj < 2; ++bj) {
                        const f32x4 v0 = acc[ai][bj][m][0] * rs, v1 = acc[ai][bj][m][1] * rs;
                        const int colv = (u.pn - 4) * 256 + bj * 128 + wc * 32 + 8 * fq, hv = colv >> 6, d = colv & 63;
                        *(u32x2*)((unsigned char*)V + ((size_t)(b * NHEAD + hv) * NTILE + tile) * 8192 + r64 * 64 + d) = (u32x2){pk4_e4m3(v0[0], v0[1], v0[2], v0[3]), pk4_e4m3(v1[0], v1[1], v1[2], v1[3])};
                    }
                }
        }
    }
};
struct EpiRes {
    static constexpr bool PERM = true; static constexpr bool ADJ = false; static constexpr bool F8 = false;
    const float* x; bf16* hb;
    __device__ __forceinline__ void operator()(const f32x4 (&acc)[2][2][4][2], const pg8::Unit& u, int wr, int wc, int fr, int fq) const {
#pragma unroll
        for (int ai = 0; ai < 2; ++ai)
#pragma unroll
            for (int m = 0; m < 4; ++m) {
                const int row = u.pm * 256 + ai * 128 + wr * 64 + m * 16 + fr;
#pragma unroll
                for (int bj = 0; bj < 2; ++bj) {
                    const int col = u.pn * 256 + bj * 128 + wc * 32 + 8 * fq;
                    f32x4 s0, s1;
                    if (x) { s0 = *(const f32x4*)(x + (size_t)row * 1024 + col); s1 = *(const f32x4*)(x + (size_t)row * 1024 + col + 4); }
                    else { const u32x4 q = *(const u32x4*)(hb + (size_t)row * 1024 + col);
                        s0 = (f32x4){bf2f(q.x & 0xffff), bf2f(q.x >> 16), bf2f(q.y & 0xffff), bf2f(q.y >> 16)}; s1 = (f32x4){bf2f(q.z & 0xffff), bf2f(q.z >> 16), bf2f(q.w & 0xffff), bf2f(q.w >> 16)}; }
                    const f32x4 v0 = s0 + acc[ai][bj][m][0], v1 = s1 + acc[ai][bj][m][1];
                    u32x4 w; w.x = pk2(v0[0], v0[1]); w.y = pk2(v0[2], v0[3]); w.z = pk2(v1[0], v1[1]); w.w = pk2(v1[2], v1[3]);
                    *(u32x4*)(hb + (size_t)row * 1024 + col) = w;
                }
            }
    }
};
struct EpiRes8 {
    static constexpr bool PERM = true; static constexpr bool ADJ = false; static constexpr bool F8 = true;
    const float* x; bf16* hb;
    __device__ __forceinline__ void operator()(const f32x4 (&acc)[2][2][4][2], const pg8::Unit& u, int wr, int wc, int fr, int fq) const {
#pragma unroll
        for (int ai = 0; ai < 2; ++ai)
#pragma unroll
            for (int m = 0; m < 4; ++m) {
                const int row = u.pm * 256 + ai * 128 + wr * 64 + m * 16 + fr;
#pragma unroll
                for (int bj = 0; bj < 2; ++bj) {
                    const int col = u.pn * 256 + bj * 128 + wc * 32 + 8 * fq;
                    const f32x4 s0 = *(const f32x4*)(x + (size_t)row * 1024 + col), s1 = *(const f32x4*)(x + (size_t)row * 1024 + col + 4);
                    const f32x4 v0 = s0 + acc[ai][bj][m][0] * WO_INV, v1 = s1 + acc[ai][bj][m][1] * WO_INV;
                    u32x4 w; w.x = pk2(v0[0], v0[1]); w.y = pk2(v0[2], v0[3]); w.z = pk2(v1[0], v1[1]); w.w = pk2(v1[2], v1[3]);
                    *(u32x4*)(hb + (size_t)row * 1024 + col) = w;
                }
            }
    }
};
struct EpiZgla {
    static constexpr bool PERM = true; static constexpr bool ADJ = false; static constexpr bool F8 = false;
    bf16* ZQK; bf16* ZV; bf16* ZR; float* GLR; const float* RS2;
    __device__ __forceinline__ void operator()(const f32x4 (&acc)[2][2][4][2], const pg8::Unit& u, int wr, int wc, int fr, int fq) const {
        bf16* dst = (bf16*)((char*)ZQK + (size_t)(u.pn >> 2) * UNIT_B); const int cbase = (u.pn & 3) * 256;
        float rsv[8];
#pragma unroll
        for (int i = 0; i < 8; ++i) rsv[i] = RS2[u.pm * 256 + (i >> 2) * 128 + wr * 64 + (i & 3) * 16 + fr];
#pragma unroll
        for (int ai = 0; ai < 2; ++ai)
#pragma unroll
            for (int m = 0; m < 4; ++m) { __builtin_amdgcn_sched_barrier(0);
                const int row = u.pm * 256 + ai * 128 + wr * 64 + m * 16 + fr;
#pragma unroll
                for (int bj = 0; bj < 2; ++bj) {
                    const float rs = rsv[ai * 4 + m]; const f32x4 v0 = acc[ai][bj][m][0] * rs, v1 = acc[ai][bj][m][1] * rs;
                    const int c = bj * 128 + wc * 32 + 8 * fq;
                    if (u.pn < 12) { u32x4 w; w.x = pk2(v0[0], v0[1]); w.y = pk2(v0[2], v0[3]); w.z = pk2(v1[0], v1[1]); w.w = pk2(v1[2], v1[3]); *(u32x4*)(dst + (size_t)row * 1024 + cbase + c) = w; }
                    else if (c < 16) { *(f32x4*)(GLR + (size_t)row * 16 + c) = v0; *(f32x4*)(GLR + (size_t)row * 16 + c + 4) = v1; }
                }
            }
    }
};

struct MoeTables { volatile LAS unsigned* tpre; volatile LAS unsigned* cnt; volatile LAS unsigned* cpre; volatile LAS unsigned* t2e; };
__device__ __forceinline__ MoeTables moe_tables(Frame& F, const unsigned* gcnt) {
    MoeTables T; T.tpre = F.MISC + 16; T.cnt = F.MISC + 64; T.cpre = F.MISC + 112; T.t2e = F.MISC + 160;
    __syncthreads();
    if (F.wave == 0) {
        const int e = F.lane & 31;
        const unsigned cn = __hip_atomic_load(gcnt + e, __ATOMIC_RELAXED, __HIP_MEMORY_SCOPE_AGENT), tl = (cn + 255u) >> 8;
        unsigned st = tl, sc = cn;
#pragma unroll
        for (int dlt = 1; dlt < 32; dlt <<= 1) { const unsigned a = __shfl_up(st, dlt, 32), b = __shfl_up(sc, dlt, 32); if (e >= dlt) { st += a; sc += b; } }
        if (F.lane < 32) { T.cnt[e] = cn; T.tpre[e] = st - tl; T.cpre[e] = sc - cn; if (e == 31) { T.tpre[32] = st; T.cpre[32] = sc; }
            for (unsigned t = 0; t < tl; ++t) T.t2e[st - tl + t] = (unsigned)e | (t << 8); }
    }
    __syncthreads();
    return T;
}
struct MoeSched {
    MoeTables T; int nN, G, c; bool gather;
    const char* A; int lda; const char* Bt; int K; size_t bexp; const int* list;
    __device__ bool next(int i, pg8::Unit& u) const {
        const int total = (int)T.tpre[32] * nN; const int L = i * G + c; if (L >= total) return false;
        const int mt = L >> (nN == 4 ? 2 : 1); u.pn = L & (nN - 1); const unsigned v = T.t2e[mt];
        u.e = (int)(v & 255u); u.pm = (int)(v >> 8); u.r0 = mt; return true;
    }
    __device__ __forceinline__ const char* a_base() const { return A; }
    __device__ __forceinline__ unsigned a_off(const pg8::Unit& u, int r, int c_) const {
        if (gather) { const int pos = u.pm * 256 + r; int tok = NREAL; if (pos < (int)T.cnt[u.e]) tok = list[(size_t)u.e * MROWS + pos] >> 1; return (unsigned)((tok * lda + c_) * 2); }
        return (unsigned)(((u.r0 * 256 + r) * lda + c_) * 2);
    }
    __device__ __forceinline__ const char* b_ptr(const pg8::Unit& u) const { return Bt + (size_t)u.e * bexp + (size_t)u.pn * 256 * K * 2; }
};
struct EpiGU {
    static constexpr bool PERM = false; static constexpr bool ADJ = false; static constexpr bool F8 = false;
    bf16* HID; const float* RSL; volatile LAS unsigned* cnt;
    __device__ __forceinline__ void operator()(const f32x4 (&acc)[2][2][4][2], const pg8::Unit& u, int wr, int wc, int fr, int fq) const {
        const int n_e = (int)cnt[u.e]; const float* rsp = RSL + (size_t)u.e * MROWS + u.pm * 256 + wr * 64 + fr; float rsv[8];
#pragma unroll
        for (int i = 0; i < 8; ++i) { const int off = (i >> 2) * 128 + (i & 3) * 16; rsv[i] = (u.pm * 256 + wr * 64 + fr + off < n_e) ? rsp[off] : 0.f; }
#pragma unroll
        for (int ai = 0; ai < 2; ++ai)
#pragma unroll
            for (int m = 0; m < 4; ++m) { __builtin_amdgcn_sched_barrier(0);
                const int rr = ai * 128 + wr * 64 + m * 16 + fr; const float rs = rsv[ai * 4 + m];
#pragma unroll
                for (int bj = 0; bj < 2; ++bj) {
                    const f32x4 g = acc[ai][bj][m][0] * rs, up = acc[ai][bj][m][1] * rs; float o[4];
#pragma unroll
                    for (int j = 0; j < 4; ++j) o[j] = g[j] * __builtin_amdgcn_rcpf(1.f + __expf(-g[j])) * up[j];
                    u32x2 w; w.x = pk2(o[0], o[1]); w.y = pk2(o[2], o[3]);
                    *(u32x2*)(HID + ((size_t)u.r0 * 256 + rr) * 256 + u.pn * 128 + bj * 64 + wc * 16 + 4 * fq) = w;
                }
            }
    }
};
constexpr float Y_SCALE = 32.f, Y_INV = 1.f / 32.f;
__device__ __forceinline__ unsigned pk4_fp8(const f32x4 v) {
    const float a = __builtin_amdgcn_fmed3f(v[0] * Y_SCALE, -448.f, 448.f), b = __builtin_amdgcn_fmed3f(v[1] * Y_SCALE, -448.f, 448.f), c = __builtin_amdgcn_fmed3f(v[2] * Y_SCALE, -448.f, 448.f), d = __builtin_amdgcn_fmed3f(v[3] * Y_SCALE, -448.f, 448.f);
    int w = 0; w = __builtin_amdgcn_cvt_pk_fp8_f32(a, b, w, false); w = __builtin_amdgcn_cvt_pk_fp8_f32(c, d, w, true); return (unsigned)w;
}
struct EpiDown {
    static constexpr bool PERM = true; static constexpr bool ADJ = true; static constexpr bool F8 = false;
    unsigned char* Y; volatile LAS unsigned* cnt; volatile LAS unsigned* cpre;
    __device__ __forceinline__ void operator()(const f32x4 (&acc)[2][2][4][2], const pg8::Unit& u, int wr, int wc, int fr, int fq) const {
        const int n_e = (int)cnt[u.e]; const size_t base = (size_t)cpre[u.e];
        const bool lo8 = fr < 8;
        unsigned char* const yb = Y + base * 1024 + u.pn * 256 + wc * 64 + (fr >> 3) * 32 + 8 * fq;
#pragma unroll
        for (int ai = 0; ai < 2; ++ai)
#pragma unroll
            for (int m = 0; m < 4; ++m) { __builtin_amdgcn_sched_barrier(0);
                const int pos = u.pm * 256 + ai * 128 + wr * 64 + m * 16 + (fr & 7);
                u32x2 o0, o1, snd, rcv;
                o0.x = pk4_fp8(acc[ai][0][m][0]); o0.y = pk4_fp8(acc[ai][0][m][1]); o1.x = pk4_fp8(acc[ai][1][m][0]); o1.y = pk4_fp8(acc[ai][1][m][1]);
                snd = lo8 ? o1 : o0;
#pragma unroll
                for (int k = 0; k < 2; ++k) rcv[k] = (unsigned)__builtin_amdgcn_update_dpp(0, (int)snd[k], 0x128, 0xf, 0xf, false);
                const u32x2 sa = lo8 ? o0 : rcv, sb = lo8 ? rcv : o1;
                if (pos < n_e) __builtin_nontemporal_store(sa, (u32x2*)(yb + (size_t)pos * 1024));
                if (pos + 8 < n_e) __builtin_nontemporal_store(sb, (u32x2*)(yb + (size_t)(pos + 8) * 1024));
            }
    }
};

__device__ __forceinline__ void unpack8(const u32x4 w, float (&x)[8]) {
    x[0] = bf2f(w.x & 0xffff); x[1] = bf2f(w.x >> 16); x[2] = bf2f(w.y & 0xffff); x[3] = bf2f(w.y >> 16);
    x[4] = bf2f(w.z & 0xffff); x[5] = bf2f(w.z >> 16); x[6] = bf2f(w.w & 0xffff); x[7] = bf2f(w.w >> 16);
}
__device__ __forceinline__ u32x4 pack8(const float (&x)[8]) { u32x4 w; w.x = pk2(x[0], x[1]); w.y = pk2(x[2], x[3]); w.z = pk2(x[4], x[5]); w.w = pk2(x[6], x[7]); return w; }
__device__ __forceinline__ void kprep_phase(const Args& args, Frame& F) {
    const bf16* KN = (const bf16*)(F.ws + A_KNRAW); const bf16* Z = (const bf16*)(F.ws + A_ZMLA); unsigned char* Kt = (unsigned char*)(F.ws + A_K); bf16* K0 = (bf16*)(F.ws + A_K0);
    const float* RH = (const float*)(F.ws + A_KNRAW);
    const float* gkn = FIN(I_MGKN);
    const int gw = F.vcu * NWAVES + F.wave, NGW = F.G * NWAVES, lane = F.lane;
    const u32x4 zero4 = {0u, 0u, 0u, 0u};
    for (int task = gw; task < (NREAL / 64) * NHEAD; task += NGW) {
        const int rt = task / NHEAD, h = task % NHEAD; const int row = rt * 64 + lane;
        const int b = row >> 13, sfr = row & (SEQ - 1), tile = 1 + (sfr >> 6), r64 = sfr & 63;
        u32x4 raw[4];
#pragma unroll
        for (int c = 0; c < 4; ++c) raw[c] = *(const u32x4*)(Z + (size_t)row * MLA_INP + 640 + 8 * c);
        const float rh = RH[(size_t)row * NHEAD + h] * KQ_SC;
        unsigned char* dst = Kt + ((size_t)(b * NHEAD + h) * NTILE + tile) * 8192 + r64 * 16;
        const float pos = (float)(16 + sfr);
        u32x4 c4, c5;
#pragma unroll
        for (int c = 0; c < 2; ++c) {
            float x1[8], x2[8]; unpack8(raw[c], x1); unpack8(raw[2 + c], x2);
#pragma unroll
            for (int e = 0; e < 8; ++e) { const int i = 8 * c + e; float sn, cs; fast_sincos(pos * ROPE_INV[i], sn, cs);
                const float a = x1[e] * rh * gkn[64 + i], bq = x2[e] * rh * gkn[80 + i]; x1[e] = a * cs - bq * sn; x2[e] = bq * cs + a * sn; }
            c4[2 * c] = pk4_e4m3(x1[0], x1[1], x1[2], x1[3]); c4[2 * c + 1] = pk4_e4m3(x1[4], x1[5], x1[6], x1[7]);
            c5[2 * c] = pk4_e4m3(x2[0], x2[1], x2[2], x2[3]); c5[2 * c + 1] = pk4_e4m3(x2[4], x2[5], x2[6], x2[7]); }
        *(u32x4*)(dst + 4 * 1024) = c4; *(u32x4*)(dst + 5 * 1024) = c5; *(u32x4*)(dst + 6 * 1024) = zero4; *(u32x4*)(dst + 7 * 1024) = zero4;
    }
    const int NTASK = 4 * NHEAD;
    for (int task = gw; task < NTASK; task += NGW) {
        const int rt = NREAL / 64 + task / NHEAD, h = task % NHEAD; const int row = rt * 64 + lane;
        int b, tile, r64; row_btr(row, b, tile, r64);
        u32x4 raw[12];
#pragma unroll
        for (int c = 0; c < 8; ++c) raw[c] = *(const u32x4*)(KN + (size_t)row * 1024 + h * 64 + 8 * c);
#pragma unroll
        for (int c = 0; c < 4; ++c) raw[8 + c] = *(const u32x4*)(Z + (size_t)row * MLA_INP + 640 + 8 * c);
        float ss = 0.f;
#pragma unroll
        for (int c = 0; c < 12; ++c) { float x[8]; unpack8(raw[c], x);
#pragma unroll
            for (int e = 0; e < 8; ++e) ss += x[e] * x[e]; }
        const float rstd = rsqrtf(ss * (1.f / QK) + EPS);
        bf16* dst = K0 + (size_t)(b * NHEAD + h) * (12 * 64 * 8) + r64 * 8;
        unsigned char* dst8 = Kt + ((size_t)(b * NHEAD + h) * NTILE + tile) * 8192 + r64 * 16;
#pragma unroll
        for (int c = 0; c < 8; ++c) { float x[8]; unpack8(raw[c], x);
#pragma unroll
            for (int e = 0; e < 8; ++e) x[e] *= rstd * gkn[8 * c + e];
            *(u32x4*)(dst + c * 512) = pack8(x);
            *(u32x2*)(dst8 + (c >> 1) * 1024 + (c & 1) * 8) = (u32x2){pk4_e4m3(x[0] * KQ_SC, x[1] * KQ_SC, x[2] * KQ_SC, x[3] * KQ_SC), pk4_e4m3(x[4] * KQ_SC, x[5] * KQ_SC, x[6] * KQ_SC, x[7] * KQ_SC)}; }
        const float pos = (float)row_pos(row);
#pragma unroll
        for (int c = 0; c < 2; ++c) {
            float x1[8], x2[8]; unpack8(raw[8 + c], x1); unpack8(raw[10 + c], x2);
#pragma unroll
            for (int e = 0; e < 8; ++e) { const int i = 8 * c + e; float sn, cs; fast_sincos(pos * ROPE_INV[i], sn, cs);
                const float a = x1[e] * rstd * gkn[64 + i], bq = x2[e] * rstd * gkn[80 + i]; x1[e] = a * cs - bq * sn; x2[e] = bq * cs + a * sn; }
            *(u32x4*)(dst + (8 + c) * 512) = pack8(x1); *(u32x4*)(dst + (10 + c) * 512) = pack8(x2);
            *(u32x2*)(dst8 + 4 * 1024 + c * 8) = (u32x2){pk4_e4m3(x1[0] * KQ_SC, x1[1] * KQ_SC, x1[2] * KQ_SC, x1[3] * KQ_SC), pk4_e4m3(x1[4] * KQ_SC, x1[5] * KQ_SC, x1[6] * KQ_SC, x1[7] * KQ_SC)};
            *(u32x2*)(dst8 + 5 * 1024 + c * 8) = (u32x2){pk4_e4m3(x2[0] * KQ_SC, x2[1] * KQ_SC, x2[2] * KQ_SC, x2[3] * KQ_SC), pk4_e4m3(x2[4] * KQ_SC, x2[5] * KQ_SC, x2[6] * KQ_SC, x2[7] * KQ_SC)}; }
        *(u32x4*)(dst8 + 6 * 1024) = zero4; *(u32x4*)(dst8 + 7 * 1024) = zero4;
    }
    { const bf16* Vb = (const bf16*)F.out; unsigned char* V8 = (unsigned char*)F.out + V8_OFF;
      LAS unsigned* scr = (LAS unsigned*)((LAS unsigned char*)F.lds + RING_OFF + F.wave * 8192);
      const LAS unsigned char* scr8 = (const LAS unsigned char*)scr;
      const unsigned char* VR = (const unsigned char*)F.out;
      u32x4 raw[8];
#define KP_VLOAD(task_) do { if ((task_) % NTILE == 0) { const bf16* src_ = Vb + (size_t)(task_) * 4096 + lane * 32; \
              _Pragma("unroll") for (int q_ = 0; q_ < 8; ++q_) raw[q_] = *(const u32x4*)(src_ + (q_ >> 2) * 2048 + 8 * (q_ & 3)); } \
          else { const unsigned char* src_ = VR + (size_t)(task_) * 8192 + lane * 64; _Pragma("unroll") for (int q_ = 0; q_ < 4; ++q_) raw[q_] = *(const u32x4*)(src_ + 16 * q_); } } while (0)
      if (gw < NB * NHEAD * NTILE) KP_VLOAD(gw);
      for (int task = gw; task < NB * NHEAD * NTILE; task += NGW) {
          if (task % NTILE == 0) {
#pragma unroll
              for (int q_ = 0; q_ < 8; ++q_) { float x[8]; unpack8(raw[q_], x);
                  scr[lane * 17 + 2 * q_] = pk4_e4m3(x[0], x[1], x[2], x[3]); scr[lane * 17 + 2 * q_ + 1] = pk4_e4m3(x[4], x[5], x[6], x[7]); }
          } else {
#pragma unroll
              for (int q_ = 0; q_ < 4; ++q_) { scr[lane * 17 + 4 * q_] = raw[q_].x; scr[lane * 17 + 4 * q_ + 1] = raw[q_].y; scr[lane * 17 + 4 * q_ + 2] = raw[q_].z; scr[lane * 17 + 4 * q_ + 3] = raw[q_].w; }
          }
          if (task + NGW < NB * NHEAD * NTILE) KP_VLOAD(task + NGW);
          asm volatile("s_waitcnt lgkmcnt(0)" ::: "memory");
#pragma unroll
          for (int i = 0; i < 4; ++i) { const int cell = lane + 64 * i, dvf = 32 * (cell >> 7) + (cell & 31), hf = (cell >> 6) & 1, c = (cell >> 5) & 1;
              unsigned w[4];
#pragma unroll
              for (int j = 0; j < 4; ++j) { unsigned acc = 0u;
#pragma unroll
                  for (int e = 0; e < 4; ++e) { const int r = 4 * j + e; const int key = 32 * c + (r & 3) + 8 * (r >> 2) + 4 * hf; acc |= (unsigned)scr8[key * 68 + dvf] << (8 * e); }
                  w[j] = acc; }
              *(u32x4*)(V8 + (size_t)task * 4096 + cell * 16) = (u32x4){w[0], w[1], w[2], w[3]}; }
          asm volatile("s_waitcnt lgkmcnt(0)" ::: "memory");
      }
#undef KP_VLOAD
    }
}

__device__ __forceinline__ int crow(int r, int hi) { return (r & 3) + 8 * (r >> 2) + 4 * hi; }
__device__ __forceinline__ s16x4 vtr(const LAS char* p) { typedef short v4i16_t __attribute__((ext_vector_type(4))); return __builtin_bit_cast(s16x4, __builtin_amdgcn_ds_read_tr16_b64_v4i16((LAS v4i16_t*)p)); }
constexpr int ATT_STAGE = 20480;
__device__ __forceinline__ void glds16(const void* gsrc, unsigned lds_dst) { unsigned keep;
    asm volatile("s_mov_b32 %0, m0\n\ts_mov_b32 m0, %2\n\ts_nop 0\n\tglobal_load_lds_dwordx4 %1, off\n\ts_mov_b32 m0, %0" : "=&s"(keep) : "v"(gsrc), "s"(lds_dst) : "memory"); }

__device__ __forceinline__ void attn_unit(const Args& args, Frame& F, int bh, int qb) {
    const int lane = F.lane, r32 = lane & 31, hi = lane >> 5, wid = F.wave;
    const int b = bh >> 4, h = bh & 15;
    const bf16* QR = (const bf16*)(F.ws + A_QRAW); const bf16* Kt = (const bf16*)(F.ws + A_K0) + (size_t)bh * 6144; const bf16* Vt = (const bf16*)F.out + (size_t)bh * NTILE * 4096;
    bf16* O = (bf16*)(F.ws + A_O);
    unsigned char* shm = F.lds + RING_OFF;
    int NT, myT, qrow;
    if (qb >= 0) { NT = 4 * qb + 5; myT = 4 * qb + 1 + (wid >> 1); qrow = b * SEQ + 256 * qb + 32 * wid + r32; }
    else { NT = 1; myT = (wid == 0) ? 0 : -1; qrow = NREAL + b * 64 + 32 + r32; }
#define ATT_LOAD(t, buf) do { const bf16* ks_ = Kt + (size_t)(t) * 6144 + lane * 8; const bf16* vs_ = Vt + (size_t)(t) * 4096 + lane * 8; LAS unsigned char* d_ = (LAS unsigned char*)(shm + (buf) * ATT_STAGE); \
        __builtin_amdgcn_global_load_lds((const unsigned*)(ks_ + wid * 512), (LAS unsigned*)(d_ + wid * 1024), 16, 0, 0); \
        if (wid < 4) __builtin_amdgcn_global_load_lds((const unsigned*)(ks_ + (wid + 8) * 512), (LAS unsigned*)(d_ + (wid + 8) * 1024), 16, 0, 0); \
        __builtin_amdgcn_global_load_lds((const unsigned*)(vs_ + wid * 512), (LAS unsigned*)(d_ + 12288 + wid * 1024), 16, 0, 0); } while (0)
    ATT_LOAD(0, 0);
    bf16x8 qr[6];
    if (myT >= 0) {
        float qf[6][8];
#pragma unroll
        for (int d0 = 0; d0 < 6; ++d0) { const u32x4 w = *(const u32x4*)(QR + (size_t)qrow * 1536 + h * QK + 16 * d0 + 8 * hi);
            qf[d0][0] = bf2f(w.x & 0xffff); qf[d0][1] = bf2f(w.x >> 16); qf[d0][2] = bf2f(w.y & 0xffff); qf[d0][3] = bf2f(w.y >> 16);
            qf[d0][4] = bf2f(w.z & 0xffff); qf[d0][5] = bf2f(w.z >> 16); qf[d0][6] = bf2f(w.w & 0xffff); qf[d0][7] = bf2f(w.w >> 16); }
        float ss = 0.f;
#pragma unroll
        for (int d0 = 0; d0 < 6; ++d0)
#pragma unroll
            for (int j = 0; j < 8; ++j) ss += qf[d0][j] * qf[d0][j];
        ss += __shfl_xor(ss, 32);
        const float rstd = rsqrtf(ss * (1.f / QK) + EPS);
        const float* gqn = FIN(I_MGQN);
#pragma unroll
        for (int d0 = 0; d0 < 6; ++d0)
#pragma unroll
            for (int j = 0; j < 8; ++j) qf[d0][j] *= rstd * gqn[16 * d0 + 8 * hi + j];
        const float pos = (float)row_pos(qrow);
#pragma unroll
        for (int j = 0; j < 8; ++j) { float sn, cs; fast_sincos(pos * ROPE_INV[8 * hi + j], sn, cs); const float x1 = qf[4][j], x2 = qf[5][j]; qf[4][j] = x1 * cs - x2 * sn; qf[5][j] = x2 * cs + x1 * sn; }
        const float sc = 0.10206207261596575f * 1.4426950408889634f;
#pragma unroll
        for (int d0 = 0; d0 < 6; ++d0) { u32x4 w; w.x = pk2(qf[d0][0] * sc, qf[d0][1] * sc); w.y = pk2(qf[d0][2] * sc, qf[d0][3] * sc); w.z = pk2(qf[d0][4] * sc, qf[d0][5] * sc); w.w = pk2(qf[d0][6] * sc, qf[d0][7] * sc); qr[d0] = __builtin_bit_cast(bf16x8, w); }
    } else {
#pragma unroll
        for (int d0 = 0; d0 < 6; ++d0) qr[d0] = (bf16x8){0, 0, 0, 0, 0, 0, 0, 0};
    }
    f32x16 o0 = {}, o1 = {};
    float mhat = 0.f, lsum = 0.f;
    f32x16 negm = {};
    VM_WAIT(); __syncthreads();
    for (int t = 0; t < NT; ++t) {
        if (t + 1 < NT) ATT_LOAD(t + 1, (t + 1) & 1);
        if (t <= myT) {
            const LAS char* Kb = (const LAS char*)(shm + (t & 1) * ATT_STAGE) + hi * 1024 + r32 * 16;
            const LAS char* Vb = (const LAS char*)(shm + (t & 1) * ATT_STAGE) + 12288 + ((lane >> 4) & 1) * 32 + (lane & 3) * 8 + (4 * hi + ((lane & 15) >> 2)) * 64;
            f32x16 p0 = negm, p1 = negm;
#pragma unroll
            for (int d0 = 0; d0 < 6; ++d0) {
                const bf16x8 a0 = *(const LAS bf16x8*)(Kb + d0 * 2048), a1 = *(const LAS bf16x8*)(Kb + d0 * 2048 + 512);
                p0 = __builtin_amdgcn_mfma_f32_32x32x16_bf16(a0, qr[d0], p0, 0, 0, 0);
                p1 = __builtin_amdgcn_mfma_f32_32x32x16_bf16(a1, qr[d0], p1, 0, 0, 0);
            }
            if (t == 0) {
#pragma unroll
                for (int r = 0; r < 16; ++r) { p0[r] = -INFINITY; if (r < 8) p1[r] = -INFINITY; }
            }
            float ra = max3f(p0[0], p0[1], p1[0]), rb = max3f(p0[2], p0[3], p1[1]); ra = max3f(ra, p1[2], p1[3]);
#pragma unroll
            for (int r = 4; r < 16; r += 4) { ra = max3f(ra, p0[r], p0[r + 1]); rb = max3f(rb, p0[r + 2], p0[r + 3]); ra = max3f(ra, p1[r], p1[r + 1]); rb = max3f(rb, p1[r + 2], p1[r + 3]); }
            float rm = max2f(ra, rb);
            { auto rr = __builtin_amdgcn_permlane32_swap(__float_as_uint(rm), __float_as_uint(rm), false, false); rm = max2f(__uint_as_float(rr[0]), __uint_as_float(rr[1])); }
            if (__builtin_expect(__any(rm > 8.f), 0)) {
                const float dl = fmaxf(rm, 0.f); mhat += dl;
#pragma unroll
                for (int r = 0; r < 16; ++r) { p0[r] -= dl; p1[r] -= dl; }
#pragma unroll
                for (int r = 0; r < 16; ++r) negm[r] = -mhat;
                const float f = __builtin_amdgcn_exp2f(-dl); lsum *= f;
#pragma unroll
                for (int r = 0; r < 16; ++r) { o0[r] *= f; o1[r] *= f; }
            }
            float ps = 0.f;
#pragma unroll
            for (int r = 0; r < 16; ++r) { p0[r] = __builtin_amdgcn_exp2f(p0[r]); p1[r] = __builtin_amdgcn_exp2f(p1[r]); ps += p0[r] + p1[r]; }
            lsum += ps;
            u32x4 pw[4];
            pw[0] = (u32x4){pk2(p0[0], p0[1]), pk2(p0[2], p0[3]), pk2(p0[4], p0[5]), pk2(p0[6], p0[7])};
            pw[1] = (u32x4){pk2(p0[8], p0[9]), pk2(p0[10], p0[11]), pk2(p0[12], p0[13]), pk2(p0[14], p0[15])};
            pw[2] = (u32x4){pk2(p1[0], p1[1]), pk2(p1[2], p1[3]), pk2(p1[4], p1[5]), pk2(p1[6], p1[7])};
            pw[3] = (u32x4){pk2(p1[8], p1[9]), pk2(p1[10], p1[11]), pk2(p1[12], p1[13]), pk2(p1[14], p1[15])};
#pragma unroll
            for (int ks = 0; ks < 4; ++ks) {
                const s16x4 l0 = vtr(Vb + ks * 1024), h0 = vtr(Vb + ks * 1024 + 512), l1 = vtr(Vb + 4096 + ks * 1024), h1 = vtr(Vb + 4096 + ks * 1024 + 512);
                const bf16x8 v0 = (bf16x8){l0[0], l0[1], l0[2], l0[3], h0[0], h0[1], h0[2], h0[3]}, v1 = (bf16x8){l1[0], l1[1], l1[2], l1[3], h1[0], h1[1], h1[2], h1[3]};
                const bf16x8 pb = __builtin_bit_cast(bf16x8, pw[ks]);
                o0 = __builtin_amdgcn_mfma_f32_32x32x16_bf16(v0, pb, o0, 0, 0, 0);
                o1 = __builtin_amdgcn_mfma_f32_32x32x16_bf16(v1, pb, o1, 0, 0, 0);
            }
        }
        VM_WAIT(); __syncthreads();
    }
#undef ATT_LOAD
    if (myT >= 0) {
        lsum += __shfl_xor(lsum, 32);
        const float inv = 1.f / lsum;
        bf16* orow = O + (size_t)qrow * 1024 + h * 64;
#pragma unroll
        for (int g = 0; g < 4; ++g) {
            u32x2 w0, w1; w0.x = pk2(o0[4 * g] * inv, o0[4 * g + 1] * inv); w0.y = pk2(o0[4 * g + 2] * inv, o0[4 * g + 3] * inv);
            w1.x = pk2(o1[4 * g] * inv, o1[4 * g + 1] * inv); w1.y = pk2(o1[4 * g + 2] * inv, o1[4 * g + 3] * inv);
            *(u32x2*)(orow + 8 * g + 4 * hi) = w0; *(u32x2*)(orow + 32 + 8 * g + 4 * hi) = w1;
        }
    }
}

namespace fa {
constexpr int SLOTK = 8192, SLOTV = 4096, NSLOTK = 4, NSLOT = 3;
constexpr int LDS_K = 0, LDS_V = NSLOTK * SLOTK, LDS_WS = LDS_V + NSLOT * SLOTV, LDS_OST = LDS_WS + NWAVES * 64 * 4, LDS_BYTES_ = LDS_OST + NWAVES * 4096;
typedef int v8i_t __attribute__((ext_vector_type(8)));
typedef const LAS char* lds_cptr;
#define FA_SBAR() __builtin_amdgcn_sched_barrier(0)
#define FA_WAIT_BAR(N) asm volatile("s_waitcnt vmcnt(" #N ") lgkmcnt(0)\n\ts_barrier" ::: "memory")
__device__ __forceinline__ v8i_t kload8(lds_cptr kp, int kb, int j) {
    const u32x4 a = *(const LAS u32x4*)(kp + j * 4096 + kb * 512), b = *(const LAS u32x4*)(kp + j * 4096 + kb * 512 + 1024);
    return (v8i_t){(int)a.x, (int)a.y, (int)a.z, (int)a.w, (int)b.x, (int)b.y, (int)b.z, (int)b.w};
}
__device__ __forceinline__ void attn_unit_fast(const Args& args, Frame& F, int bh, int qb) {
    const int lane = F.lane, r32 = lane & 31, hi = lane >> 5, wid = F.wave;
    const int b = bh >> 4, h = bh & 15;
    const bf16* QR = (const bf16*)(F.ws + A_QRAW); const unsigned char* Kt = (const unsigned char*)(F.ws + A_K) + (size_t)bh * NTILE * 8192; const unsigned char* Vt = (const unsigned char*)F.out + V8_OFF + (size_t)bh * NTILE * 4096;
    bf16* O = (bf16*)(F.ws + A_O);
    char* shm = (char*)(F.lds + RING_OFF);
    const unsigned lds0 = (unsigned)(uintptr_t)shm;
    const int NT = 4 * qb + 5;
    const int qrow = b * SEQ + 256 * qb + 32 * wid + r32;
    const int myband = wid >> 1;
    float* wsf = (float*)(shm + LDS_WS) + wid * 64;
    const unsigned char* ksrc = Kt + lane * 16 + wid * 1024; const unsigned char* vsrc = Vt + (lane & 31) * 16 + wid * 512;
    const unsigned kdst = lds0 + LDS_K + wid * 1024, vdst = lds0 + LDS_V + wid * 512;
#define FA_DMA_K(t, slot) glds16(ksrc + (size_t)(t) * 8192, (unsigned)__builtin_amdgcn_readfirstlane(kdst + (slot) * SLOTK))
#define FA_DMA_V(t, slot) do { const unsigned vd_ = (unsigned)__builtin_amdgcn_readfirstlane(vdst + (slot) * SLOTV); if (lane < 32) glds16(vsrc + (size_t)(t) * 4096, vd_); } while (0)
    const lds_cptr shm3 = (lds_cptr)shm; const lds_cptr kp0 = shm3 + LDS_K + hi * 2048 + r32 * 16; const lds_cptr vp0 = shm3 + LDS_V + hi * 1024 + r32 * 16;
    v8i_t kf[4];
    FA_DMA_K(0, 0); FA_DMA_V(0, 0); FA_DMA_K(1, 1);
    v8i_t qr[2];
    {
        float qa[32], qb_[32];
        const bf16* qsrc = QR + (size_t)qrow * 1536 + h * QK;
#pragma unroll
        for (int c = 0; c < 4; ++c) { const u32x4 w = *(const u32x4*)(qsrc + 32 * hi + 8 * c), w2 = *(const u32x4*)(qsrc + 64 + 8 * c);
            qa[8 * c + 0] = bf2f(w.x & 0xffff); qa[8 * c + 1] = bf2f(w.x >> 16); qa[8 * c + 2] = bf2f(w.y & 0xffff); qa[8 * c + 3] = bf2f(w.y >> 16);
            qa[8 * c + 4] = bf2f(w.z & 0xffff); qa[8 * c + 5] = bf2f(w.z >> 16); qa[8 * c + 6] = bf2f(w.w & 0xffff); qa[8 * c + 7] = bf2f(w.w >> 16);
            qb_[8 * c + 0] = bf2f(w2.x & 0xffff); qb_[8 * c + 1] = bf2f(w2.x >> 16); qb_[8 * c + 2] = bf2f(w2.y & 0xffff); qb_[8 * c + 3] = bf2f(w2.y >> 16);
            qb_[8 * c + 4] = bf2f(w2.z & 0xffff); qb_[8 * c + 5] = bf2f(w2.z >> 16); qb_[8 * c + 6] = bf2f(w2.w & 0xffff); qb_[8 * c + 7] = bf2f(w2.w >> 16); }
        float ss = 0.f, sr = 0.f;
#pragma unroll
        for (int j = 0; j < 32; ++j) { ss += qa[j] * qa[j]; sr += qb_[j] * qb_[j]; }
        ss += __shfl_xor(ss, 32);
        const float rstd = rsqrtf((ss + sr) * (1.f / QK) + EPS) * KQ_SC;
        const float* gqn = FIN(I_MGQN);
#pragma unroll
        for (int j = 0; j < 32; ++j) { qa[j] *= rstd * gqn[32 * hi + j]; qb_[j] *= rstd * gqn[64 + j]; }
        const float pos = (float)row_pos(qrow);
#pragma unroll
        for (int j = 0; j < 16; ++j) { float sn, cs; fast_sincos(pos * ROPE_INV[j], sn, cs); const float x1 = qb_[j], x2 = qb_[16 + j]; qb_[j] = x1 * cs - x2 * sn; qb_[16 + j] = x2 * cs + x1 * sn; }
#pragma unroll
        for (int c = 0; c < 8; ++c) { qr[0][c] = (int)pk4_e4m3(qa[4 * c], qa[4 * c + 1], qa[4 * c + 2], qa[4 * c + 3]);
            const unsigned rb = pk4_e4m3(qb_[4 * c], qb_[4 * c + 1], qb_[4 * c + 2], qb_[4 * c + 3]); qr[1][c] = hi ? 0 : (int)rb; }
    }
    f32x16 o[2], o2; o[0] = f32x16{}; o[1] = f32x16{}; o2 = f32x16{};
    v8i_t ones8; { int one_ = 0x38383838; asm volatile("" : "+v"(one_)); ones8 = (v8i_t){one_, one_, one_, one_, one_, one_, one_, one_}; }
#define FA_CMASK(P0, P1, t) do { if (FA_CMASK_ON && (t) - (NT - 4) > myband) { _Pragma("unroll") for (int r = 0; r < 16; ++r) { P0[r] = -INFINITY; P1[r] = -INFINITY; } } } while (0)
    f32x16 pA0, pA1, pB0, pB1;
    int sk_cur = 0, sk_next = 1, sk_prev = 2;
#define FA_ROT() do { const int tmp_ = sk_prev; sk_prev = sk_cur; sk_cur = sk_next; sk_next = tmp_; } while (0)
    FA_DMA_K(2, 2); FA_DMA_K(3, 3);
    FA_WAIT_BAR(4);
#define FA_MF8(a, b, c) __builtin_amdgcn_mfma_scale_f32_32x32x64_f8f6f4(a, b, c, 0, 0, 0, 0, 0, 0)
    { const f32x16 z = {};
      pA0 = FA_MF8(kload8(kp0, 0, 0), qr[0], z); pA1 = FA_MF8(kload8(kp0, 1, 0), qr[0], z); pA0 = FA_MF8(kload8(kp0, 0, 1), qr[1], pA0); pA1 = FA_MF8(kload8(kp0, 1, 1), qr[1], pA1); }
#pragma unroll
    for (int r = 0; r < 16; ++r) { pA0[r] = -INFINITY; if (r < 8) pA1[r] = -INFINITY; }
#pragma unroll
    for (int r = 0; r < 16; ++r) { pA0[r] = __builtin_amdgcn_exp2f(pA0[r]); pA1[r] = __builtin_amdgcn_exp2f(pA1[r]); }
    FA_WAIT_BAR(0);
    FA_DMA_V(1, 1);
    FA_ROT();
    kf[0] = kload8(kp0 + 1 * SLOTK, 0, 0); kf[1] = kload8(kp0 + 1 * SLOTK, 1, 0);
    FA_WAIT_BAR(1);
    v8i_t vf[2], pq;
#define FA_PKW(P, B) pk2(P[B], P[B + 1])
#define FA_PAF(k) __builtin_bit_cast(bf16x8, pw##k)
#define FA_VFR(i) (bf16x8){vlo[i][0], vlo[i][1], vlo[i][2], vlo[i][3], vhi[i][0], vhi[i][1], vhi[i][2], vhi[i][3]}
#define FA_PIN(x) asm volatile("" : "+v"(x))
#define FA_GAPA(MF, A0, A1, A2, A3, W0, W1, PW) do { MF; sacc += A0; sacc += A1; sacc += A2; sacc += A3; FA_PIN(sacc); W0; W1; FA_PIN(PW); FA_SBAR(); } while (0)
#define FA_GAPA0(MF) do { MF; FA_SBAR(); } while (0)
#define FA_GAPA8(MF, A0, A1, A2, A3, A4, A5, A6, A7, W0, W1) do { MF; W0; W1; FA_SBAR(); } while (0)
#define FA_GAPB8(MF, X, B) do { MF; _Pragma("unroll") for (int e_ = 0; e_ < 8; ++e_) X[(B) + e_] = FA_EX(X[(B) + e_]); FA_PIN(X); FA_SBAR(); } while (0)
#define FA_GAPA2(MF, A0, A1, W0, W1, PW) do { MF; sacc += A0; sacc += A1; FA_PIN(sacc); W0; W1; FA_PIN(PW); FA_SBAR(); } while (0)
#define FA_GAPA4(MF, A0, A1, A2, A3) do { MF; sacc += A0; sacc += A1; sacc += A2; sacc += A3; FA_PIN(sacc); FA_SBAR(); } while (0)
#define FA_EX(v) __builtin_amdgcn_exp2f(v)
#define FA_GAPB(MF, X, B) do { MF; X[B] = FA_EX(X[B]); X[B + 1] = FA_EX(X[B + 1]); X[B + 2] = FA_EX(X[B + 2]); X[B + 3] = FA_EX(X[B + 3]); FA_PIN(X); FA_SBAR(); } while (0)
#define FA_VRD(dvb_) do { const u32x4 a_ = *(const LAS u32x4*)(vp_ + (dvb_) * 2048), b_ = *(const LAS u32x4*)(vp_ + (dvb_) * 2048 + 512); vf[dvb_] = (v8i_t){(int)a_.x, (int)a_.y, (int)a_.z, (int)a_.w, (int)b_.x, (int)b_.y, (int)b_.z, (int)b_.w}; } while (0)
#define FA_PQ(P, B) (int)pk4_bf8(P[B], P[(B) + 1], P[(B) + 2], P[(B) + 3])
#define FA_MFPV(d_) o[d_] = __builtin_amdgcn_mfma_scale_f32_32x32x64_f8f6f4(pq, vf[d_], o[d_], 1, 0, 0, 0, 0, 0)
#define FA_KRD(G, kb_, t) do { if (G) { kf[kb_] = kload8(kp0 + (((t) + 1) & 3) * SLOTK, kb_, 0); FA_SBAR(); } } while (0)
#define FA_MF(a, b, c) __builtin_amdgcn_mfma_f32_32x32x16_bf16(a, b, c, 0, 0, 0)
#define FA_KJ(kb_, t) do { kf[2 + (kb_)] = kload8(kp0 + ((t) & 3) * SLOTK, kb_, 1); FA_SBAR(); } while (0)
#define FA_STEP(C0, C1, P0, P1, t, GK, GV, GL) do { FA_SBAR(); \
    const lds_cptr vp_ = vp0 + sk_prev * SLOTV; const f32x16 z_ = {}; \
    FA_KJ(0, t); FA_KJ(1, t); \
    FA_GAPA8(C0 = FA_MF8(kf[0], qr[0], z_), P0[2], P0[3], P0[4], P0[5], P0[6], P0[7], P0[8], P0[9],         pq[0] = FA_PQ(P0, 0), pq[1] = FA_PQ(P0, 4)); \
    FA_GAPA8(C1 = FA_MF8(kf[1], qr[0], z_), P0[10], P0[11], P0[12], P0[13], P0[14], P0[15], P1[0], P1[1],   pq[2] = FA_PQ(P0, 8), pq[3] = FA_PQ(P0, 12)); \
    FA_VRD(0); FA_SBAR(); \
    FA_GAPA8(C0 = FA_MF8(kf[2], qr[1], C0), P1[2], P1[3], P1[4], P1[5], P1[6], P1[7], P1[8], P1[9],         pq[4] = FA_PQ(P1, 0), pq[5] = FA_PQ(P1, 4)); \
    FA_VRD(1); FA_SBAR(); \
    FA_GAPA8(C1 = FA_MF8(kf[3], qr[1], C1), P1[10], P1[11], P1[12], P1[13], P1[14], P1[15], 0.f, 0.f,       pq[6] = FA_PQ(P1, 8), pq[7] = FA_PQ(P1, 12)); FA_PIN(pq); \
    if (GK) { FA_DMA_K((t) + 3, ((t) + 3) & 3); } if (GV) { FA_DMA_V((t) + 1, sk_next); } \
    FA_CMASK(C0, C1, t); \
    FA_SBAR(); \
    FA_GAPB8(FA_MFPV(0), C0, 0); \
    FA_KRD(GL, 0, t); FA_GAPB8(FA_MFPV(1), C0, 8); \
    FA_KRD(GL, 1, t); FA_GAPB8(o2 = __builtin_amdgcn_mfma_scale_f32_32x32x64_f8f6f4(pq, ones8, o2, 1, 0, 0, 0, 0, 0), C1, 0); \
    FA_GAPB8((void)0, C1, 8); \
    } while (0)
#define FA_ENDW(tt) do { if ((tt) + 3 < NT) { FA_WAIT_BAR(2); } else if ((tt) + 1 < NT) { FA_WAIT_BAR(1); } else { FA_WAIT_BAR(0); } } while (0)
    int t = 1;
#define FA_CMASK_ON 0
    for (; t + 5 < NT; t += 2) {
        FA_STEP(pB0, pB1, pA0, pA1, t, true, true, true);     FA_WAIT_BAR(2); FA_ROT();
        FA_STEP(pA0, pA1, pB0, pB1, t + 1, true, true, true); FA_WAIT_BAR(2); FA_ROT();
    }
#undef FA_CMASK_ON
#define FA_CMASK_ON 1
    for (; t + 1 < NT; t += 2) {
        FA_STEP(pB0, pB1, pA0, pA1, t, (t + 3 < NT), (t + 1 < NT), (t + 1 < NT));     FA_ENDW(t);     FA_ROT();
        FA_STEP(pA0, pA1, pB0, pB1, t + 1, (t + 4 < NT), (t + 2 < NT), (t + 2 < NT)); FA_ENDW(t + 1); FA_ROT();
    }
#undef FA_CMASK_ON
    {
      pq = (v8i_t){FA_PQ(pA0, 0), FA_PQ(pA0, 4), FA_PQ(pA0, 8), FA_PQ(pA0, 12), FA_PQ(pA1, 0), FA_PQ(pA1, 4), FA_PQ(pA1, 8), FA_PQ(pA1, 12)};
      const lds_cptr vp_ = vp0 + sk_prev * SLOTV;
      FA_VRD(0); FA_VRD(1);
      FA_MFPV(0); FA_MFPV(1); o2 = __builtin_amdgcn_mfma_scale_f32_32x32x64_f8f6f4(pq, ones8, o2, 1, 0, 0, 0, 0, 0); }
    float rli[16];
#pragma unroll
    for (int r = 0; r < 16; ++r) rli[r] = __builtin_amdgcn_rcpf(o2[r]);
    unsigned char* Ow = (unsigned char*)(F.ws + A_O8) + (size_t)(b * SEQ + 256 * qb + wid * 32) * 1024 + h * 64;
    { unsigned char* stg = (unsigned char*)(shm + LDS_OST) + wid * 2048;
#pragma unroll
      for (int r = 0; r < 16; r += 2) { const int ra = crow(r, hi), rb = crow(r + 1, hi);
#pragma unroll
          for (int d0 = 0; d0 < 2; ++d0) { const unsigned w = pk4_e4m3(o[d0][r] * rli[r] * O_SC, o[d0][r + 1] * rli[r + 1] * O_SC, 0.f, 0.f);
              stg[ra * 64 + d0 * 32 + r32] = (unsigned char)(w & 0xffu); stg[rb * 64 + d0 * 32 + r32] = (unsigned char)((w >> 8) & 0xffu); } }
      asm volatile("s_waitcnt lgkmcnt(0)" ::: "memory");
      { const int row = lane >> 1, hb_ = (lane & 1) * 32; const u32x4 v0 = *(const u32x4*)(stg + row * 64 + hb_), v1 = *(const u32x4*)(stg + row * 64 + hb_ + 16);
        *(u32x4*)(Ow + (size_t)row * 1024 + hb_) = v0; *(u32x4*)(Ow + (size_t)row * 1024 + hb_ + 16) = v1; } }
    asm volatile("s_waitcnt vmcnt(0) lgkmcnt(0)\n\ts_barrier" ::: "memory");
#undef FA_DMA_K
#undef FA_DMA_V
#undef FA_CMASK
#undef FA_ROT
#undef FA_PKW
#undef FA_PAF
#undef FA_VFR
#undef FA_PIN
#undef FA_GAPA
#undef FA_GAPA0
#undef FA_GAPA8
#undef FA_MF8
#undef FA_GAPA2
#undef FA_GAPA4
#undef FA_EX
#undef FA_GAPB
#undef FA_VRD
#undef FA_PQ
#undef FA_MFPV
#undef FA_GAPB8
#undef FA_KRD
#undef FA_KJ
#undef FA_MF
#undef FA_STEP
#undef FA_ENDW
}
#undef FA_SBAR
#undef FA_WAIT_BAR
}

__device__ __forceinline__ void attn_phase(const Args& args, Frame& F) {
    const int v = F.vcu, xg = v >> 5, j32 = v & 31;
    for (int i = 0; ; ++i) {
        int bh, qb;
        if (F.G == 256) { if (i > 8 || (i == 8 && j32 >= 8)) break;
            if (i == 8) { bh = 8 * xg + j32; qb = -1; } else { bh = 8 * xg + i; qb = (i & 1) ? 31 - j32 : j32; } }
        else { const int u = blockIdx.x + i * F.G; if (u >= 64 * 33) break; bh = u / 33; qb = (u % 33) - 1; }
        if (qb >= 0) fa::attn_unit_fast(args, F, bh, qb); else attn_unit(args, F, bh, qb);
    }
}

__device__ __forceinline__ void route_phase(const Args& args, Frame& F, int layer, const bf16* hb, unsigned* gcnt, int* list, float* wts, unsigned* epos, float* rsl) {
    const int lane = F.lane, wave = F.wave, tid = F.tid, l15 = lane & 15, kq = lane >> 4;
    const float* gain = FIN(I_NFFN) + layer * 1024; const float* wrg = FIN(I_RWG) + (size_t)layer * 1024 * 4; const float* wre = FIN(I_RWE) + (size_t)layer * 1024 * 32;
    const float* brg = FIN(I_RBG) + layer * 4; const float* bre = FIN(I_RBE) + layer * 32;
    float* part_lg = (float*)(F.lds + RING_OFF);
    float* part_ss = (float*)(F.lds + RING_OFF + 49152);
    float* logit_s = (float*)(F.lds + RING_OFF + 50176);
    float* rstd_s = (float*)(F.lds + RING_OFF + 56320);
    int* dec_e = (int*)(F.lds + RING_OFF + 57344);
    float* dec_w = (float*)(F.lds + RING_OFF + 57344 + 2048);
    int* dec_rank = (int*)(F.lds + RING_OFF + 57344 + 4096);
    int* lcnt = (int*)(F.lds + RING_OFF + 57344 + 6144);
    int* lbase = (int*)(F.lds + RING_OFF + 57344 + 6144 + 128);
    float* rstd_all = (float*)(F.lds + RING_OFF + 57344 + 6144 + 256);
    const int RPB = (MROWS + F.G - 1) / F.G;
    const int r0 = blockIdx.x * RPB, r1 = (r0 + RPB < MROWS) ? r0 + RPB : MROWS;
    if (tid < 32) lcnt[tid] = 0;
    const int kbase = 128 * wave;
    bf16x8 wh[4][3], wl[4][3];
#pragma unroll
    for (int s4 = 0; s4 < 4; ++s4)
#pragma unroll
        for (int cb = 0; cb < 3; ++cb) {
            float w[8]; const int col = 16 * cb + l15;
#pragma unroll
            for (int j = 0; j < 8; ++j) { const int k = kbase + 32 * s4 + 8 * kq + j; float v = 0.f; if (col < 4) v = wrg[k * 4 + col]; else if (col < 36) v = wre[k * 32 + (col - 4)]; w[j] = v * gain[k]; }
            u32x4 ph, pl; unsigned hw[4], lw[4];
#pragma unroll
            for (int j = 0; j < 4; ++j) { const unsigned hb_ = pk2(w[2 * j], w[2 * j + 1]); hw[j] = hb_; lw[j] = pk2(w[2 * j] - bf2f(hb_ & 0xffff), w[2 * j + 1] - bf2f(hb_ >> 16)); }
            ph = (u32x4){hw[0], hw[1], hw[2], hw[3]}; pl = (u32x4){lw[0], lw[1], lw[2], lw[3]};
            wh[s4][cb] = __builtin_bit_cast(bf16x8, ph); wl[s4][cb] = __builtin_bit_cast(bf16x8, pl);
        }
    __syncthreads();
    const int ngroups = (RPB + 31) / 32;
    u32x4 xa[2][4];
    auto load_rows = [&](int g) {
#pragma unroll
        for (int rb = 0; rb < 2; ++rb) { const int lr = 32 * g + 16 * rb + l15, r = r0 + lr; const bool ok = lr < RPB && r < r1 && !row_is_dummy(r);
#pragma unroll
            for (int s4 = 0; s4 < 4; ++s4) xa[rb][s4] = ok ? *(const u32x4*)(hb + (size_t)r * 1024 + kbase + 32 * s4 + 8 * kq) : (u32x4){0u, 0u, 0u, 0u}; }
    };
    load_rows(0);
    for (int g = 0; g < ngroups; ++g) {
        u32x4 xc[2][4];
#pragma unroll
        for (int rb = 0; rb < 2; ++rb)
#pragma unroll
            for (int s4 = 0; s4 < 4; ++s4) xc[rb][s4] = xa[rb][s4];
        if (g + 1 < ngroups) load_rows(g + 1);
#pragma unroll
        for (int rb = 0; rb < 2; ++rb) {
            float ss = 0.f; f32x4 acc[3] = {};
#pragma unroll
            for (int s4 = 0; s4 < 4; ++s4) {
                const u32x4 q = xc[rb][s4]; const unsigned qw[4] = {q.x, q.y, q.z, q.w};
#pragma unroll
                for (int j = 0; j < 4; ++j) { const float a = bf2f(qw[j] & 0xffff), b = bf2f(qw[j] >> 16); ss += a * a + b * b; }
                const bf16x8 xh = __builtin_bit_cast(bf16x8, q);
#pragma unroll
                for (int cb = 0; cb < 3; ++cb) {
                    acc[cb] = __builtin_amdgcn_mfma_f32_16x16x32_bf16(xh, wh[s4][cb], acc[cb], 0, 0, 0);
                    acc[cb] = __builtin_amdgcn_mfma_f32_16x16x32_bf16(xh, wl[s4][cb], acc[cb], 0, 0, 0);
                }
            }
            ss += __shfl_xor(ss, 16); ss += __shfl_xor(ss, 32);
#pragma unroll
            for (int cb = 0; cb < 3; ++cb)
#pragma unroll
                for (int rg = 0; rg < 4; ++rg) part_lg[(wave * 32 + 16 * rb + 4 * kq + rg) * 48 + 16 * cb + l15] = acc[cb][rg];
            if (kq == 0) part_ss[wave * 32 + 16 * rb + l15] = ss;
        }
        __syncthreads();
        for (int i = tid; i < 1536; i += NTHREADS) { float a = 0.f;
#pragma unroll
            for (int w = 0; w < 8; ++w) a += part_lg[w * 1536 + i];
            logit_s[i] = a; }
        if (tid < 32) { float tot = 0.f;
#pragma unroll
            for (int w = 0; w < 8; ++w) tot += part_ss[w * 32 + tid];
            const float rstd = rsqrtf(tot * (1.f / 1024.f) + EPS); rstd_s[tid] = rstd; if (32 * g + tid < RPB) rstd_all[32 * g + tid] = rstd; }
        __syncthreads();
        if (tid < 32) {
            const int lr = 32 * g + tid, r = r0 + lr;
            if (lr < RPB) {
                int e1 = -1, e2 = -1; float w1 = 0.f, w2 = 0.f;
                if (r < r1 && !row_is_dummy(r)) {
                    const float* lg = logit_s + tid * 48; const float rs = rstd_s[tid];
                    float gl[4]; int gs = 0;
#pragma unroll
                    for (int i = 0; i < 4; ++i) gl[i] = lg[i] * rs + brg[i];
#pragma unroll
                    for (int i = 1; i < 4; ++i) if (gl[i] > gl[gs]) gs = i;
                    float den = 0.f;
#pragma unroll
                    for (int i = 0; i < 4; ++i) den += __expf(gl[i] - gl[gs]);
                    const float pg = 1.f / den;
                    float el[8]; int i1 = 0;
#pragma unroll
                    for (int i = 0; i < 8; ++i) el[i] = lg[4 + 8 * gs + i] * rs + bre[8 * gs + i];
#pragma unroll
                    for (int i = 1; i < 8; ++i) if (el[i] > el[i1]) i1 = i;
                    int i2 = (i1 == 0) ? 1 : 0;
#pragma unroll
                    for (int i = 0; i < 8; ++i) if (i != i1 && el[i] > el[i2]) i2 = i;
                    float e1v = el[0], e2v = el[0];
#pragma unroll
                    for (int i = 0; i < 8; ++i) { if (i == i1) e1v = el[i]; if (i == i2) e2v = el[i]; }
                    const float ex = __expf(e2v - e1v);
                    w1 = pg / (1.f + ex); w2 = pg * ex / (1.f + ex); e1 = 8 * gs + i1; e2 = 8 * gs + i2;
                }
                dec_e[2 * lr] = e1; dec_e[2 * lr + 1] = e2; dec_w[2 * lr] = w1; dec_w[2 * lr + 1] = w2;
                dec_rank[2 * lr] = e1 >= 0 ? atomicAdd(&lcnt[e1], 1) : 0; dec_rank[2 * lr + 1] = e2 >= 0 ? atomicAdd(&lcnt[e2], 1) : 0;
            }
        }
    }
    __syncthreads();
    if (tid < 32) lbase[tid] = (int)atomicAdd(gcnt + tid, (unsigned)lcnt[tid]);
    __syncthreads();
    for (int i = tid; i < 2 * RPB; i += NTHREADS) {
        const int e = dec_e[i]; if (e < 0) continue;
        const int slot = 2 * (r0 + (i >> 1)) + (i & 1); const int pos = lbase[e] + dec_rank[i];
        list[(size_t)e * MROWS + pos] = slot; wts[slot] = dec_w[i]; epos[slot] = ((unsigned)e << 20) | (unsigned)pos; rsl[(size_t)e * MROWS + pos] = rstd_all[i >> 1];
    }
    __syncthreads();
}

constexpr int G1_QT = 0, G1_KM = 17408, G1_KH = 34816, G1_VT = 55296, G1_BL = 92160, G1_GLR = 124928, G1_SCR = 129024;
constexpr int PQ = 272, PKH = 320, PV = 576;
__device__ __forceinline__ float logsigmoid_f(float x) { const float e = __builtin_amdgcn_exp2f(-1.4426950408889634f * fabsf(x)); return fminf(x, 0.f) - 0.6931471805599453f * __builtin_amdgcn_logf(1.f + e); }

__device__ __forceinline__ bf16x8 tr_frag(const LAS char* tile, int pitch, int col0, int ks, int lane) {
    const int hi = lane >> 5, q = (lane & 15) >> 2, p = lane & 3, h16 = (lane >> 4) & 1;
    const LAS char* a = tile + (16 * ks + 8 * hi + q) * pitch + (col0 + 16 * h16 + 4 * p) * 2;
    const s16x4 lo = vtr(a), hi4 = vtr(a + 4 * pitch);
    return (bf16x8){lo[0], lo[1], lo[2], lo[3], hi4[0], hi4[1], hi4[2], hi4[3]};
}

__device__ __forceinline__ void g1_phase(const Args& args, Frame& F) {
    const int tid = F.tid, lane = F.lane, wave = F.wave, r32 = lane & 31, hi = lane >> 5;
    unsigned char* shm = F.lds + RING_OFF;
    const bf16* ZQK = (const bf16*)(F.ws + A_ZQK); const bf16* ZV = (const bf16*)(F.ws + A_ZV); const float* GLR = (const float*)(F.ws + S_GLR);
    bf16* QT = (bf16*)(F.ws + A_QT);
    float* bL = (float*)(shm + G1_BL); float* scr = (float*)(shm + G1_SCR);
    constexpr int NPAIR = NB * GH * 16;
    int pair = blockIdx.x; if (pair >= NPAIR) return;
    int ci = 0;
    int bh = pair & 15, c = 8 * (pair >> 4), b = bh >> 2, h = bh & 3;
    f32x16 acc[4]; float pcum = 1.f;
    u32x4 qp[2], kp[2], vp[4]; f32x4 gl0 = {}, gl1 = {}; int prow[2], pd[2];
    const int tbw = wave & 1, dbw = wave >> 1;
#pragma unroll
    for (int j = 0; j < 2; ++j) { const int p = tid + 512 * j; prow[j] = p >> 4; pd[j] = (p & 15) * 8; }
#define G1_LOAD_QK(b_, c_, h_) do { _Pragma("unroll") for (int j = 0; j < 2; ++j) { const int row = row_of(b_, c_, prow[j]); const bool dz_ = (c_) == 0 && prow[j] < 48;     \
            qp[j] = dz_ ? (u32x4){0u, 0u, 0u, 0u} : *(const u32x4*)(ZQK + (size_t)row * 1024 + (h_) * 128 + pd[j]); kp[j] = dz_ ? (u32x4){0u, 0u, 0u, 0u} : *(const u32x4*)(ZQK + (size_t)row * 1024 + 512 + (h_) * 128 + pd[j]); } } while (0)
#define G1_LOAD_V(b_, c_, h_) do { _Pragma("unroll") for (int j = 0; j < 4; ++j) { const int p = tid + 512 * j, i = p >> 5, dc = (p & 31) * 8; vp[j] = ((c_) == 0 && i < 48) ? (u32x4){0u, 0u, 0u, 0u} : *(const u32x4*)(ZV + (size_t)row_of(b_, c_, i) * 1024 + (h_) * 256 + dc); } \
        { const float* gp_ = GLR + (size_t)row_of(b_, c_, 32 * tbw + r32) * 16 + 8 * hi; gl0 = *(const f32x4*)gp_; gl1 = *(const f32x4*)(gp_ + 4); } } while (0)
    G1_LOAD_V(b, c, h); G1_LOAD_QK(b, c, h);
    int wh_ = -1; bf16x8 wfh = {}, wfl = {}; float bg = 0.f;
    for (;;) {
        const int unit = bh * NTILE + c;
        bf16* ATT = (bf16*)(F.ws + A_ATT) + (size_t)unit * 4096; unsigned char* DST = (unsigned char*)F.out + (size_t)(bh * (NTILE - 1) + c) * 32768;     float* GAM = (float*)(F.ws + S_GAM) + (size_t)unit * 128;
        if (h != wh_) { const float* wgu = FIN(I_GWGU); unsigned hw[4], lw[4];
#pragma unroll
            for (int j = 0; j < 4; ++j) { const float w0 = wgu[(8 * hi + 2 * j) * GNK + h * 128 + 32 * dbw + r32], w1 = wgu[(8 * hi + 2 * j + 1) * GNK + h * 128 + 32 * dbw + r32];
                const unsigned hb_ = pk2(w0, w1); hw[j] = hb_; lw[j] = pk2(w0 - bf2f(hb_ & 0xffff), w1 - bf2f(hb_ >> 16)); }
            wfh = __builtin_bit_cast(bf16x8, (u32x4){hw[0], hw[1], hw[2], hw[3]}); wfl = __builtin_bit_cast(bf16x8, (u32x4){lw[0], lw[1], lw[2], lw[3]});
            bg = FIN(I_GBG)[h * 128 + 32 * dbw + r32]; wh_ = h; }
#pragma unroll
        for (int j = 0; j < 4; ++j) { const int p = tid + 512 * j, i = p >> 5, dc = (p & 31) * 8; *(u32x4*)(shm + G1_VT + i * PV + dc * 2) = vp[j]; }
        f32x16 gx;
        { const float gv[8] = {gl0.x, gl0.y, gl0.z, gl0.w, gl1.x, gl1.y, gl1.z, gl1.w}; unsigned hw[4], lw[4];
#pragma unroll
          for (int j = 0; j < 4; ++j) { const unsigned hb_ = pk2(gv[2 * j], gv[2 * j + 1]); hw[j] = hb_; lw[j] = pk2(gv[2 * j] - bf2f(hb_ & 0xffff), gv[2 * j + 1] - bf2f(hb_ >> 16)); }
          const bf16x8 xh = __builtin_bit_cast(bf16x8, (u32x4){hw[0], hw[1], hw[2], hw[3]}), xl = __builtin_bit_cast(bf16x8, (u32x4){lw[0], lw[1], lw[2], lw[3]});
#pragma unroll
          for (int r = 0; r < 16; ++r) gx[r] = bg;
          gx = __builtin_amdgcn_mfma_f32_32x32x16_bf16(xh, wfh, gx, 0, 0, 0); gx = __builtin_amdgcn_mfma_f32_32x32x16_bf16(xl, wfh, gx, 0, 0, 0); gx = __builtin_amdgcn_mfma_f32_32x32x16_bf16(xh, wfl, gx, 0, 0, 0); }
        const int nci = ((pair >> 4) == 15) ? 9 : 8; const bool same = ci + 1 < nci; const int pairn = same ? pair : pair + F.G; const bool more = same || pairn < NPAIR;
        const int bhn = pairn & 15, cn = same ? c + 1 : 8 * (pairn >> 4);
        if (more) G1_LOAD_V(bhn >> 2, cn, bhn & 3);
        { const int d = 32 * dbw + r32; float t0[4], t1[4];
#pragma unroll
          for (int g = 0; g < 4; ++g) { float run = 0.f;
#pragma unroll
              for (int e = 0; e < 4; ++e) { run += logsigmoid_f(gx[4 * g + e]) * (1.f / 16.f); gx[4 * g + e] = run; }
              const auto rr = __builtin_amdgcn_permlane32_swap(__float_as_uint(run), __float_as_uint(run), false, false); t0[g] = __uint_as_float(rr[0]); t1[g] = __uint_as_float(rr[1]); }
          float off[4], run = 0.f;
#pragma unroll
          for (int g = 0; g < 4; ++g) { const float o1 = run + t0[g]; off[g] = hi ? o1 : run; run = o1 + t1[g]; }
          if (tbw == 0 && hi == 0) scr[d] = run;
          __syncthreads();
          const float base = tbw ? scr[d] : 0.f;
#pragma unroll
          for (int g = 0; g < 4; ++g)
#pragma unroll
              for (int e = 0; e < 4; ++e) bL[(32 * tbw + 8 * g + 4 * hi + e) * 128 + d] = gx[4 * g + e] + (off[g] + base);
          if (tbw == 1 && hi == 0) { const float gam = __expf(run + base); scr[512 + d] = gam; pcum = (ci == 0) ? gam : pcum * gam; GAM[d] = pcum; } }
        __syncthreads();
#pragma unroll
        for (int j = 0; j < 2; ++j) {
            const int i = prow[j], d0 = pd[j]; const unsigned qw[4] = {qp[j].x, qp[j].y, qp[j].z, qp[j].w}, kw[4] = {kp[j].x, kp[j].y, kp[j].z, kp[j].w};
            float qt[8], km[8], kh[8];
#pragma unroll
            for (int e = 0; e < 8; ++e) { const float bb = bL[i * 128 + d0 + e], gam = scr[512 + d0 + e];
                const float qv = bf2f((e & 1) ? (qw[e >> 1] >> 16) : (qw[e >> 1] & 0xffff)), kv = bf2f((e & 1) ? (kw[e >> 1] >> 16) : (kw[e >> 1] & 0xffff));
                qt[e] = qv * 0.08838834764831845f * __expf(bb); km[e] = kv * __expf(-bb); kh[e] = km[e] * gam; }
            u32x4 wq, wm, wh; wq.x = pk2(qt[0], qt[1]); wq.y = pk2(qt[2], qt[3]); wq.z = pk2(qt[4], qt[5]); wq.w = pk2(qt[6], qt[7]);
            wm.x = pk2(km[0], km[1]); wm.y = pk2(km[2], km[3]); wm.z = pk2(km[4], km[5]); wm.w = pk2(km[6], km[7]);
            wh.x = pk2(kh[0], kh[1]); wh.y = pk2(kh[2], kh[3]); wh.z = pk2(kh[4], kh[5]); wh.w = pk2(kh[6], kh[7]);
            *(u32x4*)(shm + G1_QT + i * PQ + d0 * 2) = wq; *(u32x4*)(shm + G1_KM + i * PQ + d0 * 2) = wm; *(u32x4*)(shm + G1_KH + i * PKH + d0 * 2) = wh;
            *(u32x4*)(QT + (size_t)row_of(b, c, i) * 512 + h * 128 + d0) = wq;
        }
        if (more) G1_LOAD_QK(bhn >> 2, cn, bhn & 3);
        __syncthreads();
        if (wave < 4) {
            const int sb = wave & 1, tb = wave >> 1; f32x16 a = {};
            if (!(sb == 1 && tb == 0)) {
#pragma unroll
                for (int ks = 0; ks < 8; ++ks) { const bf16x8 fa = *(const LAS bf16x8*)((const LAS char*)(shm + G1_KM) + (32 * sb + r32) * PQ + (16 * ks + 8 * hi) * 2), fb = *(const LAS bf16x8*)((const LAS char*)(shm + G1_QT) + (32 * tb + r32) * PQ + (16 * ks + 8 * hi) * 2);
                    a = __builtin_amdgcn_mfma_f32_32x32x16_bf16(fa, fb, a, 0, 0, 0); }
            }
            const int t = 32 * tb + r32;
#pragma unroll
            for (int g = 0; g < 4; ++g) { const int s0 = 32 * sb + 8 * g + 4 * hi; float v[4];
#pragma unroll
                for (int e = 0; e < 4; ++e) v[e] = (s0 + e <= t) ? a[4 * g + e] : 0.f;
                u32x2 w; w.x = pk2(v[0], v[1]); w.y = pk2(v[2], v[3]); *(u32x2*)(ATT + t * 64 + s0) = w; }
        }
        if (c < NTILE - 1) {
          if (ci == 0) {
#pragma unroll
              for (int kb = 0; kb < 4; ++kb) acc[kb] = f32x16{};
          } else {
#pragma unroll
              for (int kb = 0; kb < 4; ++kb)
#pragma unroll
                  for (int g = 0; g < 4; ++g) { const f32x4 gm = *(const f32x4*)(scr + 512 + 32 * kb + 8 * g + 4 * hi); acc[kb][4 * g] *= gm.x; acc[kb][4 * g + 1] *= gm.y; acc[kb][4 * g + 2] *= gm.z; acc[kb][4 * g + 3] *= gm.w; }
          }
#pragma unroll
          for (int ks = 0; ks < 4; ++ks) {
              const bf16x8 fv = tr_frag((const LAS char*)(shm + G1_VT), PV, 32 * wave, ks, lane);
#pragma unroll
              for (int kb = 0; kb < 4; ++kb) { const bf16x8 fk = tr_frag((const LAS char*)(shm + G1_KH), PKH, 32 * kb, ks, lane); acc[kb] = __builtin_amdgcn_mfma_f32_32x32x16_bf16(fk, fv, acc[kb], 0, 0, 0); }
          }
          const int dv = 32 * wave + r32;
#pragma unroll
          for (int kb = 0; kb < 4; ++kb) {
              unsigned g0 = pk4_e4m3(acc[kb][0], acc[kb][1], acc[kb][2], acc[kb][3]), g1 = pk4_e4m3(acc[kb][4], acc[kb][5], acc[kb][6], acc[kb][7]);
              unsigned g2 = pk4_e4m3(acc[kb][8], acc[kb][9], acc[kb][10], acc[kb][11]), g3 = pk4_e4m3(acc[kb][12], acc[kb][13], acc[kb][14], acc[kb][15]);
              { const auto r = __builtin_amdgcn_permlane32_swap(g0, g2, false, false); g0 = r[0]; g2 = r[1]; }
              { const auto r = __builtin_amdgcn_permlane32_swap(g1, g3, false, false); g1 = r[0]; g3 = r[1]; }
              *(u32x4*)(DST + dv * 128 + 32 * kb + 16 * hi) = (u32x4){g0, g2, g1, g3};
          } }
        __syncthreads();
        if (!more) break;
        ci = same ? ci + 1 : 0; pair = pairn; bh = bhn; c = cn; b = bh >> 2; h = bh & 3;
    }
#undef G1_LOAD_QK
#undef G1_LOAD_V
}
__device__ __forceinline__ void g2_phase(Frame& F) {
    const unsigned char* LS = (const unsigned char*)F.out; const float* GAM = (const float*)(F.ws + S_GAM); bf16* BST = (bf16*)(F.ws + A_BST);
    for (int e4 = blockIdx.x * NTHREADS + F.tid; e4 < NB * GH * 8192; e4 += F.G * NTHREADS) {
        const int bh = e4 >> 13, idx = e4 & 8191, dk0 = (idx * 4) & 127;
        unsigned dd[15]; f32x4 gg[15];
#pragma unroll
        for (int r = 0; r < 15; ++r) { const size_t j = 8 * r + 7; dd[r] = *(const unsigned*)(LS + ((size_t)bh * (NTILE - 1) + j) * 32768 + idx * 4); gg[r] = *(const f32x4*)(GAM + ((size_t)bh * NTILE + j) * 128 + dk0); }
        float s0 = 0.f, s1 = 0.f, s2 = 0.f, s3 = 0.f;
#pragma unroll
        for (int r = 0; r < 15; ++r) {
            const f32x2_t lo = __builtin_amdgcn_cvt_pk_f32_fp8((int)dd[r], false), hi2 = __builtin_amdgcn_cvt_pk_f32_fp8((int)dd[r], true);
            s0 = gg[r].x * s0 + lo.x; s1 = gg[r].y * s1 + lo.y; s2 = gg[r].z * s2 + hi2.x; s3 = gg[r].w * s3 + hi2.y;
            *(u32x2*)(BST + ((size_t)bh * 15 + r) * 32768 + idx * 4) = (u32x2){pk2(s0, s1), pk2(s2, s3)}; }
    }
}
constexpr int G3_QT = 0, G3_AT = 17408, G3_VT = 26624, G3_PART = 63488, G3_QT2 = 65536;
constexpr int PA = 144;
__device__ __forceinline__ void g3_phase(const Args& args, Frame& F) {
    const int tid = F.tid, lane = F.lane, wave = F.wave, r32 = lane & 31, hi = lane >> 5;
    unsigned char* shm = F.lds + RING_OFF;
    const bf16* QT = (const bf16*)(F.ws + A_QT); const bf16* ZV = (const bf16*)(F.ws + A_ZV); const bf16* ZR = (const bf16*)(F.ws + A_ZR); bf16* OG = (bf16*)(F.ws + A_OG);
    float* part = (float*)(shm + G3_PART);
    const float* gout = FIN(I_GGOUT);
    constexpr int NPAIR = NB * GH * 16;
    const float* GAM = (const float*)(F.ws + S_GAM); const bf16* BST = (const bf16*)(F.ws + A_BST);
    int pair = blockIdx.x; if (pair >= NPAIR) return;
    int ci = 0;
    int bh = pair & 15, c = 8 * (pair >> 4) + 1, b = bh >> 2, h = bh & 3;
    u32x4 qp[2], ap, vp[4]; u32x2 sf[8]; f32x4 pj[2][2];
    bf16x8 bfr[8];
#define G3_LOAD() do { const int unit_ = bh * NTILE + c; const bf16* ATT_ = (const bf16*)(F.ws + A_ATT) + (size_t)unit_ * 4096; const unsigned char* SB_ = (const unsigned char*)F.out + (size_t)(bh * (NTILE - 1) + c - 1) * 32768; \
        _Pragma("unroll") for (int j = 0; j < 2; ++j) { const int p = tid + 512 * j, i = p >> 4, d0 = (p & 15) * 8; qp[j] = *(const u32x4*)(QT + (size_t)row_of(b, c, i) * 512 + h * 128 + d0); } \
        { const int i = tid >> 3, s0 = (tid & 7) * 8; ap = *(const u32x4*)(ATT_ + i * 64 + s0); } \
        _Pragma("unroll") for (int j = 0; j < 4; ++j) { const int p = tid + 512 * j, i = p >> 5, dc = (p & 31) * 8; vp[j] = *(const u32x4*)(ZV + (size_t)row_of(b, c, i) * 1024 + h * 256 + dc); } \
        _Pragma("unroll") for (int j = 0; j < 2; ++j) { const int d0 = ((tid + 512 * j) & 15) * 8; const float* pp_ = GAM + ((size_t)bh * NTILE + c - 1) * 128 + d0; pj[j][0] = *(const f32x4*)pp_; pj[j][1] = *(const f32x4*)(pp_ + 4); } \
        { _Pragma("unroll") for (int ks = 0; ks < 8; ++ks) sf[ks] = *(const u32x2*)(SB_ + (32 * wave + r32) * 128 + 16 * ks + 8 * hi); } } while (0)
#define G3_LOADB() do { if ((pair >> 4) > 0) { const bf16* bp_ = BST + ((size_t)bh * 15 + (pair >> 4) - 1) * 32768 + (32 * wave + r32) * 128 + 8 * hi; _Pragma("unroll") for (int ks = 0; ks < 8; ++ks) bfr[ks] = *(const bf16x8*)(bp_ + 16 * ks); } } while (0)
    G3_LOAD(); G3_LOADB();
    float go[4][4];
#pragma unroll
    for (int g = 0; g < 4; ++g)
#pragma unroll
        for (int e = 0; e < 4; ++e) go[g][e] = gout[32 * wave + 8 * g + 4 * hi + e];
    for (;;) {
#pragma unroll
        for (int j = 0; j < 2; ++j) { const int p = tid + 512 * j, i = p >> 4, d0 = (p & 15) * 8; *(u32x4*)(shm + G3_QT + i * PQ + d0 * 2) = qp[j];
            if ((pair >> 4) > 0) { float x[8]; unpack8(qp[j], x);
                x[0] *= pj[j][0].x; x[1] *= pj[j][0].y; x[2] *= pj[j][0].z; x[3] *= pj[j][0].w; x[4] *= pj[j][1].x; x[5] *= pj[j][1].y; x[6] *= pj[j][1].z; x[7] *= pj[j][1].w;
                *(u32x4*)(shm + G3_QT2 + i * PQ + d0 * 2) = pack8(x); } }
        { const int i = tid >> 3, s0 = (tid & 7) * 8; *(u32x4*)(shm + G3_AT + i * PA + s0 * 2) = ap; }
#pragma unroll
        for (int j = 0; j < 4; ++j) { const int p = tid + 512 * j, i = p >> 5, dc = (p & 31) * 8; *(u32x4*)(shm + G3_VT + i * PV + dc * 2) = vp[j]; }
        u32x2 rw[2][4];
#pragma unroll
        for (int tb = 0; tb < 2; ++tb) { const int row = row_of(b, c, 32 * tb + r32);
#pragma unroll
            for (int g = 0; g < 4; ++g) rw[tb][g] = *(const u32x2*)(ZR + (size_t)row * 1024 + h * 256 + 32 * wave + 8 * g + 4 * hi); }
        __syncthreads();
        f32x16 acc[2] = {};
        {
#pragma unroll
            for (int ks = 0; ks < 8; ++ks) {
                const f32x2_t e0 = __builtin_amdgcn_cvt_pk_f32_fp8((int)sf[ks].x, false), e1 = __builtin_amdgcn_cvt_pk_f32_fp8((int)sf[ks].x, true), e2 = __builtin_amdgcn_cvt_pk_f32_fp8((int)sf[ks].y, false), e3 = __builtin_amdgcn_cvt_pk_f32_fp8((int)sf[ks].y, true);
                const bf16x8 sfb = __builtin_bit_cast(bf16x8, (u32x4){pk2(e0.x, e0.y), pk2(e1.x, e1.y), pk2(e2.x, e2.y), pk2(e3.x, e3.y)});
#pragma unroll
                for (int tb = 0; tb < 2; ++tb) { const bf16x8 fb = *(const LAS bf16x8*)((const LAS char*)(shm + G3_QT) + (32 * tb + r32) * PQ + (16 * ks + 8 * hi) * 2); acc[tb] = __builtin_amdgcn_mfma_f32_32x32x16_bf16(sfb, fb, acc[tb], 0, 0, 0); }
            }
            if ((pair >> 4) > 0) {
#pragma unroll
                for (int ks = 0; ks < 8; ++ks)
#pragma unroll
                    for (int tb = 0; tb < 2; ++tb) { const bf16x8 fb = *(const LAS bf16x8*)((const LAS char*)(shm + G3_QT2) + (32 * tb + r32) * PQ + (16 * ks + 8 * hi) * 2); acc[tb] = __builtin_amdgcn_mfma_f32_32x32x16_bf16(bfr[ks], fb, acc[tb], 0, 0, 0); }
            }
        }
        const bool same = ci + 1 < 8; const int pairn = same ? pair : pair + F.G; const bool more = same || pairn < NPAIR; const int bhn = pairn & 15, cn = same ? c + 1 : 8 * (pairn >> 4) + 1;
        const int b0 = b, c0 = c, h0 = h, bh0 = bh;
        if (more) { bh = bhn; c = cn; b = bh >> 2; h = bh & 3; G3_LOAD(); bh = bh0; c = c0; b = b0; h = h0; }
#pragma unroll
        for (int ks = 0; ks < 4; ++ks) {
            const bf16x8 fv = tr_frag((const LAS char*)(shm + G3_VT), PV, 32 * wave, ks, lane);
#pragma unroll
            for (int tb = 0; tb < 2; ++tb) { const bf16x8 fb = *(const LAS bf16x8*)((const LAS char*)(shm + G3_AT) + (32 * tb + r32) * PA + (16 * ks + 8 * hi) * 2); acc[tb] = __builtin_amdgcn_mfma_f32_32x32x16_bf16(fv, fb, acc[tb], 0, 0, 0); }
        }
#pragma unroll
        for (int tb = 0; tb < 2; ++tb) { float sq = 0.f;
#pragma unroll
            for (int r = 0; r < 16; ++r) sq += acc[tb][r] * acc[tb][r];
            sq += __shfl_xor(sq, 32);
            if (hi == 0) part[wave * 64 + 32 * tb + r32] = sq; }
        __syncthreads();
#pragma unroll
        for (int tb = 0; tb < 2; ++tb) {
            const int t = 32 * tb + r32; float tot = 0.f;
#pragma unroll
            for (int w = 0; w < 8; ++w) tot += part[w * 64 + t];
            const float rstd = rsqrtf(tot * (1.f / GDV) + EPS);
            const int row = row_of(b, c, t);
#pragma unroll
            for (int g = 0; g < 4; ++g) {
                const int dv = 32 * wave + 8 * g + 4 * hi; const u32x2 rwv = rw[tb][g];
                const float rv[4] = {bf2f(rwv.x & 0xffff), bf2f(rwv.x >> 16), bf2f(rwv.y & 0xffff), bf2f(rwv.y >> 16)}; float o[4];
#pragma unroll
                for (int e = 0; e < 4; ++e) o[e] = acc[tb][4 * g + e] * rstd * go[g][e] * (rv[e] * __builtin_amdgcn_rcpf(1.f + __expf(-rv[e])));
                u32x2 w; w.x = pk2(o[0], o[1]); w.y = pk2(o[2], o[3]); *(u32x2*)(OG + (size_t)row * 1024 + h * 256 + dv) = w;
            }
        }
        __syncthreads();
        if (!more) break;
        ci = same ? ci + 1 : 0; pair = pairn; bh = bhn; c = cn; b = bh >> 2; h = bh & 3;
        if (!same) G3_LOADB();
    }
#undef G3_LOAD
#undef G3_LOADB
}

template <bool FINAL>
__device__ __forceinline__ void combine_rows(const Args& args, Frame& F, const MoeTables& T, float* rs2) {
    const unsigned char* y = (const unsigned char*)(F.ws + A_Y); bf16* hb = (bf16*)(F.ws + A_HB); const unsigned* epos = (const unsigned*)(F.ws + S_EPOS); const unsigned* wtsu = (const unsigned*)(F.ws + S_WTS);
    const int gw = F.vcu * NWAVES + F.wave, NGW = F.G * NWAVES, lane = F.lane;
    const int RMAX = FINAL ? NREAL : MROWS;
#define CB_META(r_) ((lane < 2 ? epos : wtsu)[2 * (size_t)(r_) + (lane & 1)])
#define CB_LOAD(r_, m_, h_, y0_, y1_, w0_, w1_) do { if (!row_is_dummy(r_)) { \
            const unsigned e0_ = (unsigned)__builtin_amdgcn_readlane((int)m_, 0), e1_ = (unsigned)__builtin_amdgcn_readlane((int)m_, 1); \
            w0_ = Y_INV * __uint_as_float((unsigned)__builtin_amdgcn_readlane((int)m_, 2)); w1_ = Y_INV * __uint_as_float((unsigned)__builtin_amdgcn_readlane((int)m_, 3)); \
            const size_t ya_ = (size_t)T.cpre[e0_ >> 20] + (e0_ & 0xfffffu), yb_ = (size_t)T.cpre[e1_ >> 20] + (e1_ & 0xfffffu); \
            _Pragma("unroll") for (int j = 0; j < 4; ++j) { h_[j] = *(const u32x2*)(hb + (size_t)(r_) * 1024 + 4 * lane + 256 * j); \
                y0_[j] = *(const unsigned*)(y + ya_ * 1024 + 4 * lane + 256 * j); y1_[j] = *(const unsigned*)(y + yb_ * 1024 + 4 * lane + 256 * j); } } } while (0)
    u32x2 ha[4], hq[4]; unsigned ya0[4], ya1[4], yb0[4], yb1[4]; float wa0 = 0.f, wa1 = 0.f, wb0 = 0.f, wb1 = 0.f; unsigned mnext = 0u;
    if (gw < RMAX) { unsigned m0 = row_is_dummy(gw) ? 0u : CB_META(gw); CB_LOAD(gw, m0, ha, ya0, ya1, wa0, wa1); if (gw + NGW < RMAX && !row_is_dummy(gw + NGW)) mnext = CB_META(gw + NGW); }
    for (int r = gw; r < RMAX; r += NGW) {
        const int rn = r + NGW, rnn = r + 2 * NGW;
        if (rn < RMAX) CB_LOAD(rn, mnext, hq, yb0, yb1, wb0, wb1);
        if (rnn < RMAX && !row_is_dummy(rnn)) mnext = CB_META(rnn);
        if (row_is_dummy(r)) {
            if (!FINAL && lane == 0) rs2[r] = 0.f;
        } else {
            f32x4 v[4];
#pragma unroll
            for (int j = 0; j < 4; ++j) { const u32x2 q = ha[j];
                const f32x2_t a0 = __builtin_amdgcn_cvt_pk_f32_fp8((int)ya0[j], false), a1 = __builtin_amdgcn_cvt_pk_f32_fp8((int)ya0[j], true), b0 = __builtin_amdgcn_cvt_pk_f32_fp8((int)ya1[j], false), b1 = __builtin_amdgcn_cvt_pk_f32_fp8((int)ya1[j], true);
                v[j].x = bf2f(q.x & 0xffff) + (wa0 * a0.x + wa1 * b0.x); v[j].y = bf2f(q.x >> 16) + (wa0 * a0.y + wa1 * b0.y);
                v[j].z = bf2f(q.y & 0xffff) + (wa0 * a1.x + wa1 * b1.x); v[j].w = bf2f(q.y >> 16) + (wa0 * a1.y + wa1 * b1.y); }
            if (FINAL) {
#pragma unroll
                for (int j = 0; j < 4; ++j) __builtin_nontemporal_store(v[j], (f32x4*)(F.out + (size_t)r * 1024 + 4 * lane + 256 * j));
            } else {
#pragma unroll
                for (int j = 0; j < 4; ++j) { u32x2 o; o.x = pk2(v[j].x, v[j].y); o.y = pk2(v[j].z, v[j].w); *(u32x2*)(hb + (size_t)r * 1024 + 4 * lane + 256 * j) = o;
                    v[j] = (f32x4){bf2f(o.x & 0xffff), bf2f(o.x >> 16), bf2f(o.y & 0xffff), bf2f(o.y >> 16)}; }
                float sq = 0.f;
#pragma unroll
                for (int j = 0; j < 4; ++j) sq += (v[j].x * v[j].x + v[j].y * v[j].y) + (v[j].z * v[j].z + v[j].w * v[j].w);
                const float rstd = rsqrtf(wave_sum(sq) * (1.f / 1024.f) + EPS);
                if (lane == 0) rs2[r] = rstd;
            }
        }
#pragma unroll
        for (int j = 0; j < 4; ++j) { ha[j] = hq[j]; ya0[j] = yb0[j]; ya1[j] = yb1[j]; }
        wa0 = wb0; wa1 = wb1;
    }
#undef CB_META
#undef CB_LOAD
}

__device__ __forceinline__ void glr_skinny(Frame& F, const bf16* hb, const bf16* Wg, const float* rs2, float* GLR) {
    const int tid = F.tid, lane = F.lane, l15 = lane & 15, kq = lane >> 4;
    LAS unsigned char* wl = (LAS unsigned char*)F.lds + RING_OFF;
    __syncthreads();
#pragma unroll
    for (int i = 0; i < 4; ++i) { const int p = tid + 512 * i, n = p >> 7, c = (p & 127) * 16; *(LAS u32x4*)(wl + n * 2064 + c) = *(const u32x4*)((const char*)Wg + (size_t)n * 2048 + c); }
    __syncthreads();
    const int NG = MROWS / 16;
    for (int grp = F.vcu * NWAVES + F.wave; grp < NG; grp += F.G * NWAVES) {
        const bf16* ap = hb + (size_t)(16 * grp + l15) * 1024 + 8 * kq;
        f32x4 acc = {};
#pragma unroll 1
        for (int bt = 0; bt < 4; ++bt) {
            u32x4 a[8];
#pragma unroll
            for (int j = 0; j < 8; ++j) a[j] = *(const u32x4*)(ap + 32 * (8 * bt + j));
#pragma unroll
            for (int j = 0; j < 8; ++j) { const bf16x8 b = *(const LAS bf16x8*)(wl + l15 * 2064 + (8 * bt + j) * 64 + kq * 16); acc = __builtin_amdgcn_mfma_f32_16x16x32_bf16(__builtin_bit_cast(bf16x8, a[j]), b, acc, 0, 0, 0); }
        }
#pragma unroll
        for (int r = 0; r < 4; ++r) { const int row = 16 * grp + 4 * kq + r; GLR[(size_t)row * 16 + l15] = acc[r] * rs2[row]; }
    }
    __syncthreads();
}

template <class EpiF>
__device__ __forceinline__ void meta_gemm(const bf16* A, int lda, const bf16* Bt, int K, int N, Frame& F, EpiF epi) {
    if (F.vcu >= N / 32) return;
    const int lane = F.lane, wave = F.wave, l15 = lane & 15, kq = lane >> 4, kpart = wave & 3;
    const int col0 = 16 * (2 * F.vcu + (wave >> 2)), k0 = kpart * (K / 4), nks = K / 128;
    float* red = (float*)(F.lds + RING_OFF);
    f32x4 acc[4] = {};
#pragma unroll 4
    for (int s4 = 0; s4 < nks; ++s4) {
        const bf16x8 bfr = *(const bf16x8*)(Bt + (size_t)(col0 + l15) * K + k0 + 32 * s4 + 8 * kq);
#pragma unroll
        for (int rb = 0; rb < 4; ++rb) { const bf16x8 afr = *(const bf16x8*)(A + (size_t)(NREAL + rb * 64 + 48 + l15) * lda + k0 + 32 * s4 + 8 * kq); acc[rb] = __builtin_amdgcn_mfma_f32_16x16x32_bf16(afr, bfr, acc[rb], 0, 0, 0); }
    }
#pragma unroll
    for (int rb = 0; rb < 4; ++rb)
#pragma unroll
        for (int rg = 0; rg < 4; ++rg) red[(wave * 16 + rb * 4 + rg) * 64 + lane] = acc[rb][rg];
    __syncthreads();
    if (kpart == 0) {
#pragma unroll
        for (int rb = 0; rb < 4; ++rb)
#pragma unroll
            for (int rg = 0; rg < 4; ++rg) { float v = acc[rb][rg];
#pragma unroll
                for (int w = 1; w < 4; ++w) v += red[((wave + w) * 16 + rb * 4 + rg) * 64 + lane];
                epi(NREAL + rb * 64 + 48 + 4 * kq + rg, col0 + l15, v); }
    }
    __syncthreads();
}

struct MetaEpiQ { bf16* QR; const float* part;
    __device__ __forceinline__ void operator()(int row, int col, float v) const { float ss = 0.f;
#pragma unroll
        for (int i = 0; i < 12; ++i) ss += part[(size_t)row * 24 + i];
        QR[(size_t)row * 1536 + col] = (bf16)f2bf(v * rsqrtf(ss * (1.f / MLA_Q) + EPS)); } };
struct MetaEpiKV { bf16* KN; bf16* VT; const float* part;
    __device__ __forceinline__ void operator()(int row, int col, float v) const { float ss = 0.f;
#pragma unroll
        for (int i = 12; i < 20; ++i) ss += part[(size_t)row * 24 + i];
        const bf16 o = (bf16)f2bf(v * rsqrtf(ss * (1.f / MLA_KV) + EPS));
        int b, tile, r64; row_btr(row, b, tile, r64);
        if (col < 1024) { const int pn = col >> 8, bj = (col >> 7) & 1, wc = (col >> 5) & 3, head = 4 * pn + wc, d = 32 * bj + (col & 31); KN[(size_t)row * 1024 + head * 64 + d] = o; }
        else { const int hv = (col - 1024) >> 6, d = col & 63; VT[((((size_t)(b * NHEAD + hv) * NTILE + tile) * 2 + (d >> 5)) * 64 + r64) * 32 + (d & 31)] = o; } } };
struct MetaEpiRes { const float* meta; bf16* hb;
    __device__ __forceinline__ void operator()(int row, int col, float v) const { const int q = row - NREAL;
        const float sv = meta ? meta[(size_t)((q & 63) - 48) * 1024 + col] : bf2f(hb[(size_t)row * 1024 + col]); hb[(size_t)row * 1024 + col] = (bf16)f2bf(sv + v); } };

struct MetaEpiZgla { bf16* ZQK; bf16* ZV; bf16* ZR; const float* rs2;
    __device__ __forceinline__ void operator()(int row, int col, float v) const { bf16* dst = col < 1024 ? ZQK : (col < 2048 ? ZV : ZR); dst[(size_t)row * 1024 + (col & 1023)] = (bf16)f2bf(v * rs2[row]); } };

#ifndef STOP_AFTER
#define STOP_AFTER 99
#endif
constexpr int N_PHASES = 19;
__global__ void __launch_bounds__(NTHREADS, 2) fwd_kernel(const Args args) {
    extern __shared__ __attribute__((aligned(16))) unsigned char lds_raw[];
    Frame F;
    F.lds = lds_raw; F.MISC = (volatile LAS unsigned*)((LAS unsigned char*)lds_raw + MISC_OFF);
    F.tid = threadIdx.x; F.lane = F.tid & 63; F.wave = __builtin_amdgcn_readfirstlane(F.tid >> 6);
    F.G = gridDim.x; { const int bx = blockIdx.x; F.vcu = (F.G % 8 == 0) ? (bx % 8) * (F.G / 8) + bx / 8 : bx; }
    F.ws = args.ws; F.ctl = (unsigned*)(args.ws + WS_CTL); F.out = args.out;
    for (int u = F.tid; u < (LDS_BYTES - LDSCTL_OFF) / 4; u += NTHREADS) ((LAS unsigned*)((LAS unsigned char*)lds_raw + LDSCTL_OFF))[u] = 0u;
    __syncthreads();
    XcdBarrier bar = xcd_barrier_post(F.ctl + CW_BAR, F.MISC);
    const int lo = args.ph_lo, hi = args.ph_hi;
    LAS unsigned char* ldsl = (LAS unsigned char*)lds_raw + RING_OFF;
    unsigned char* ws = F.ws;
#ifndef ONLY_PHASE
#define ONLY_PHASE -1
#endif
#define IN(k) ((ONLY_PHASE < 0 || ONLY_PHASE == (k)) && lo <= (k) && (k) < hi)
#ifndef DUP_MASK
#define DUP_MASK 0
#endif
#define REP(k) _Pragma("unroll") for (int rep_ = 0; rep_ < 1 + ((DUP_MASK >> (k)) & 1); ++rep_)
#define SEAM(k) do { if (IN(k) && IN((k) + 1)) xcd_barrier(bar); } while (0)

    if (IN(0)) REP(0) { __syncthreads(); p0_prologue(args, F); } SEAM(0);
    if (IN(1)) REP(1) { __syncthreads();
        pg8::DenseSched S; S.init(MROWS, MLA_INP, F.G, (int)blockIdx.x, ws + A_HN, 1024, ws + W_MI, 1024);
        EpiZmla E{(bf16*)(ws + A_ZMLA), (float*)(ws + S_PART)};
        pg8::gemm_phase(ldsl, 1024, S, E);
        if (F.G == 256 && (int)blockIdx.x >= 387 - 256) {
            const int nw = (2 * 256 - 387) * NWAVES, lim = nw * P1_FILL_PER_WAVE < D1_ITEMS ? nw * P1_FILL_PER_WAVE : D1_ITEMS;
            def_convert<1>(args, F, ((int)blockIdx.x - (387 - 256)) * NWAVES + F.wave, nw, lim, P1_FILL_PER_WAVE); }
    } SEAM(1);
    if (IN(2)) REP(2) { __syncthreads();
        { meta_gemm((const bf16*)(ws + A_ZMLA), MLA_INP, (const bf16*)(ws + W_UQ), MLA_Q, 1536, F, MetaEpiQ{(bf16*)(ws + A_QRAW), (const float*)(ws + S_PART)});
          meta_gemm((const bf16*)(ws + A_ZMLA) + MLA_Q, MLA_INP, (const bf16*)(ws + W_UKV), MLA_KV, 2048, F, MetaEpiKV{(bf16*)(ws + A_KNRAW), (bf16*)F.out, (const float*)(ws + S_PART)}); }
        { pg8::DenseSched S; S.init(NREAL, 1536, F.G, (int)blockIdx.x, ws + A_ZMLA, MLA_INP, ws + W_UQ, MLA_Q);
          EpiQ E{(bf16*)(ws + A_QRAW), (const float*)(ws + S_PART)}; pg8::gemm_phase(ldsl, MLA_Q, S, E);
#ifdef DUP_Q
          __syncthreads(); pg8::gemm_phase(ldsl, MLA_Q, S, E);
#endif
        }
        { pg8::DenseSched S; S.init(NREAL, 2048, F.G, (int)blockIdx.x, ws + A_ZMLA + MLA_Q * 2, MLA_INP, ws + W_UKV, MLA_KV);
          EpiKV E{(bf16*)(ws + A_K), (bf16*)F.out, (const float*)(ws + S_PART), (float*)(ws + A_KNRAW), FIN(I_MGKN)}; pg8::gemm_phase(ldsl, MLA_KV, S, E);
#ifdef DUP_KV
          __syncthreads(); pg8::gemm_phase(ldsl, MLA_KV, S, E);
#endif
        }
    } SEAM(2);
    if (IN(3)) REP(3) { __syncthreads(); kprep_phase(args, F); } SEAM(3);
    if (IN(4)) REP(4) { __syncthreads(); attn_phase(args, F); } SEAM(4);
    if (IN(5)) REP(5) { __syncthreads();
        meta_gemm((const bf16*)(ws + A_O), 1024, (const bf16*)(ws + W_OM), 1024, 1024, F, MetaEpiRes{FIN(I_META), (bf16*)(ws + A_HB)});
        pg8::DenseSched S; S.init(NREAL, 1024, F.G, (int)blockIdx.x, ws + A_O8, 512, ws + A_WOM8, 512);
        EpiRes8 E{FIN(I_X), (bf16*)(ws + A_HB)}; pg8::gemm_phase(ldsl, 512, S, E);
    } SEAM(5);
#if STOP_AFTER >= 6
    if (IN(6)) { route_phase(args, F, 0, (const bf16*)(ws + A_HB), F.ctl + CW_CNT, (int*)(ws + S_LIST), (float*)(ws + S_WTS), (unsigned*)(ws + S_EPOS), (float*)(ws + A_RSL));
 } SEAM(6);
    if (IN(7)) REP(7) { __syncthreads();
        MoeTables T = moe_tables(F, F.ctl + CW_CNT);
        MoeSched S{T, 2, F.G, F.vcu, true, (const char*)(ws + A_HB), 1024, (const char*)(ws + W_GU), 1024, (size_t)512 * 1024 * 2, (const int*)(ws + S_LIST)};
        EpiGU E{(bf16*)(ws + A_HID), (const float*)(ws + A_RSL), T.cnt}; pg8::gemm_phase(ldsl, 1024, S, E);
        def_fill_idle<7>(args, F, (int)T.tpre[32] * 2, WD_ITEMS, P7_FILL_PER_WAVE, true);
        { const int tot = (int)T.tpre[32] * 2, maxu = (tot + F.G - 1) / F.G, thr = tot - (maxu - 1) * F.G, nfill = F.G - thr;
          if (F.vcu >= thr && nfill > 0) { int cov = nfill * NWAVES * P7_FILL2_PER_WAVE; cov = cov < GU_ITEMS ? cov : GU_ITEMS; def_convert<7>(args, F, WD_ITEMS + (F.vcu - thr) * NWAVES + F.wave, nfill * NWAVES, WD_ITEMS + cov, P7_FILL2_PER_WAVE); } }
    } SEAM(7);
    if (IN(8)) REP(8) { __syncthreads();
        MoeTables T = moe_tables(F, F.ctl + CW_CNT);
        MoeSched S{T, 4, F.G, F.vcu, false, (const char*)(ws + A_HID), 256, (const char*)(ws + W_D), 256, (size_t)1024 * 256 * 2, (const int*)(ws + S_LIST)};
        EpiDown E{(unsigned char*)(ws + A_Y), T.cnt, T.cpre}; pg8::gemm_phase(ldsl, 256, S, E);
    } SEAM(8);
#endif
#if STOP_AFTER >= 9
    if (IN(9)) { MoeTables T = moe_tables(F, F.ctl + CW_CNT); combine_rows<false>(args, F, T, (float*)(ws + S_SSQ_Q)); } SEAM(9);
#endif
#if STOP_AFTER >= 10
    if (IN(10)) REP(10) { __syncthreads();
        meta_gemm((const bf16*)(ws + A_HB), 1024, (const bf16*)(ws + W_GI), 1024, 3072, F, MetaEpiZgla{(bf16*)(ws + A_ZQK), (bf16*)(ws + A_ZV), (bf16*)(ws + A_ZR), (const float*)(ws + S_SSQ_Q)});
        pg8::DenseSched S; S.init(NREAL, 3072, F.G, (int)blockIdx.x, ws + A_HB, 1024, ws + W_GI, 1024);
        EpiZgla E{(bf16*)(ws + A_ZQK), (bf16*)(ws + A_ZV), (bf16*)(ws + A_ZR), (float*)(ws + S_GLR), (const float*)(ws + S_SSQ_Q)}; pg8::gemm_phase(ldsl, 1024, S, E);
        glr_skinny(F, (const bf16*)(ws + A_HB), (const bf16*)(ws + W_GI) + (size_t)3072 * 1024, (const float*)(ws + S_SSQ_Q), (float*)(ws + S_GLR));
    } SEAM(10);
    if (IN(11)) REP(11) { __syncthreads(); g1_phase(args, F); } SEAM(11);
    if (IN(12)) { g2_phase(F); } SEAM(12);
    if (IN(13)) REP(13) { __syncthreads(); g3_phase(args, F); } SEAM(13);
    if (IN(14)) {
        pg8::DenseSched S; S.init(NREAL, 1024, F.G, (int)blockIdx.x, ws + A_OG, 1024, ws + W_OG, 1024);
        EpiRes E{nullptr, (bf16*)(ws + A_HB)}; pg8::gemm_phase(ldsl, 1024, S, E);
    } SEAM(14);
#endif
#if STOP_AFTER >= 15
    if (IN(15)) { route_phase(args, F, 1, (const bf16*)(ws + A_HB), F.ctl + CW_CNT + 32, (int*)(ws + S_LIST), (float*)(ws + S_WTS), (unsigned*)(ws + S_EPOS), (float*)(ws + A_RSL));
        { MoeTables T0 = moe_tables(F, F.ctl + CW_CNT);
          const int tot = (int)T0.tpre[32] * 2, maxu = (tot + F.G - 1) / F.G, thr = tot - (maxu - 1) * F.G, nfill = F.G - thr; int cov = nfill > 0 ? nfill * NWAVES * P7_FILL2_PER_WAVE : 0; cov = cov < GU_ITEMS ? cov : GU_ITEMS;
          def_convert<7>(args, F, WD_ITEMS + cov + F.vcu * NWAVES + F.wave, F.G * NWAVES, D7_ITEMS, 1 << 30); }
    } SEAM(15);
    if (IN(16)) REP(16) { __syncthreads();
        MoeTables T = moe_tables(F, F.ctl + CW_CNT + 32);
        MoeSched S{T, 2, F.G, F.vcu, true, (const char*)(ws + A_HB), 1024, (const char*)(ws + W_GU) + (size_t)32 * 512 * 1024 * 2, 1024, (size_t)512 * 1024 * 2, (const int*)(ws + S_LIST)};
        EpiGU E{(bf16*)(ws + A_HID), (const float*)(ws + A_RSL), T.cnt}; pg8::gemm_phase(ldsl, 1024, S, E);
        def_fill_idle<16>(args, F, (int)T.tpre[32] * 2, D16_ITEMS, P7_FILL_PER_WAVE, true);
    } SEAM(16);
    if (IN(17)) REP(17) { __syncthreads();
        MoeTables T = moe_tables(F, F.ctl + CW_CNT + 32);
        MoeSched S{T, 4, F.G, F.vcu, false, (const char*)(ws + A_HID), 256, (const char*)(ws + W_D) + (size_t)32 * 1024 * 256 * 2, 256, (size_t)1024 * 256 * 2, (const int*)(ws + S_LIST)};
        EpiDown E{(unsigned char*)(ws + A_Y), T.cnt, T.cpre}; pg8::gemm_phase(ldsl, 256, S, E);
    } SEAM(17);
    if (IN(18)) { MoeTables T = moe_tables(F, F.ctl + CW_CNT + 32); combine_rows<true>(args, F, T, nullptr); }
#endif
#undef IN
#undef SEAM
}

#ifndef N_LAUNCH_SPLIT
#define N_LAUNCH_SPLIT 0
#endif
extern "C" void kernel_launch(void* const* d_in, const int* in_sizes, int n_in, void* d_out, int out_size, void* d_ws, size_t ws_size, hipStream_t stream) {
    static int grid = 0;
    if (grid == 0) {
        if (n_in != 24 || ws_size < WS_END) { fprintf(stderr, "kernel_launch: needs 24 inputs and %zu bytes of workspace (got %d, %zu)\n", (size_t)WS_END, n_in, ws_size); grid = -1; return; }
        int dev = 0, cus = 0, per_cu = 0;
        if (hipGetDevice(&dev) != hipSuccess || hipDeviceGetAttribute(&cus, hipDeviceAttributeMultiprocessorCount, dev) != hipSuccess) { grid = -1; return; }
        if (hipFuncSetAttribute((const void*)fwd_kernel, hipFuncAttributeMaxDynamicSharedMemorySize, LDS_BYTES) != hipSuccess) { fprintf(stderr, "kernel_launch: hipFuncSetAttribute failed\n"); grid = -1; return; }
        if (hipOccupancyMaxActiveBlocksPerMultiprocessor(&per_cu, (const void*)fwd_kernel, NTHREADS, LDS_BYTES) != hipSuccess || per_cu < 1) fprintf(stderr, "kernel_launch: occupancy query says %d\n", per_cu);
        (void)hipGetLastError();
        grid = cus;
    }
    if (grid < 0) return;
    (void)hipMemsetAsync((char*)d_ws + WS_CTL, 0, CTL_ZERO_BYTES, stream);
    Args a{};
    for (int i = 0; i < 24; ++i) a.in[i] = (const float*)d_in[i];
    a.out = (float*)d_out; a.ws = (unsigned char*)d_ws;
#if N_LAUNCH_SPLIT
    for (int p = 0; p < N_PHASES; ++p) { a.ph_lo = p; a.ph_hi = p + 1; hipLaunchKernelGGL(fwd_kernel, dim3(grid), dim3(NTHREADS), LDS_BYTES, stream, a); }
#else
    a.ph_lo = 0; a.ph_hi = N_PHASES;
    hipLaunchKernelGGL(fwd_kernel, dim3(grid), dim3(NTHREADS), LDS_BYTES, stream, a);
#endif
}
```

```cpp
#include <hip/hip_runtime.h>
#include <cstdio>
#include <cstdint>

#define LAS __attribute__((address_space(3)))
#define GAS __attribute__((address_space(1)))
typedef unsigned short bf16;
typedef short bf16x8 __attribute__((ext_vector_type(8)));
typedef short s16x4 __attribute__((ext_vector_type(4)));
typedef float f32x4 __attribute__((ext_vector_type(4)));
typedef float f32x16 __attribute__((ext_vector_type(16)));
typedef unsigned u32x4 __attribute__((ext_vector_type(4)));
typedef unsigned u32x2 __attribute__((ext_vector_type(2)));
typedef GAS unsigned gu32;

constexpr int NB = 4, SEQ = 8192, DM = 1024;
constexpr int NREAL = NB * SEQ;
constexpr int MROWS = NREAL + 256;
constexpr int NTILE = 129;
constexpr int NHEAD = 16, QK = 96, NOPE = 64, ROPE = 32, VD = 64;
constexpr int MLA_Q = 384, MLA_KV = 256, MLA_IN = 672, MLA_INP = 768;
constexpr int GH = 4, GDK = 128, GDV = 256, GNK = 512, GNV = 1024, GLA_IN = 3088, GLA_INP = 3328;
constexpr int NEXP = 32, DEXP = 256;
constexpr float EPS = 1e-6f;
constexpr int NWAVES = 8, NTHREADS = 512;

__device__ __forceinline__ float bf2f(unsigned short b) { return __uint_as_float(((unsigned)b) << 16); }
__device__ __forceinline__ unsigned f2bf(float f) { unsigned u = __float_as_uint(f); return (u + 0x7fffu + ((u >> 16) & 1u)) >> 16; }
typedef float f32x2_t __attribute__((ext_vector_type(2))); typedef __bf16 bf16x2_t __attribute__((ext_vector_type(2)));
__device__ __forceinline__ unsigned pk2(float lo, float hi) { f32x2_t v = {lo, hi}; bf16x2_t b = __builtin_convertvector(v, bf16x2_t); return __builtin_bit_cast(unsigned, b); }
constexpr float W_SC = 64.f, O_SC = 16.f, WO_INV = 1.f / (64.f * 16.f);
constexpr float KQ_SC = 0.38372263f;
__device__ __forceinline__ unsigned pk4_e4m3(float a, float b, float c, float d) {
    a = __builtin_amdgcn_fmed3f(a, -448.f, 448.f); b = __builtin_amdgcn_fmed3f(b, -448.f, 448.f); c = __builtin_amdgcn_fmed3f(c, -448.f, 448.f); d = __builtin_amdgcn_fmed3f(d, -448.f, 448.f);
    int w = 0; w = __builtin_amdgcn_cvt_pk_fp8_f32(a, b, w, false); w = __builtin_amdgcn_cvt_pk_fp8_f32(c, d, w, true); return (unsigned)w;
}
__device__ __forceinline__ unsigned pk4_bf8(float a, float b, float c, float d) { int w = 0; w = __builtin_amdgcn_cvt_pk_bf8_f32(a, b, w, false); w = __builtin_amdgcn_cvt_pk_bf8_f32(c, d, w, true); return (unsigned)w; }
__device__ __forceinline__ float max3f(float a, float b, float c) { float r; asm("v_max3_f32 %0, %1, %2, %3" : "=v"(r) : "v"(a), "v"(b), "v"(c)); return r; }
__device__ __forceinline__ float max2f(float a, float b) { float r; asm("v_max_f32_e32 %0, %1, %2" : "=v"(r) : "v"(a), "v"(b)); return r; }
__device__ __forceinline__ float wave_sum(float v) {
#pragma unroll
    for (int o = 1; o < 64; o <<= 1) v += __shfl_xor(v, o);
    return v;
}
#define LDS_WAIT() asm volatile("s_waitcnt lgkmcnt(0)" ::: "memory")
#define VM_WAIT() asm volatile("s_waitcnt vmcnt(0)" ::: "memory")

__device__ const float ROPE_INV[16] = {1.000000000e+00f, 5.623413324e-01f, 3.162277639e-01f, 1.778279394e-01f, 1.000000015e-01f, 5.623412877e-02f, 3.162277862e-02f, 1.778279431e-02f,
                                       9.999999776e-03f, 5.623413250e-03f, 3.162277862e-03f, 1.778279431e-03f, 1.000000047e-03f, 5.623413017e-04f, 3.162277862e-04f, 1.778279402e-04f};


__device__ __forceinline__ void fast_sincos(float a, float& sn, float& cs) {
    const float k = rintf(a * 0.15915494309189535f);
    float r = fmaf(-k, 6.2831854820251465f, a); r = fmaf(-k, -1.7484556e-7f, r);
    const float rev = r * 0.15915494309189535f;
    sn = __builtin_amdgcn_sinf(rev); cs = __builtin_amdgcn_cosf(rev);
}

__device__ __forceinline__ bool row_is_dummy(int r) { return r >= NREAL && ((r - NREAL) & 63) < 48; }
__device__ __forceinline__ int row_pos(int r) { return r < NREAL ? 16 + (r & (SEQ - 1)) : ((r - NREAL) & 63) - 48; }
__device__ __forceinline__ void row_btr(int r, int& b, int& tile, int& r64) {
    if (r < NREAL) { b = r >> 13; const int s = r & (SEQ - 1); tile = 1 + (s >> 6); r64 = s & 63; }
    else { const int q = r - NREAL; b = q >> 6; tile = 0; r64 = q & 63; }
}
__device__ __forceinline__ int row_of(int b, int tile, int r64) { return tile == 0 ? NREAL + b * 64 + r64 : b * SEQ + (tile - 1) * 64 + r64; }

namespace pg8 {
typedef unsigned short bf16_t; typedef int v8i_t __attribute__((ext_vector_type(8))); typedef int i32x4_t __attribute__((ext_vector_type(4)));
constexpr int BM = 256, BK = 64, HALF = 128, HTB = HALF * BK * 2, STAGE_BYTES = 8 * HTB, NXCD = 8, WGM = 8;
__host__ __device__ __forceinline__ int lds_byte(int r, int c) { const int st = (r >> 4) * 2 + (c >> 5), rr = r & 15, cc = c & 31, ob = rr * 64 + cc * 2; return st * 1024 + (ob ^ (((ob >> 9) & 1) << 5)); }
__host__ __device__ __forceinline__ void stage_rc(int b, int& R, int& C) { const int st = b / 1024, sb = b % 1024, swz = sb ^ (((sb >> 9) & 1) << 5); R = (st >> 1) * 16 + swz / 64; C = (st & 1) * 32 + (swz % 64) / 2; }
__host__ __device__ __forceinline__ int perm32(int rho) { const int n = rho >> 4, i = rho & 15; return 8 * (i >> 2) + 4 * n + (i & 3); }

struct Unit { int pm, pn, e, r0; };

struct DenseSched {
    int nM, nN, nwg, G, c;
    const char* A; int lda; const char* Bt; int K;
    __device__ void init(int M, int N, int G_, int c_, const void* A_, int lda_, const void* Bt_, int K_) { nM = M / BM; nN = N / BM; nwg = nM * nN; G = G_; c = c_; A = (const char*)A_; lda = lda_; Bt = (const char*)Bt_; K = K_; }
    __device__ bool next(int i, Unit& u) const {
        const long L = (long)i * G + c; if (L >= nwg) return false;
        int wgid = (int)L; { const int q = nwg / NXCD, r = nwg % NXCD, xcd = wgid % NXCD, off = wgid / NXCD; wgid = (xcd < r ? xcd * (q + 1) : r * (q + 1) + (xcd - r) * q) + off; }
        const int nig = WGM * nN, gid = wgid / nig, fm = gid * WGM, gsz = (nM - fm) < WGM ? (nM - fm) : WGM;
        u.pm = fm + ((wgid % nig) % gsz); u.pn = (wgid % nig) / gsz; u.e = 0; u.r0 = u.pm; return true;
    }
    __device__ __forceinline__ const char* a_base() const { return A; }
    __device__ __forceinline__ unsigned a_off(const Unit& u, int r, int c_) const { return (unsigned)(((u.pm * BM + r) * lda + c_) * 2); }
    __device__ __forceinline__ const char* b_ptr(const Unit& u) const { return Bt + (size_t)u.pn * BM * K * 2; }
};

template <class Epi, class Sched>
__device__ __forceinline__ void gemm_phase(LAS unsigned char* lds, const int K, const Sched& S, const Epi& E) {
    const int tid = threadIdx.x, wid = __builtin_amdgcn_readfirstlane(tid >> 6), lane = tid & 63, wr = wid >> 2, wc = wid & 3, fr = lane & 15, fq = lane >> 4;
    const int nt = K / BK;
    int sR[2], sC[2]; unsigned voffB[2];
#pragma unroll
    for (int i = 0; i < 2; ++i) { int R, C; stage_rc(tid * 16 + i * 8192, R, C); sR[i] = R; sC[i] = C; const int Rb = Epi::PERM ? ((Epi::ADJ ? (R >> 5) * 64 : (R & ~31)) + perm32(R & 31)) : R; voffB[i] = (unsigned)(Rb * K + C) * 2u; }
    const size_t kstep = (size_t)(BK * 2);
    const size_t hstepB = (size_t)(Epi::ADJ ? 32 : HALF) * K * 2;
    const unsigned ldsw = (unsigned)wid * 1024u;
    const int aoff = lds_byte(wr * 64 + fr, fq * 8), boff = lds_byte(wc * 32 + fr, fq * 8);
#define PG8_SA(b, h) (((b) * 2 + (h)) * HTB)
#define PG8_SB(b, h) ((4 + (b) * 2 + (h)) * HTB)
#define PG8_STAGE(bufoff, gbase, voff) do { _Pragma("unroll") for (int _i = 0; _i < 2; ++_i) \
        __builtin_amdgcn_global_load_lds((const unsigned*)((const char*)(gbase) + (voff)[_i]), (LAS unsigned*)(lds + (bufoff) + ldsw + _i * 8192), 16, 0, 0); } while (0)
#define PG8_LDA(dst, b, h) do { _Pragma("unroll") for (int m = 0; m < 4; ++m) _Pragma("unroll") for (int k = 0; k < 2; ++k) dst[m][k] = *(const LAS bf16x8*)(lds + PG8_SA(b, h) + aoff + m * 2048 + k * 1024); } while (0)
#define PG8_LDB(dst, b, h) do { _Pragma("unroll") for (int n = 0; n < 2; ++n) _Pragma("unroll") for (int k = 0; k < 2; ++k) dst[n][k] = *(const LAS bf16x8*)(lds + PG8_SB(b, h) + boff + n * 2048 + k * 1024); } while (0)
#define PG8_F8(x0, x1) __builtin_shufflevector(__builtin_bit_cast(i32x4_t, x0), __builtin_bit_cast(i32x4_t, x1), 0, 1, 2, 3, 4, 5, 6, 7)
#define PG8_MMA(ai, bj, At, Bt) do { __builtin_amdgcn_s_setprio(1); _Pragma("unroll") for (int m = 0; m < 4; ++m) _Pragma("unroll") for (int n = 0; n < 2; ++n) { \
        if (Epi::F8) { const v8i_t b8_ = PG8_F8(Bt[n][0], Bt[n][1]), a8_ = PG8_F8(At[m][0], At[m][1]); asm volatile("v_mfma_f32_16x16x128_f8f6f4 %0, %1, %2, %0" : "+v"(acc[ai][bj][m][n]) : "v"(b8_), "v"(a8_)); } \
        else { _Pragma("unroll") for (int k = 0; k < 2; ++k) acc[ai][bj][m][n] = __builtin_amdgcn_mfma_f32_16x16x32_bf16(Bt[n][k], At[m][k], acc[ai][bj][m][n], 0, 0, 0); } } __builtin_amdgcn_s_setprio(0); } while (0)
#define PG8_WAIT_V(n) asm volatile("s_waitcnt vmcnt(" #n ")" ::: "memory")
#define PG8_WAIT_L(n) asm volatile("s_waitcnt lgkmcnt(" #n ")" ::: "memory")
#define PG8_BAR __builtin_amdgcn_s_barrier()
#define PG8_SCHED __builtin_amdgcn_sched_barrier(0)
    Unit cur, nxt; int ui = 0;
    if (!S.next(0, cur)) return;
    f32x4 acc[2][2][4][2];
#pragma unroll
    for (int a = 0; a < 2; ++a)
#pragma unroll
        for (int b = 0; b < 2; ++b)
#pragma unroll
            for (int m = 0; m < 4; ++m)
#pragma unroll
                for (int n = 0; n < 2; ++n) acc[a][b][m][n] = (f32x4){0.f, 0.f, 0.f, 0.f};
    bf16x8 At[4][2], B0[2][2], B1[2][2];
    const char* const Ab = S.a_base();
    unsigned vc0[2], vc1[2], vn0[2], vn1[2];
#pragma unroll
    for (int i = 0; i < 2; ++i) { vc0[i] = S.a_off(cur, sR[i], sC[i]); vc1[i] = S.a_off(cur, HALF + sR[i], sC[i]); }
    const char* cB = S.b_ptr(cur);
    PG8_STAGE(PG8_SB(0, 0), cB, voffB); PG8_STAGE(PG8_SB(0, 1), cB + hstepB, voffB); PG8_STAGE(PG8_SA(0, 0), Ab, vc0); PG8_STAGE(PG8_SA(0, 1), Ab, vc1);
    if (wr == 1) PG8_BAR;
    PG8_WAIT_V(2); PG8_BAR;
    PG8_STAGE(PG8_SB(1, 0), cB + kstep, voffB); PG8_STAGE(PG8_SA(1, 0), Ab + kstep, vc0); PG8_STAGE(PG8_SB(1, 1), cB + hstepB + kstep, voffB);
    PG8_WAIT_V(6); PG8_BAR;
    for (;;) {
        const bool has_next = S.next(ui + 1, nxt);
        const char* nB = has_next ? S.b_ptr(nxt) : cB;
#pragma unroll
        for (int i = 0; i < 2; ++i) { vn0[i] = has_next ? S.a_off(nxt, sR[i], sC[i]) : vc0[i]; vn1[i] = has_next ? S.a_off(nxt, HALF + sR[i], sC[i]) : vc1[i]; }
#pragma unroll 1
        for (int t = 0; t < nt; t += 2) {
            const bool last = (t == nt - 2);
            const char* a1 = Ab + (size_t)(t + 1) * kstep;
            const char* a2 = last ? Ab : Ab + (size_t)(t + 2) * kstep; const char* b2 = last ? nB : cB + (size_t)(t + 2) * kstep;
            const char* a3 = a2 + kstep; const char* b3 = b2 + kstep;
            unsigned v20[2], v21[2];
#pragma unroll
            for (int i = 0; i < 2; ++i) { v20[i] = last ? vn0[i] : vc0[i]; v21[i] = last ? vn1[i] : vc1[i]; }
            PG8_LDB(B0, 0, 0); PG8_LDB(B1, 0, 1); PG8_SCHED; PG8_LDA(At, 0, 0); PG8_STAGE(PG8_SA(1, 1), a1, vc1);
            PG8_WAIT_V(8); PG8_WAIT_L(0); PG8_BAR; PG8_MMA(0, 0, At, B0); PG8_MMA(0, 1, At, B1); PG8_BAR; PG8_SCHED;
            PG8_LDA(At, 0, 1); PG8_STAGE(PG8_SB(0, 0), b2, voffB); PG8_STAGE(PG8_SB(0, 1), b2 + hstepB, voffB); PG8_STAGE(PG8_SA(0, 0), a2, v20);
            PG8_WAIT_V(8); PG8_WAIT_L(0); PG8_BAR; PG8_MMA(1, 0, At, B0); PG8_MMA(1, 1, At, B1); PG8_BAR; PG8_SCHED;
            PG8_LDB(B0, 1, 0); PG8_LDB(B1, 1, 1); PG8_SCHED; PG8_LDA(At, 1, 0); PG8_STAGE(PG8_SA(0, 1), a2, v21);
            PG8_WAIT_V(8); PG8_WAIT_L(0); PG8_BAR; PG8_MMA(0, 0, At, B0); PG8_MMA(0, 1, At, B1); PG8_BAR; PG8_SCHED;
            PG8_LDA(At, 1, 1); PG8_STAGE(PG8_SB(1, 0), b3, voffB); PG8_STAGE(PG8_SB(1, 1), b3 + hstepB, voffB); PG8_STAGE(PG8_SA(1, 0), a3, v20);
            PG8_WAIT_V(8); PG8_WAIT_L(0); PG8_BAR; PG8_MMA(1, 0, At, B0); PG8_MMA(1, 1, At, B1); PG8_BAR; PG8_SCHED;
        }
        if (wr == 0) PG8_BAR;
        E(acc, cur, wr, wc, fr, fq);
        if (!has_next) break;
#pragma unroll
        for (int a = 0; a < 2; ++a)
#pragma unroll
            for (int b = 0; b < 2; ++b)
#pragma unroll
                for (int m = 0; m < 4; ++m)
#pragma unroll
                    for (int n = 0; n < 2; ++n) acc[a][b][m][n] = (f32x4){0.f, 0.f, 0.f, 0.f};
        cur = nxt; cB = nB; ++ui;
#pragma unroll
        for (int i = 0; i < 2; ++i) { vc0[i] = vn0[i]; vc1[i] = vn1[i]; }
        if (wr == 1) PG8_BAR;
    }
    PG8_WAIT_V(0);
    PG8_BAR;
#undef PG8_SA
#undef PG8_SB
#undef PG8_STAGE
#undef PG8_LDA
#undef PG8_LDB
#undef PG8_MMA
#undef PG8_F8
#undef PG8_WAIT_V
#undef PG8_WAIT_L
#undef PG8_BAR
#undef PG8_SCHED
}
}

#define XB_TMO      128
#define XB_XCNT(j)  (256  + 64 * (j))
#define XB_XSUB(j)  (1280 + 64 * (j))
#define XB_XGEN(j)  (2304 + 64 * (j))
#define XB_TOP      3328
#define XB_TOPGEN   3392
#define XCD_BAR_WORDS 3456
#define XB_SPIN_CAP (1u << 21)
__device__ __forceinline__ unsigned xb_ld(unsigned* p)              { return __hip_atomic_load(p, __ATOMIC_RELAXED, __HIP_MEMORY_SCOPE_AGENT); }
__device__ __forceinline__ unsigned xb_add(unsigned* p, unsigned v) { return __hip_atomic_fetch_add(p, v, __ATOMIC_RELAXED, __HIP_MEMORY_SCOPE_AGENT); }
__device__ __forceinline__ unsigned xb_xcc_id() { return (unsigned)__builtin_amdgcn_s_getreg((3 << 11) | 20) & 0xFu; }
#define XB_SPIN(cond, bar) do { unsigned _sp = 0; while (cond) { __builtin_amdgcn_s_sleep(1); \
    if ((++_sp & 255u) == 0u) { if (xb_ld(&(bar)[XB_TMO])) break; if (_sp > XB_SPIN_CAP) { atomicAdd(&(bar)[XB_TMO], 1u); break; } } } } while (0)
struct XcdBarrier { unsigned* bar; unsigned x; volatile LAS unsigned* st; };
__device__ __forceinline__ XcdBarrier xcd_barrier_post(unsigned* bar, volatile LAS unsigned* st) {
    XcdBarrier b; b.bar = bar; b.x = xb_xcc_id(); b.st = st;
    if (threadIdx.x == 0) (void)xb_add(&bar[XB_XCNT(b.x)], 1u);
    return b;
}
__device__ __forceinline__ void xcd_barrier_complete(unsigned* bar, unsigned x, unsigned& nloc, unsigned& nx) {
    const unsigned G = gridDim.x * gridDim.y * gridDim.z;
    unsigned sum, cnt, mine, sp = 0u;
    for (;;) {
        sum = 0u; cnt = 0u; mine = 0u;
#pragma unroll
        for (unsigned j = 0; j < 16; ++j) { const unsigned c = xb_ld(&bar[XB_XCNT(j)]); sum += c; cnt += (c > 0u) ? 1u : 0u; mine = (j == x) ? c : mine; }
        if (sum == G) break;
        __builtin_amdgcn_s_sleep(1);
        if ((++sp & 255u) == 0u) { if (xb_ld(&bar[XB_TMO])) break; if (sp > XB_SPIN_CAP) { atomicAdd(&bar[XB_TMO], 1u); break; } }
    }
    nloc = mine > 0u ? mine : 1u; nx = cnt > 0u ? cnt : 1u;
}
__device__ __forceinline__ void xcd_barrier(const XcdBarrier& b) {
    asm volatile("s_waitcnt vmcnt(0)" ::: "memory");
    __syncthreads();
    if (threadIdx.x == 0) {
        unsigned* bar = b.bar;
        __builtin_amdgcn_s_waitcnt(0);
        unsigned nloc = b.st[0], nx = b.st[1];
        if (nloc == 0u) { xcd_barrier_complete(bar, b.x, nloc, nx); b.st[0] = nloc; b.st[1] = nx; }
        const unsigned old = xb_add(&bar[XB_XSUB(b.x)], 1u);
        const unsigned gen = old / nloc;
        if (old + 1u == (gen + 1u) * nloc) {
            __builtin_amdgcn_fence(__ATOMIC_RELEASE, "agent");
            asm volatile("s_waitcnt vmcnt(0)" ::: "memory");
            const unsigned og = xb_add(&bar[XB_TOP], 1u);
            const unsigned tg = og / nx;
            if (og + 1u == (tg + 1u) * nx) xb_add(&bar[XB_TOPGEN], 1u);
            else XB_SPIN(xb_ld(&bar[XB_TOPGEN]) == tg, bar);
            __builtin_amdgcn_fence(__ATOMIC_ACQUIRE, "agent");
            xb_add(&bar[XB_XGEN(b.x)], 1u);
            asm volatile("s_waitcnt vmcnt(0)" ::: "memory");
        } else {
            XB_SPIN(xb_ld(&bar[XB_XGEN(b.x)]) == gen, bar);
            __builtin_amdgcn_fence(__ATOMIC_ACQUIRE, "agent");
            asm volatile("s_waitcnt vmcnt(0)" ::: "memory");
        }
    }
    __syncthreads();
}

constexpr size_t MiB = 1u << 20;
constexpr size_t UNIT_B = (size_t)MROWS * 1024 * 2;
constexpr size_t WS_CTL = 0, CTL_ZERO_BYTES = 64 * 1024;
constexpr int CW_TMO = 0, CW_BAR = 4096, CW_CNT = 8192;
constexpr size_t W_MI = 1 * MiB;
constexpr size_t W_UQ = W_MI + (size_t)MLA_INP * 1024 * 2;
constexpr size_t W_UKV = W_UQ + (size_t)1536 * 384 * 2;
constexpr size_t W_OM = W_UKV + (size_t)2048 * 256 * 2;
constexpr size_t W_GI = W_OM + (size_t)1024 * 1024 * 2;
constexpr size_t W_OG = W_GI + (size_t)GLA_INP * 1024 * 2;
constexpr size_t W_GU = W_OG + (size_t)1024 * 1024 * 2;
constexpr size_t W_D = W_GU + (size_t)2 * 32 * 512 * 1024 * 2;
constexpr size_t W_END = W_D + (size_t)2 * 32 * 1024 * 256 * 2;
static_assert(W_END <= 112 * MiB, "weights");
constexpr size_t S_SSQ_Q = 112 * MiB;
constexpr size_t S_SSQ_KV = S_SSQ_Q + (size_t)MROWS * 4;
constexpr size_t S_HMETA = S_SSQ_KV + (size_t)MROWS * 4;
constexpr size_t S_GLR = S_HMETA + (size_t)256 * 1024 * 4;
constexpr size_t S_GAM = S_GLR + (size_t)MROWS * 16 * 4;
constexpr size_t S_LIST = S_GAM + (size_t)NB * GH * NTILE * 128 * 4;
constexpr size_t S_WTS = S_LIST + (size_t)NEXP * MROWS * 4;
constexpr size_t S_PART = S_WTS + (size_t)2 * MROWS * 4;
constexpr size_t S_EPOS = S_PART + (size_t)MROWS * 24 * 4;
constexpr size_t S_END = S_EPOS + (size_t)2 * MROWS * 4;
static_assert(S_END <= 124 * MiB, "small buffers");
constexpr size_t ACT0 = 124 * MiB;
constexpr size_t A_HN = ACT0;
constexpr size_t A_K = ACT0;
constexpr size_t V8_OFF = (size_t)NB * NHEAD * NTILE * 8192;
constexpr size_t A_BST = ACT0 + 4 * UNIT_B;
constexpr size_t A_WOM8 = ACT0 + UNIT_B * 19 / 4;
constexpr size_t A_O8 = ACT0 + UNIT_B * 15 / 4;
constexpr size_t A_K0 = ACT0 + UNIT_B;
constexpr size_t A_ZMLA = ACT0 + UNIT_B * 3 / 2;
constexpr size_t A_QRAW = ACT0 + UNIT_B * 9 / 4;
constexpr size_t A_KNRAW = ACT0 + UNIT_B * 15 / 4;
constexpr size_t A_O = A_KNRAW;
constexpr size_t A_RSL = ACT0;
constexpr size_t A_HID = ACT0 + UNIT_B;
constexpr size_t A_Y = ACT0 + 2 * UNIT_B;
constexpr size_t A_HN2 = ACT0 + 4 * UNIT_B;
constexpr size_t A_HB = ACT0 + 5 * UNIT_B;
constexpr size_t A_ZQK = ACT0;
constexpr size_t A_ZV = ACT0 + UNIT_B;
constexpr size_t A_ZR = ACT0 + 2 * UNIT_B;
constexpr size_t A_QT = ACT0 + 3 * UNIT_B;
constexpr size_t A_ATT = ACT0 + UNIT_B * 7 / 2;
constexpr size_t A_OG = ACT0;
constexpr size_t WS_END = ACT0 + 6 * UNIT_B;
static_assert(WS_END <= 512 * MiB, "workspace map");
static_assert(A_ATT + (size_t)NB * GH * NTILE * 4096 * 2 <= A_HN2, "att");
static_assert(A_HID + (size_t)74240 * 256 * 2 <= A_Y, "hid");
constexpr int HID_TILES_MAX = 290;

constexpr int RING_OFF = 0;
constexpr int LDSCTL_OFF = 139264, MISC_OFF = LDSCTL_OFF;
constexpr int LDS_BYTES = 147456;

struct Args {
    const float* in[24]; float* out; unsigned char* ws; int ph_lo, ph_hi;
};
struct Frame {
    unsigned char* lds; volatile LAS unsigned* MISC; unsigned* ctl; unsigned char* ws;
    int tid, lane, wave, vcu, G;
    float* out;
};
#define FIN(i) (args.in[i])
enum { I_X = 0, I_META, I_NMIX, I_NFFN, I_MWIN, I_MGQ, I_MWUQ, I_MGKV, I_MWUKV, I_MGQN, I_MGKN, I_MWO, I_GWIN, I_GWGU, I_GBG, I_GGOUT, I_GWO, I_RWG, I_RBG, I_RWE, I_RBE, I_EWG, I_EWU, I_EWD };

struct TrItem { const float* src; int ok; int ldw; const float* gk; int k0; bf16* dst; int Kdst; float f8; };
__device__ __forceinline__ TrItem tr_make(const float* W0, int c0, int n0v, const float* W1, int c1, int n1v, int ldw, const float* gk, int k0, bf16* dst, int Kdst, int lane) {
    const int r = lane >> 3, c4 = lane & 7; TrItem t;
    t.src = (c4 < 4 ? W0 + c0 + 4 * c4 : W1 + c1 + 4 * (c4 - 4)) + (size_t)(k0 + r) * ldw; t.ok = c4 < 4 ? (n0v > 0) : (n1v > 0); t.ldw = ldw; t.gk = gk; t.k0 = k0; t.dst = dst; t.Kdst = Kdst; t.f8 = 0.f; return t;
}
__device__ __forceinline__ TrItem tr_make_plain(const float* W, int K, int N, const float* gk, bf16* dst, int item, int lane) {
    const int kb = item % (K / 64), nb = item / (K / 64); const int c0 = 32 * nb, c1 = c0 + 16;
    int n0v = N - c0; n0v = n0v < 0 ? 0 : (n0v > 16 ? 16 : n0v); int n1v = N - c1; n1v = n1v < 0 ? 0 : (n1v > 16 ? 16 : n1v);
    return tr_make(W, c0, n0v, W, c1, n1v, N, gk, 64 * kb, dst + (size_t)32 * nb * K, K, lane);
}
__device__ __forceinline__ void tr_load(const TrItem& t, f32x4 (&v)[8]) {
#pragma unroll
    for (int i = 0; i < 8; ++i) v[i] = t.ok ? *(const f32x4*)(t.src + (size_t)(8 * i) * t.ldw) : (f32x4){0.f, 0.f, 0.f, 0.f};
}
__device__ __forceinline__ void tr_finish(const TrItem& t, const f32x4 (&v)[8], float* scr, int lane) {
    const int r = lane >> 3, c4 = lane & 7;
#pragma unroll
    for (int i = 0; i < 8; ++i) { const int kk = 8 * i + r; f32x4 w = v[i]; if (t.gk) w = w * t.gk[t.k0 + kk];
        float* d = scr + kk * 33 + 4 * c4; d[0] = w.x; d[1] = w.y; d[2] = w.z; d[3] = w.w; }
    LDS_WAIT(); asm volatile("" ::: "memory");
    int c = lane & 7; asm volatile("" : "+v"(c));
#pragma unroll
    for (int j4 = 0; j4 < 4; ++j4) { const int n = (lane >> 3) + 8 * j4; const float* sp = scr + (8 * c) * 33 + n;
        if (t.f8 > 0.f) { const float f = t.f8; *(u32x2*)((unsigned char*)t.dst + (size_t)n * t.Kdst + t.k0 + 8 * c) = (u32x2){pk4_e4m3(sp[0 * 33] * f, sp[1 * 33] * f, sp[2 * 33] * f, sp[3 * 33] * f), pk4_e4m3(sp[4 * 33] * f, sp[5 * 33] * f, sp[6 * 33] * f, sp[7 * 33] * f)}; }
        else { u32x4 o; o.x = pk2(sp[0 * 33], sp[1 * 33]); o.y = pk2(sp[2 * 33], sp[3 * 33]); o.z = pk2(sp[4 * 33], sp[5 * 33]); o.w = pk2(sp[6 * 33], sp[7 * 33]);
            *(u32x4*)(t.dst + (size_t)n * t.Kdst + t.k0 + 8 * c) = o; } }
    LDS_WAIT(); asm volatile("" ::: "memory");
}

template <bool FIRST, bool COMBINE, bool WRITE_HN>
__device__ __forceinline__ void norm_rows(const Args& args, Frame& F, const float* gain, bf16* hn, const bf16* y, bf16* hb) {
    const int gw = F.vcu * NWAVES + F.wave, NGW = F.G * NWAVES, lane = F.lane;
    f32x4 g4[4];
    if (WRITE_HN) {
#pragma unroll
        for (int j = 0; j < 4; ++j) g4[j] = *(const f32x4*)(gain + 4 * lane + 256 * j);
    }
    f32x4 va[4], vb[4]; u32x2 ha[4], hbq[4], ya0[4], ya1[4], yb0[4], yb1[4];
#define NR_LOAD(r_, v_, h_, y0_, y1_) do { if (!row_is_dummy(r_)) { \
            if (FIRST) { const float* src_ = (r_) < NREAL ? FIN(I_X) + (size_t)(r_) * 1024 : FIN(I_META) + (size_t)((((r_) - NREAL) & 63) - 48) * 1024; \
                _Pragma("unroll") for (int j = 0; j < 4; ++j) v_[j] = *(const f32x4*)(src_ + 4 * lane + 256 * j); } \
            else { _Pragma("unroll") for (int j = 0; j < 4; ++j) h_[j] = *(const u32x2*)(hb + (size_t)(r_) * 1024 + 4 * lane + 256 * j); } \
            if (COMBINE) { _Pragma("unroll") for (int j = 0; j < 4; ++j) { y0_[j] = *(const u32x2*)(y + (size_t)(2 * (r_)) * 1024 + 4 * lane + 256 * j); y1_[j] = *(const u32x2*)(y + (size_t)(2 * (r_) + 1) * 1024 + 4 * lane + 256 * j); } } } } while (0)
    if (gw < MROWS) NR_LOAD(gw, va, ha, ya0, ya1);
    for (int r = gw; r < MROWS; r += NGW) {
        const int rn = r + NGW;
        if (rn < MROWS) NR_LOAD(rn, vb, hbq, yb0, yb1);
        if (row_is_dummy(r)) {
            if (WRITE_HN) {
#pragma unroll
                for (int j = 0; j < 4; ++j) { if (FIRST) *(unsigned*)((unsigned char*)hn + (size_t)r * 1024 + 4 * lane + 256 * j) = 0u; else *(u32x2*)(hn + (size_t)r * 1024 + 4 * lane + 256 * j) = (u32x2){0u, 0u}; }
            }
        } else {
            f32x4 v[4];
#pragma unroll
            for (int j = 0; j < 4; ++j) { if (FIRST) v[j] = va[j]; else { const u32x2 q = ha[j]; v[j] = (f32x4){bf2f(q.x & 0xffff), bf2f(q.x >> 16), bf2f(q.y & 0xffff), bf2f(q.y >> 16)}; } }
            if (COMBINE) {
#pragma unroll
                for (int j = 0; j < 4; ++j) { const u32x2 a = ya0[j], b = ya1[j];
                    v[j].x += bf2f(a.x & 0xffff) + bf2f(b.x & 0xffff); v[j].y += bf2f(a.x >> 16) + bf2f(b.x >> 16);
                    v[j].z += bf2f(a.y & 0xffff) + bf2f(b.y & 0xffff); v[j].w += bf2f(a.y >> 16) + bf2f(b.y >> 16); }
#pragma unroll
                for (int j = 0; j < 4; ++j) { u32x2 o; o.x = pk2(v[j].x, v[j].y); o.y = pk2(v[j].z, v[j].w); *(u32x2*)(hb + (size_t)r * 1024 + 4 * lane + 256 * j) = o;
                    v[j] = (f32x4){bf2f(o.x & 0xffff), bf2f(o.x >> 16), bf2f(o.y & 0xffff), bf2f(o.y >> 16)}; }
            }
            if (WRITE_HN) {
                float s = 0.f;
#pragma unroll
                for (int j = 0; j < 4; ++j) s += (v[j].x * v[j].x + v[j].y * v[j].y) + (v[j].z * v[j].z + v[j].w * v[j].w);
                const float rstd = rsqrtf(wave_sum(s) * (1.f / 1024.f) + EPS);
#pragma unroll
                for (int j = 0; j < 4; ++j) {
                    if (FIRST) *(unsigned*)((unsigned char*)hn + (size_t)r * 1024 + 4 * lane + 256 * j) = pk4_e4m3(v[j].x * rstd * g4[j].x, v[j].y * rstd * g4[j].y, v[j].z * rstd * g4[j].z, v[j].w * rstd * g4[j].w);
                    else { u32x2 o; o.x = pk2(v[j].x * rstd * g4[j].x, v[j].y * rstd * g4[j].y); o.y = pk2(v[j].z * rstd * g4[j].z, v[j].w * rstd * g4[j].w);
                        *(u32x2*)(hn + (size_t)r * 1024 + 4 * lane + 256 * j) = o; } }
            }
        }
#pragma unroll
        for (int j = 0; j < 4; ++j) { va[j] = vb[j]; ha[j] = hbq[j]; ya0[j] = yb0[j]; ya1[j] = yb1[j]; }
    }
#undef NR_LOAD
}

constexpr int GU_ITEMS = 32 * 256, WD_ITEMS = 32 * 128, WGI_ITEMS = 16 * 104;
__device__ __forceinline__ TrItem gu_item(const Args& args, unsigned char* ws, int layer, int it, int lane) {
    const int le = layer * 32 + (it >> 8), q = it & 255, kb = q % 16, nb = q / 16; const int pn = nb >> 3, bj = (nb >> 2) & 1, wc = nb & 3, hc0 = 128 * pn + 64 * bj + 16 * wc;
    return tr_make(FIN(I_EWG) + (size_t)le * 1024 * 256, hc0, 16, FIN(I_EWU) + (size_t)le * 1024 * 256, hc0, 16, 256, FIN(I_NFFN) + layer * 1024, 64 * kb, (bf16*)(ws + W_GU) + ((size_t)le * 512 + 32 * nb) * 1024, 1024, lane);
}
__device__ __forceinline__ TrItem wd_item(const Args& args, unsigned char* ws, int layer, int it, int lane) {
    const int le = layer * 32 + it / 128, q = it % 128;
    return tr_make_plain(FIN(I_EWD) + (size_t)le * 256 * 1024, 256, 1024, nullptr, (bf16*)(ws + W_D) + (size_t)le * 1024 * 256, q, lane);
}
__device__ __forceinline__ TrItem wgi_item(const Args& args, unsigned char* ws, int r, int lane) {
    const int kb = r % 16, nb = r / 16; const float* W = FIN(I_GWIN); int c0, n0v, c1, n1v;
    if (nb < 64) { c0 = 32 * nb; n0v = 16; c1 = c0 + 16; n1v = 16; }
    else if (nb < 96) { c0 = 2064 + 32 * (nb - 64); n0v = 16; c1 = c0 + 16; n1v = 16; }
    else if (nb == 96) { c0 = 2048; n0v = 16; c1 = 0; n1v = 0; }
    else { c0 = 0; n0v = 0; c1 = 0; n1v = 0; }
    return tr_make(W, c0, n0v, W, c1, n1v, GLA_IN, FIN(I_NMIX) + 1024, 64 * kb, (bf16*)(ws + W_GI) + (size_t)32 * nb * 1024, 1024, lane);
}
constexpr int D1_ITEMS = GU_ITEMS + WGI_ITEMS, D7_ITEMS = WD_ITEMS + GU_ITEMS, D16_ITEMS = WD_ITEMS;
template <int SET> __device__ __forceinline__ TrItem def_item(const Args& args, unsigned char* ws, int it, int lane) {
    if (SET == 1) return it < GU_ITEMS ? gu_item(args, ws, 0, it, lane) : wgi_item(args, ws, it - GU_ITEMS, lane);
    if (SET == 7) return it < WD_ITEMS ? wd_item(args, ws, 0, it, lane) : gu_item(args, ws, 1, it - WD_ITEMS, lane);
    return wd_item(args, ws, 1, it, lane);
}
template <int SET> __device__ __forceinline__ void def_convert(const Args& args, Frame& F, int first, int stride, int limit, int maxn) {
    float* scr = (float*)(F.lds + RING_OFF + F.wave * 16384); const int lane = F.lane;
    if (first >= limit || maxn <= 0) return;
    TrItem cur = def_item<SET>(args, F.ws, first, lane); f32x4 va[8]; tr_load(cur, va);
    int n = 1;
    for (int it = first; ; ) {
        const int nx = it + stride; const bool more = nx < limit && n < maxn; TrItem nxt = cur; f32x4 vb[8];
        if (more) { nxt = def_item<SET>(args, F.ws, nx, lane); tr_load(nxt, vb); }
        tr_finish(cur, va, scr, lane);
        if (!more) break;
#pragma unroll
        for (int i = 0; i < 8; ++i) va[i] = vb[i];
        cur = nxt; it = nx; ++n;
    }
}
template <int SET> __device__ __forceinline__ void def_fill_idle(const Args& args, Frame& F, int tot, int nitems, int per_wave, bool rest) {
    const int maxu = (tot + F.G - 1) / F.G, thr = tot - (maxu - 1) * F.G, nfill = F.G - thr;
    int cov = nfill > 0 ? nfill * NWAVES * per_wave : 0; cov = cov < nitems ? cov : nitems;
    if (F.vcu >= thr && nfill > 0) def_convert<SET>(args, F, (F.vcu - thr) * NWAVES + F.wave, nfill * NWAVES, cov, per_wave);
    if (rest) def_convert<SET>(args, F, cov + F.vcu * NWAVES + F.wave, F.G * NWAVES, nitems, 1 << 30);
}
constexpr int P1_FILL_PER_WAVE = 10;
constexpr int P7_FILL_PER_WAVE = 4;
constexpr int P7_FILL2_PER_WAVE = 6;

__device__ __forceinline__ void p0_prologue(const Args& args, Frame& F) {
    float* scr = (float*)(F.lds + RING_OFF + F.wave * 16384);
    const int gw = F.vcu * NWAVES + F.wave, NGW = F.G * NWAVES, lane = F.lane;
    unsigned char* ws = F.ws;
    constexpr int I0 = 16 * 24, I1 = 6 * 48, I2 = 4 * 64, I3 = 16 * 32, I5 = 16 * 32, I6 = 16 * 32;
    const int nfill1 = (F.G == 256) ? (2 * 256 - 387) * NWAVES * P1_FILL_PER_WAVE : 0;
    const int D1_COV = nfill1 < D1_ITEMS ? nfill1 : D1_ITEMS;
    const int NITEMS = I0 + I1 + I2 + I3 + I5 + I6 + (D1_ITEMS - D1_COV);
    auto make = [&](int it) -> TrItem {
        int r = it;
        if (r < I0) { const int kb = r % 16, nb = r / 16; const int c0 = 32 * nb, c1 = c0 + 16; TrItem t8 = tr_make(FIN(I_MWIN), c0, 16, FIN(I_MWIN), c1, 16, MLA_IN, nullptr, 64 * kb, (bf16*)(ws + W_MI + (size_t)32 * nb * 1024), 1024, lane); t8.f8 = W_SC; return t8; } r -= I0;
        if (r < I1) return tr_make_plain(FIN(I_MWUQ), MLA_Q, 1536, FIN(I_MGQ), (bf16*)(ws + W_UQ), r, lane); r -= I1;
        if (r < I2) {
            const int kb = r % 4, nb = r / 4; int c0;
            if (nb < 32) { const int pn = nb >> 3, bj = (nb >> 2) & 1, wc = nb & 3; c0 = (4 * pn + wc) * 128 + 32 * bj; } else { const int j = nb - 32; c0 = (j >> 1) * 128 + 64 + 32 * (j & 1); }
            return tr_make(FIN(I_MWUKV), c0, 16, FIN(I_MWUKV), c0 + 16, 16, 2048, FIN(I_MGKV), 64 * kb, (bf16*)(ws + W_UKV) + (size_t)32 * nb * MLA_KV, MLA_KV, lane); } r -= I2;
        if (r < I3) return tr_make_plain(FIN(I_MWO), 1024, 1024, nullptr, (bf16*)(ws + W_OM), r, lane); r -= I3;
        if (r < I5) return tr_make_plain(FIN(I_GWO), 1024, 1024, nullptr, (bf16*)(ws + W_OG), r, lane); r -= I5;
        if (r < I6) { const int kb = r % 16, nb = r / 16; TrItem t8 = tr_make(FIN(I_MWO), 32 * nb, 16, FIN(I_MWO), 32 * nb + 16, 16, 1024, nullptr, 64 * kb, (bf16*)(ws + A_WOM8 + (size_t)32 * nb * 1024), 1024, lane); t8.f8 = W_SC; return t8; } r -= I6;
        return def_item<1>(args, ws, D1_COV + r, lane);
    };
    if (gw < NITEMS) {
        TrItem cur = make(gw); f32x4 va[8]; tr_load(cur, va);
        for (int it = gw; it < NITEMS; it += NGW) {
            const int nx = it + NGW; TrItem nxt = cur; f32x4 vb[8];
            if (nx < NITEMS) { nxt = make(nx); tr_load(nxt, vb); }
            tr_finish(cur, va, scr, lane);
            if (nx < NITEMS) {
#pragma unroll
                for (int i = 0; i < 8; ++i) va[i] = vb[i];
                cur = nxt; }
        }
    }
    { unsigned* vz = (unsigned*)F.out; for (int i = blockIdx.x * NTHREADS + F.tid; i < 64 * 2 * 48 * 16; i += F.G * NTHREADS) { const int w16 = i & 15, r = (i >> 4) % 48, dh = ((i >> 4) / 48) & 1, bh = (i >> 4) / 96;
        vz[((((size_t)bh * NTILE + 0) * 2 + dh) * 64 + r) * 16 + w16] = 0u; } }
    { unsigned* hz = (unsigned*)(ws + A_HB + (size_t)NREAL * 1024 * 2); for (int i = blockIdx.x * NTHREADS + F.tid; i < 256 * 512; i += F.G * NTHREADS) { if (((i >> 9) & 63) < 48) hz[i] = 0u; } }
    norm_rows<true, false, true>(args, F, FIN(I_NMIX), (bf16*)(ws + A_HN), nullptr, (bf16*)(ws + A_HB));
}

struct EpiZmla {
    static constexpr bool PERM = true; static constexpr bool ADJ = false; static constexpr bool F8 = true;
    bf16* Z; float* part;
    __device__ __forceinline__ void operator()(const f32x4 (&acc)[2][2][4][2], const pg8::Unit& u, int wr, int wc, int fr, int fq) const {
#pragma unroll
        for (int ai = 0; ai < 2; ++ai)
#pragma unroll
            for (int m = 0; m < 4; ++m) { __builtin_amdgcn_sched_barrier(0);
                const int row = u.pm * 256 + ai * 128 + wr * 64 + m * 16 + fr;
#pragma unroll
                for (int bj = 0; bj < 2; ++bj) {
                    const f32x4 v0 = acc[ai][bj][m][0] * (1.f / W_SC), v1 = acc[ai][bj][m][1] * (1.f / W_SC);
                    const int col = u.pn * 256 + bj * 128 + wc * 32 + 8 * fq;
                    u32x4 w; w.x = pk2(v0[0], v0[1]); w.y = pk2(v0[2], v0[3]); w.z = pk2(v1[0], v1[1]); w.w = pk2(v1[2], v1[3]);
                    *(u32x4*)(Z + (size_t)row * MLA_INP + col) = w;
                    const int cb = u.pn * 256 + bj * 128;
                    if (cb < 768) {
                        float s = (v0[0] * v0[0] + v0[1] * v0[1]) + (v0[2] * v0[2] + v0[3] * v0[3]) + (v1[0] * v1[0] + v1[1] * v1[1]) + (v1[2] * v1[2] + v1[3] * v1[3]);
                        s += __shfl_xor(s, 16); s += __shfl_xor(s, 32);
                        if (fq == 0) part[(size_t)row * 24 + (cb >> 7) * 4 + wc] = s;
                    }
                }
            }
    }
};
struct EpiQ {
    static constexpr bool PERM = true; static constexpr bool ADJ = false; static constexpr bool F8 = false;
    bf16* Q; const float* ssq;
    __device__ __forceinline__ void operator()(const f32x4 (&acc)[2][2][4][2], const pg8::Unit& u, int wr, int wc, int fr, int fq) const {
        float rsv[8];
#pragma unroll
        for (int i = 0; i < 8; ++i) { const int row = u.pm * 256 + (i >> 2) * 128 + wr * 64 + (i & 3) * 16 + fr;
            const f32x4 pa = *(const f32x4*)(ssq + (size_t)row * 24), pb = *(const f32x4*)(ssq + (size_t)row * 24 + 4), pc = *(const f32x4*)(ssq + (size_t)row * 24 + 8);
            rsv[i] = rsqrtf((((pa[0] + pa[1]) + (pa[2] + pa[3])) + ((pb[0] + pb[1]) + (pb[2] + pb[3])) + ((pc[0] + pc[1]) + (pc[2] + pc[3]))) * (1.f / MLA_Q) + EPS); }
#pragma unroll
        for (int ai = 0; ai < 2; ++ai)
#pragma unroll
            for (int m = 0; m < 4; ++m) { __builtin_amdgcn_sched_barrier(0);
                const int row = u.pm * 256 + ai * 128 + wr * 64 + m * 16 + fr;
                const float rs = rsv[ai * 4 + m];
#pragma unroll
                for (int bj = 0; bj < 2; ++bj) {
                    const f32x4 v0 = acc[ai][bj][m][0] * rs, v1 = acc[ai][bj][m][1] * rs;
                    const int col = u.pn * 256 + bj * 128 + wc * 32 + 8 * fq;
                    u32x4 w; w.x = pk2(v0[0], v0[1]); w.y = pk2(v0[2], v0[3]); w.z = pk2(v1[0], v1[1]); w.w = pk2(v1[2], v1[3]);
                    *(u32x4*)(Q + (size_t)row * 1536 + col) = w;
                }
            }
    }
};
struct EpiKV {
    static constexpr bool PERM = true; static constexpr bool ADJ = false; static constexpr bool F8 = false;
    bf16* KT; bf16* V; const float* ssq; float* RH; const float* gkn;
    __device__ __forceinline__ void operator()(const f32x4 (&acc)[2][2][4][2], const pg8::Unit& u, int wr, int wc, int fr, int fq) const {
        if (u.pn < 4) {
            const int head = 4 * u.pn + wc;
#pragma unroll
            for (int ai = 0; ai < 2; ++ai)
#pragma unroll
                for (int m = 0; m < 4; ++m) { __builtin_amdgcn_sched_barrier(0);
                    const int row = u.pm * 256 + ai * 128 + wr * 64 + m * 16 + fr;
                    const int b = row >> 13, sfr = row & (SEQ - 1), tile = 1 + (sfr >> 6), r64 = sfr & 63;
                    const f32x4 pa_ = *(const f32x4*)(ssq + (size_t)row * 24 + 12), pb_ = *(const f32x4*)(ssq + (size_t)row * 24 + 16); const float rs = rsqrtf((((pa_[0] + pa_[1]) + (pa_[2] + pa_[3])) + ((pb_[0] + pb_[1]) + (pb_[2] + pb_[3]))) * (1.f / MLA_KV) + EPS);
                    float sq = 0.f;
#pragma unroll
                    for (int bj = 0; bj < 2; ++bj)
#pragma unroll
                        for (int n = 0; n < 2; ++n) { const f32x4 a = acc[ai][bj][m][n]; sq += (a[0] * a[0] + a[1] * a[1]) + (a[2] * a[2] + a[3] * a[3]); }
                    sq += __shfl_xor(sq, 16); sq += __shfl_xor(sq, 32);
                    const float rh = rsqrtf((sq * rs * rs + ssq[(size_t)row * 24 + 20]) * (1.f / QK) + EPS), rr = rs * rh;
                    unsigned char* kt = (unsigned char*)KT + ((size_t)(b * NHEAD + head) * NTILE + tile) * 8192 + r64 * 16 + (fq & 1) * 8;
                    const float rk = rr * KQ_SC;
#pragma unroll
                    for (int bj = 0; bj < 2; ++bj) { const f32x4 g0 = *(const f32x4*)(gkn + 32 * bj + 8 * fq), g1 = *(const f32x4*)(gkn + 32 * bj + 8 * fq + 4);
                        const f32x4 x0 = acc[ai][bj][m][0] * g0 * rk, x1 = acc[ai][bj][m][1] * g1 * rk;
                        *(u32x2*)(kt + (2 * bj + (fq >> 1)) * 1024) = (u32x2){pk4_e4m3(x0[0], x0[1], x0[2], x0[3]), pk4_e4m3(x1[0], x1[1], x1[2], x1[3])}; }
                    if (fq == 0) RH[(size_t)row * NHEAD + head] = rh;
                }
        } else {
#pragma unroll
            for (int ai = 0; ai < 2; ++ai)
#pragma unroll
                for (int m = 0; m < 4; ++m) { __builtin_amdgcn_sched_barrier(0);
                    const int row = u.pm * 256 + ai * 128 + wr * 64 + m * 16 + fr;
                    const f32x4 pa_ = *(const f32x4*)(ssq + (size_t)row * 24 + 12), pb_ = *(const f32x4*)(ssq + (size_t)row * 24 + 16); const float rs = rsqrtf((((pa_[0] + pa_[1]) + (pa_[2] + pa_[3])) + ((pb_[0] + pb_[1]) + (pb_[2] + pb_[3]))) * (1.f / MLA_KV) + EPS);
                    const int b = row >> 13, sfr = row & (SEQ - 1), tile = 1 + (sfr >> 6), r64 = sfr & 63;
#pragma unroll
                    for (int bj = 0; bj < 2; ++bj) {
                        const f32x4 v0 = acc[ai][bj][m][0] * rs, v1 = acc[ai][bj][m][1] * rs;
                        const int colv = (u.pn - 4) * 256 + bj * 128 + wc * 32 + 8 * fq, hv = colv >> 6, d = colv & 63;
                        *(u32x2*)((unsigned char*)V + ((size_t)(b * NHEAD + hv) * NTILE + tile) * 8192 + r64 * 64 + d) = (u32x2){pk4_e4m3(v0[0], v0[1], v0[2], v0[3]), pk4_e4m3(v1[0], v1[1], v1[2], v1[3])};
                    }
                }
        }
    }
};
struct EpiRes {
    static constexpr bool PERM = true; static constexpr bool ADJ = false; static constexpr bool F8 = false;
    const float* x; bf16* hb;
    __device__ __forceinline__ void operator()(const f32x4 (&acc)[2][2][4][2], const pg8::Unit& u, int wr, int wc, int fr, int fq) const {
#pragma unroll
        for (int ai = 0; ai < 2; ++ai)
#pragma unroll
            for (int m = 0; m < 4; ++m) {
                const int row = u.pm * 256 + ai * 128 + wr * 64 + m * 16 + fr;
#pragma unroll
                for (int bj = 0; bj < 2; ++bj) {
                    const int col = u.pn * 256 + bj * 128 + wc * 32 + 8 * fq;
                    f32x4 s0, s1;
                    if (x) { s0 = *(const f32x4*)(x + (size_t)row * 1024 + col); s1 = *(const f32x4*)(x + (size_t)row * 1024 + col + 4); }
                    else { const u32x4 q = *(const u32x4*)(hb + (size_t)row * 1024 + col);
                        s0 = (f32x4){bf2f(q.x & 0xffff), bf2f(q.x >> 16), bf2f(q.y & 0xffff), bf2f(q.y >> 16)}; s1 = (f32x4){bf2f(q.z & 0xffff), bf2f(q.z >> 16), bf2f(q.w & 0xffff), bf2f(q.w >> 16)}; }
                    const f32x4 v0 = s0 + acc[ai][bj][m][0], v1 = s1 + acc[ai][bj][m][1];
                    u32x4 w; w.x = pk2(v0[0], v0[1]); w.y = pk2(v0[2], v0[3]); w.z = pk2(v1[0], v1[1]); w.w = pk2(v1[2], v1[3]);
                    *(u32x4*)(hb + (size_t)row * 1024 + col) = w;
                }
            }
    }
};
struct EpiRes8 {
    static constexpr bool PERM = true; static constexpr bool ADJ = false; static constexpr bool F8 = true;
    const float* x; bf16* hb;
    __device__ __forceinline__ void operator()(const f32x4 (&acc)[2][2][4][2], const pg8::Unit& u, int wr, int wc, int fr, int fq) const {
#pragma unroll
        for (int ai = 0; ai < 2; ++ai)
#pragma unroll
            for (int m = 0; m < 4; ++m) {
                const int row = u.pm * 256 + ai * 128 + wr * 64 + m * 16 + fr;
#pragma unroll
                for (int bj = 0; bj < 2; ++bj) {
                    const int col = u.pn * 256 + bj * 128 + wc * 32 + 8 * fq;
                    const f32x4 s0 = *(const f32x4*)(x + (size_t)row * 1024 + col), s1 = *(const f32x4*)(x + (size_t)row * 1024 + col + 4);
                    const f32x4 v0 = s0 + acc[ai][bj][m][0] * WO_INV, v1 = s1 + acc[ai][bj][m][1] * WO_INV;
                    u32x4 w; w.x = pk2(v0[0], v0[1]); w.y = pk2(v0[2], v0[3]); w.z = pk2(v1[0], v1[1]); w.w = pk2(v1[2], v1[3]);
                    *(u32x4*)(hb + (size_t)row * 1024 + col) = w;
                }
            }
    }
};
struct EpiZgla {
    static constexpr bool PERM = true; static constexpr bool ADJ = false; static constexpr bool F8 = false;
    bf16* ZQK; bf16* ZV; bf16* ZR; float* GLR; const float* RS2;
    __device__ __forceinline__ void operator()(const f32x4 (&acc)[2][2][4][2], const pg8::Unit& u, int wr, int wc, int fr, int fq) const {
        bf16* dst = (bf16*)((char*)ZQK + (size_t)(u.pn >> 2) * UNIT_B); const int cbase = (u.pn & 3) * 256;
        float rsv[8];
#pragma unroll
        for (int i = 0; i < 8; ++i) rsv[i] = RS2[u.pm * 256 + (i >> 2) * 128 + wr * 64 + (i & 3) * 16 + fr];
#pragma unroll
        for (int ai = 0; ai < 2; ++ai)
#pragma unroll
            for (int m = 0; m < 4; ++m) { __builtin_amdgcn_sched_barrier(0);
                const int row = u.pm * 256 + ai * 128 + wr * 64 + m * 16 + fr;
#pragma unroll
                for (int bj = 0; bj < 2; ++bj) {
                    const float rs = rsv[ai * 4 + m]; const f32x4 v0 = acc[ai][bj][m][0] * rs, v1 = acc[ai][bj][m][1] * rs;
                    const int c = bj * 128 + wc * 32 + 8 * fq;
                    if (u.pn < 12) { u32x4 w; w.x = pk2(v0[0], v0[1]); w.y = pk2(v0[2], v0[3]); w.z = pk2(v1[0], v1[1]); w.w = pk2(v1[2], v1[3]); *(u32x4*)(dst + (size_t)row * 1024 + cbase + c) = w; }
                    else if (c < 16) { *(f32x4*)(GLR + (size_t)row * 16 + c) = v0; *(f32x4*)(GLR + (size_t)row * 16 + c + 4) = v1; }
                }
            }
    }
};

struct MoeTables { volatile LAS unsigned* tpre; volatile LAS unsigned* cnt; volatile LAS unsigned* cpre; volatile LAS unsigned* t2e; };
__device__ __forceinline__ MoeTables moe_tables(Frame& F, const unsigned* gcnt) {
    MoeTables T; T.tpre = F.MISC + 16; T.cnt = F.MISC + 64; T.cpre = F.MISC + 112; T.t2e = F.MISC + 160;
    __syncthreads();
    if (F.wave == 0) {
        const int e = F.lane & 31;
        const unsigned cn = __hip_atomic_load(gcnt + e, __ATOMIC_RELAXED, __HIP_MEMORY_SCOPE_AGENT), tl = (cn + 255u) >> 8;
        unsigned st = tl, sc = cn;
#pragma unroll
        for (int dlt = 1; dlt < 32; dlt <<= 1) { const unsigned a = __shfl_up(st, dlt, 32), b = __shfl_up(sc, dlt, 32); if (e >= dlt) { st += a; sc += b; } }
        if (F.lane < 32) { T.cnt[e] = cn; T.tpre[e] = st - tl; T.cpre[e] = sc - cn; if (e == 31) { T.tpre[32] = st; T.cpre[32] = sc; }
            for (unsigned t = 0; t < tl; ++t) T.t2e[st - tl + t] = (unsigned)e | (t << 8); }
    }
    __syncthreads();
    return T;
}
struct MoeSched {
    MoeTables T; int nN, G, c; bool gather;
    const char* A; int lda; const char* Bt; int K; size_t bexp; const int* list;
    __device__ bool next(int i, pg8::Unit& u) const {
        const int total = (int)T.tpre[32] * nN; const int L = i * G + c; if (L >= total) return false;
        const int mt = L >> (nN == 4 ? 2 : 1); u.pn = L & (nN - 1); const unsigned v = T.t2e[mt];
        u.e = (int)(v & 255u); u.pm = (int)(v >> 8); u.r0 = mt; return true;
    }
    __device__ __forceinline__ const char* a_base() const { return A; }
    __device__ __forceinline__ unsigned a_off(const pg8::Unit& u, int r, int c_) const {
        if (gather) { const int pos = u.pm * 256 + r; int tok = NREAL; if (pos < (int)T.cnt[u.e]) tok = list[(size_t)u.e * MROWS + pos] >> 1; return (unsigned)((tok * lda + c_) * 2); }
        return (unsigned)(((u.r0 * 256 + r) * lda + c_) * 2);
    }
    __device__ __forceinline__ const char* b_ptr(const pg8::Unit& u) const { return Bt + (size_t)u.e * bexp + (size_t)u.pn * 256 * K * 2; }
};
struct EpiGU {
    static constexpr bool PERM = false; static constexpr bool ADJ = false; static constexpr bool F8 = false;
    bf16* HID; const float* RSL; volatile LAS unsigned* cnt;
    __device__ __forceinline__ void operator()(const f32x4 (&acc)[2][2][4][2], const pg8::Unit& u, int wr, int wc, int fr, int fq) const {
        const int n_e = (int)cnt[u.e]; const float* rsp = RSL + (size_t)u.e * MROWS + u.pm * 256 + wr * 64 + fr; float rsv[8];
#pragma unroll
        for (int i = 0; i < 8; ++i) { const int off = (i >> 2) * 128 + (i & 3) * 16; rsv[i] = (u.pm * 256 + wr * 64 + fr + off < n_e) ? rsp[off] : 0.f; }
#pragma unroll
        for (int ai = 0; ai < 2; ++ai)
#pragma unroll
            for (int m = 0; m < 4; ++m) { __builtin_amdgcn_sched_barrier(0);
                const int rr = ai * 128 + wr * 64 + m * 16 + fr; const float rs = rsv[ai * 4 + m];
#pragma unroll
                for (int bj = 0; bj < 2; ++bj) {
                    const f32x4 g = acc[ai][bj][m][0] * rs, up = acc[ai][bj][m][1] * rs; float o[4];
#pragma unroll
                    for (int j = 0; j < 4; ++j) o[j] = g[j] * __builtin_amdgcn_rcpf(1.f + __expf(-g[j])) * up[j];
                    u32x2 w; w.x = pk2(o[0], o[1]); w.y = pk2(o[2], o[3]);
                    *(u32x2*)(HID + ((size_t)u.r0 * 256 + rr) * 256 + u.pn * 128 + bj * 64 + wc * 16 + 4 * fq) = w;
                }
            }
    }
};
constexpr float Y_SCALE = 32.f, Y_INV = 1.f / 32.f;
__device__ __forceinline__ unsigned pk4_fp8(const f32x4 v) {
    const float a = __builtin_amdgcn_fmed3f(v[0] * Y_SCALE, -448.f, 448.f), b = __builtin_amdgcn_fmed3f(v[1] * Y_SCALE, -448.f, 448.f), c = __builtin_amdgcn_fmed3f(v[2] * Y_SCALE, -448.f, 448.f), d = __builtin_amdgcn_fmed3f(v[3] * Y_SCALE, -448.f, 448.f);
    int w = 0; w = __builtin_amdgcn_cvt_pk_fp8_f32(a, b, w, false); w = __builtin_amdgcn_cvt_pk_fp8_f32(c, d, w, true); return (unsigned)w;
}
struct EpiDown {
    static constexpr bool PERM = true; static constexpr bool ADJ = true; static constexpr bool F8 = false;
    unsigned char* Y; volatile LAS unsigned* cnt; volatile LAS unsigned* cpre;
    __device__ __forceinline__ void operator()(const f32x4 (&acc)[2][2][4][2], const pg8::Unit& u, int wr, int wc, int fr, int fq) const {
        const int n_e = (int)cnt[u.e]; const size_t base = (size_t)cpre[u.e];
        const bool lo8 = fr < 8;
        unsigned char* const yb = Y + base * 1024 + u.pn * 256 + wc * 64 + (fr >> 3) * 32 + 8 * fq;
#pragma unroll
        for (int ai = 0; ai < 2; ++ai)
#pragma unroll
            for (int m = 0; m < 4; ++m) { __builtin_amdgcn_sched_barrier(0);
                const int pos = u.pm * 256 + ai * 128 + wr * 64 + m * 16 + (fr & 7);
                u32x2 o0, o1, snd, rcv;
                o0.x = pk4_fp8(acc[ai][0][m][0]); o0.y = pk4_fp8(acc[ai][0][m][1]); o1.x = pk4_fp8(acc[ai][1][m][0]); o1.y = pk4_fp8(acc[ai][1][m][1]);
                snd = lo8 ? o1 : o0;
#pragma unroll
                for (int k = 0; k < 2; ++k) rcv[k] = (unsigned)__builtin_amdgcn_update_dpp(0, (int)snd[k], 0x128, 0xf, 0xf, false);
                const u32x2 sa = lo8 ? o0 : rcv, sb = lo8 ? rcv : o1;
                if (pos < n_e) __builtin_nontemporal_store(sa, (u32x2*)(yb + (size_t)pos * 1024));
                if (pos + 8 < n_e) __builtin_nontemporal_store(sb, (u32x2*)(yb + (size_t)(pos + 8) * 1024));
            }
    }
};

__device__ __forceinline__ void unpack8(const u32x4 w, float (&x)[8]) {
    x[0] = bf2f(w.x & 0xffff); x[1] = bf2f(w.x >> 16); x[2] = bf2f(w.y & 0xffff); x[3] = bf2f(w.y >> 16);
    x[4] = bf2f(w.z & 0xffff); x[5] = bf2f(w.z >> 16); x[6] = bf2f(w.w & 0xffff); x[7] = bf2f(w.w >> 16);
}
__device__ __forceinline__ u32x4 pack8(const float (&x)[8]) { u32x4 w; w.x = pk2(x[0], x[1]); w.y = pk2(x[2], x[3]); w.z = pk2(x[4], x[5]); w.w = pk2(x[6], x[7]); return w; }
__device__ __forceinline__ void kprep_phase(const Args& args, Frame& F) {
    const bf16* KN = (const bf16*)(F.ws + A_KNRAW); const bf16* Z = (const bf16*)(F.ws + A_ZMLA); unsigned char* Kt = (unsigned char*)(F.ws + A_K); bf16* K0 = (bf16*)(F.ws + A_K0);
    const float* RH = (const float*)(F.ws + A_KNRAW);
    const float* gkn = FIN(I_MGKN);
    const int gw = F.vcu * NWAVES + F.wave, NGW = F.G * NWAVES, lane = F.lane;
    const u32x4 zero4 = {0u, 0u, 0u, 0u};
    for (int task = gw; task < (NREAL / 64) * NHEAD; task += NGW) {
        const int rt = task / NHEAD, h = task % NHEAD; const int row = rt * 64 + lane;
        const int b = row >> 13, sfr = row & (SEQ - 1), tile = 1 + (sfr >> 6), r64 = sfr & 63;
        u32x4 raw[4];
#pragma unroll
        for (int c = 0; c < 4; ++c) raw[c] = *(const u32x4*)(Z + (size_t)row * MLA_INP + 640 + 8 * c);
        const float rh = RH[(size_t)row * NHEAD + h] * KQ_SC;
        unsigned char* dst = Kt + ((size_t)(b * NHEAD + h) * NTILE + tile) * 8192 + r64 * 16;
        const float pos = (float)(16 + sfr);
        u32x4 c4, c5;
#pragma unroll
        for (int c = 0; c < 2; ++c) {
            float x1[8], x2[8]; unpack8(raw[c], x1); unpack8(raw[2 + c], x2);
#pragma unroll
            for (int e = 0; e < 8; ++e) { const int i = 8 * c + e; float sn, cs; fast_sincos(pos * ROPE_INV[i], sn, cs);
                const float a = x1[e] * rh * gkn[64 + i], bq = x2[e] * rh * gkn[80 + i]; x1[e] = a * cs - bq * sn; x2[e] = bq * cs + a * sn; }
            c4[2 * c] = pk4_e4m3(x1[0], x1[1], x1[2], x1[3]); c4[2 * c + 1] = pk4_e4m3(x1[4], x1[5], x1[6], x1[7]);
            c5[2 * c] = pk4_e4m3(x2[0], x2[1], x2[2], x2[3]); c5[2 * c + 1] = pk4_e4m3(x2[4], x2[5], x2[6], x2[7]); }
        *(u32x4*)(dst + 4 * 1024) = c4; *(u32x4*)(dst + 5 * 1024) = c5; *(u32x4*)(dst + 6 * 1024) = zero4; *(u32x4*)(dst + 7 * 1024) = zero4;
    }
    const int NTASK = 4 * NHEAD;
    for (int task = gw; task < NTASK; task += NGW) {
        const int rt = NREAL / 64 + task / NHEAD, h = task % NHEAD; const int row = rt * 64 + lane;
        int b, tile, r64; row_btr(row, b, tile, r64);
        u32x4 raw[12];
#pragma unroll
        for (int c = 0; c < 8; ++c) raw[c] = *(const u32x4*)(KN + (size_t)row * 1024 + h * 64 + 8 * c);
#pragma unroll
        for (int c = 0; c < 4; ++c) raw[8 + c] = *(const u32x4*)(Z + (size_t)row * MLA_INP + 640 + 8 * c);
        float ss = 0.f;
#pragma unroll
        for (int c = 0; c < 12; ++c) { float x[8]; unpack8(raw[c], x);
#pragma unroll
            for (int e = 0; e < 8; ++e) ss += x[e] * x[e]; }
        const float rstd = rsqrtf(ss * (1.f / QK) + EPS);
        bf16* dst = K0 + (size_t)(b * NHEAD + h) * (12 * 64 * 8) + r64 * 8;
        unsigned char* dst8 = Kt + ((size_t)(b * NHEAD + h) * NTILE + tile) * 8192 + r64 * 16;
#pragma unroll
        for (int c = 0; c < 8; ++c) { float x[8]; unpack8(raw[c], x);
#pragma unroll
            for (int e = 0; e < 8; ++e) x[e] *= rstd * gkn[8 * c + e];
            *(u32x4*)(dst + c * 512) = pack8(x);
            *(u32x2*)(dst8 + (c >> 1) * 1024 + (c & 1) * 8) = (u32x2){pk4_e4m3(x[0] * KQ_SC, x[1] * KQ_SC, x[2] * KQ_SC, x[3] * KQ_SC), pk4_e4m3(x[4] * KQ_SC, x[5] * KQ_SC, x[6] * KQ_SC, x[7] * KQ_SC)}; }
        const float pos = (float)row_pos(row);
#pragma unroll
        for (int c = 0; c < 2; ++c) {
            float x1[8], x2[8]; unpack8(raw[8 + c], x1); unpack8(raw[10 + c], x2);
#pragma unroll
            for (int e = 0; e < 8; ++e) { const int i = 8 * c + e; float sn, cs; fast_sincos(pos * ROPE_INV[i], sn, cs);
                const float a = x1[e] * rstd * gkn[64 + i], bq = x2[e] * rstd * gkn[80 + i]; x1[e] = a * cs - bq * sn; x2[e] = bq * cs + a * sn; }
            *(u32x4*)(dst + (8 + c) * 512) = pack8(x1); *(u32x4*)(dst + (10 + c) * 512) = pack8(x2);
            *(u32x2*)(dst8 + 4 * 1024 + c * 8) = (u32x2){pk4_e4m3(x1[0] * KQ_SC, x1[1] * KQ_SC, x1[2] * KQ_SC, x1[3] * KQ_SC), pk4_e4m3(x1[4] * KQ_SC, x1[5] * KQ_SC, x1[6] * KQ_SC, x1[7] * KQ_SC)};
            *(u32x2*)(dst8 + 5 * 1024 + c * 8) = (u32x2){pk4_e4m3(x2[0] * KQ_SC, x2[1] * KQ_SC, x2[2] * KQ_SC, x2[3] * KQ_SC), pk4_e4m3(x2[4] * KQ_SC, x2[5] * KQ_SC, x2[6] * KQ_SC, x2[7] * KQ_SC)}; }
        *(u32x4*)(dst8 + 6 * 1024) = zero4; *(u32x4*)(dst8 + 7 * 1024) = zero4;
    }
    { const bf16* Vb = (const bf16*)F.out; unsigned char* V8 = (unsigned char*)F.out + V8_OFF;
      LAS unsigned* scr = (LAS unsigned*)((LAS unsigned char*)F.lds + RING_OFF + F.wave * 8192);
      const LAS unsigned char* scr8 = (const LAS unsigned char*)scr;
      const unsigned char* VR = (const unsigned char*)F.out;
      u32x4 raw[8];
#define KP_VLOAD(task_) do { if ((task_) % NTILE == 0) { const bf16* src_ = Vb + (size_t)(task_) * 4096 + lane * 32; \
              _Pragma("unroll") for (int q_ = 0; q_ < 8; ++q_) raw[q_] = *(const u32x4*)(src_ + (q_ >> 2) * 2048 + 8 * (q_ & 3)); } \
          else { const unsigned char* src_ = VR + (size_t)(task_) * 8192 + lane * 64; _Pragma("unroll") for (int q_ = 0; q_ < 4; ++q_) raw[q_] = *(const u32x4*)(src_ + 16 * q_); } } while (0)
      if (gw < NB * NHEAD * NTILE) KP_VLOAD(gw);
      for (int task = gw; task < NB * NHEAD * NTILE; task += NGW) {
          if (task % NTILE == 0) {
#pragma unroll
              for (int q_ = 0; q_ < 8; ++q_) { float x[8]; unpack8(raw[q_], x);
                  scr[lane * 17 + 2 * q_] = pk4_e4m3(x[0], x[1], x[2], x[3]); scr[lane * 17 + 2 * q_ + 1] = pk4_e4m3(x[4], x[5], x[6], x[7]); }
          } else {
#pragma unroll
              for (int q_ = 0; q_ < 4; ++q_) { scr[lane * 17 + 4 * q_] = raw[q_].x; scr[lane * 17 + 4 * q_ + 1] = raw[q_].y; scr[lane * 17 + 4 * q_ + 2] = raw[q_].z; scr[lane * 17 + 4 * q_ + 3] = raw[q_].w; }
          }
          if (task + NGW < NB * NHEAD * NTILE) KP_VLOAD(task + NGW);
          asm volatile("s_waitcnt lgkmcnt(0)" ::: "memory");
#pragma unroll
          for (int i = 0; i < 4; ++i) { const int cell = lane + 64 * i, dvf = 32 * (cell >> 7) + (cell & 31), hf = (cell >> 6) & 1, c = (cell >> 5) & 1;
              unsigned w[4];
#pragma unroll
              for (int j = 0; j < 4; ++j) { unsigned acc = 0u;
#pragma unroll
                  for (int e = 0; e < 4; ++e) { const int r = 4 * j + e; const int key = 32 * c + (r & 3) + 8 * (r >> 2) + 4 * hf; acc |= (unsigned)scr8[key * 68 + dvf] << (8 * e); }
                  w[j] = acc; }
              *(u32x4*)(V8 + (size_t)task * 4096 + cell * 16) = (u32x4){w[0], w[1], w[2], w[3]}; }
          asm volatile("s_waitcnt lgkmcnt(0)" ::: "memory");
      }
#undef KP_VLOAD
    }
}

__device__ __forceinline__ int crow(int r, int hi) { return (r & 3) + 8 * (r >> 2) + 4 * hi; }
__device__ __forceinline__ s16x4 vtr(const LAS char* p) { typedef short v4i16_t __attribute__((ext_vector_type(4))); return __builtin_bit_cast(s16x4, __builtin_amdgcn_ds_read_tr16_b64_v4i16((LAS v4i16_t*)p)); }
constexpr int ATT_STAGE = 20480;
__device__ __forceinline__ void glds16(const void* gsrc, unsigned lds_dst) { unsigned keep;
    asm volatile("s_mov_b32 %0, m0\n\ts_mov_b32 m0, %2\n\ts_nop 0\n\tglobal_load_lds_dwordx4 %1, off\n\ts_mov_b32 m0, %0" : "=&s"(keep) : "v"(gsrc), "s"(lds_dst) : "memory"); }

__device__ __forceinline__ void attn_unit(const Args& args, Frame& F, int bh, int qb) {
    const int lane = F.lane, r32 = lane & 31, hi = lane >> 5, wid = F.wave;
    const int b = bh >> 4, h = bh & 15;
    const bf16* QR = (const bf16*)(F.ws + A_QRAW); const bf16* Kt = (const bf16*)(F.ws + A_K0) + (size_t)bh * 6144; const bf16* Vt = (const bf16*)F.out + (size_t)bh * NTILE * 4096;
    bf16* O = (bf16*)(F.ws + A_O);
    unsigned char* shm = F.lds + RING_OFF;
    int NT, myT, qrow;
    if (qb >= 0) { NT = 4 * qb + 5; myT = 4 * qb + 1 + (wid >> 1); qrow = b * SEQ + 256 * qb + 32 * wid + r32; }
    else { NT = 1; myT = (wid == 0) ? 0 : -1; qrow = NREAL + b * 64 + 32 + r32; }
#define ATT_LOAD(t, buf) do { const bf16* ks_ = Kt + (size_t)(t) * 6144 + lane * 8; const bf16* vs_ = Vt + (size_t)(t) * 4096 + lane * 8; LAS unsigned char* d_ = (LAS unsigned char*)(shm + (buf) * ATT_STAGE); \
        __builtin_amdgcn_global_load_lds((const unsigned*)(ks_ + wid * 512), (LAS unsigned*)(d_ + wid * 1024), 16, 0, 0); \
        if (wid < 4) __builtin_amdgcn_global_load_lds((const unsigned*)(ks_ + (wid + 8) * 512), (LAS unsigned*)(d_ + (wid + 8) * 1024), 16, 0, 0); \
        __builtin_amdgcn_global_load_lds((const unsigned*)(vs_ + wid * 512), (LAS unsigned*)(d_ + 12288 + wid * 1024), 16, 0, 0); } while (0)
    ATT_LOAD(0, 0);
    bf16x8 qr[6];
    if (myT >= 0) {
        float qf[6][8];
#pragma unroll
        for (int d0 = 0; d0 < 6; ++d0) { const u32x4 w = *(const u32x4*)(QR + (size_t)qrow * 1536 + h * QK + 16 * d0 + 8 * hi);
            qf[d0][0] = bf2f(w.x & 0xffff); qf[d0][1] = bf2f(w.x >> 16); qf[d0][2] = bf2f(w.y & 0xffff); qf[d0][3] = bf2f(w.y >> 16);
            qf[d0][4] = bf2f(w.z & 0xffff); qf[d0][5] = bf2f(w.z >> 16); qf[d0][6] = bf2f(w.w & 0xffff); qf[d0][7] = bf2f(w.w >> 16); }
        float ss = 0.f;
#pragma unroll
        for (int d0 = 0; d0 < 6; ++d0)
#pragma unroll
            for (int j = 0; j < 8; ++j) ss += qf[d0][j] * qf[d0][j];
        ss += __shfl_xor(ss, 32);
        const float rstd = rsqrtf(ss * (1.f / QK) + EPS);
        const float* gqn = FIN(I_MGQN);
#pragma unroll
        for (int d0 = 0; d0 < 6; ++d0)
#pragma unroll
            for (int j = 0; j < 8; ++j) qf[d0][j] *= rstd * gqn[16 * d0 + 8 * hi + j];
        const float pos = (float)row_pos(qrow);
#pragma unroll
        for (int j = 0; j < 8; ++j) { float sn, cs; fast_sincos(pos * ROPE_INV[8 * hi + j], sn, cs); const float x1 = qf[4][j], x2 = qf[5][j]; qf[4][j] = x1 * cs - x2 * sn; qf[5][j] = x2 * cs + x1 * sn; }
        const float sc = 0.10206207261596575f * 1.4426950408889634f;
#pragma unroll
        for (int d0 = 0; d0 < 6; ++d0) { u32x4 w; w.x = pk2(qf[d0][0] * sc, qf[d0][1] * sc); w.y = pk2(qf[d0][2] * sc, qf[d0][3] * sc); w.z = pk2(qf[d0][4] * sc, qf[d0][5] * sc); w.w = pk2(qf[d0][6] * sc, qf[d0][7] * sc); qr[d0] = __builtin_bit_cast(bf16x8, w); }
    } else {
#pragma unroll
        for (int d0 = 0; d0 < 6; ++d0) qr[d0] = (bf16x8){0, 0, 0, 0, 0, 0, 0, 0};
    }
    f32x16 o0 = {}, o1 = {};
    float mhat = 0.f, lsum = 0.f;
    f32x16 negm = {};
    VM_WAIT(); __syncthreads();
    for (int t = 0; t < NT; ++t) {
        if (t + 1 < NT) ATT_LOAD(t + 1, (t + 1) & 1);
        if (t <= myT) {
            const LAS char* Kb = (const LAS char*)(shm + (t & 1) * ATT_STAGE) + hi * 1024 + r32 * 16;
            const LAS char* Vb = (const LAS char*)(shm + (t & 1) * ATT_STAGE) + 12288 + ((lane >> 4) & 1) * 32 + (lane & 3) * 8 + (4 * hi + ((lane & 15) >> 2)) * 64;
            f32x16 p0 = negm, p1 = negm;
#pragma unroll
            for (int d0 = 0; d0 < 6; ++d0) {
                const bf16x8 a0 = *(const LAS bf16x8*)(Kb + d0 * 2048), a1 = *(const LAS bf16x8*)(Kb + d0 * 2048 + 512);
                p0 = __builtin_amdgcn_mfma_f32_32x32x16_bf16(a0, qr[d0], p0, 0, 0, 0);
                p1 = __builtin_amdgcn_mfma_f32_32x32x16_bf16(a1, qr[d0], p1, 0, 0, 0);
            }
            if (t == 0) {
#pragma unroll
                for (int r = 0; r < 16; ++r) { p0[r] = -INFINITY; if (r < 8) p1[r] = -INFINITY; }
            }
            float ra = max3f(p0[0], p0[1], p1[0]), rb = max3f(p0[2], p0[3], p1[1]); ra = max3f(ra, p1[2], p1[3]);
#pragma unroll
            for (int r = 4; r < 16; r += 4) { ra = max3f(ra, p0[r], p0[r + 1]); rb = max3f(rb, p0[r + 2], p0[r + 3]); ra = max3f(ra, p1[r], p1[r + 1]); rb = max3f(rb, p1[r + 2], p1[r + 3]); }
            float rm = max2f(ra, rb);
            { auto rr = __builtin_amdgcn_permlane32_swap(__float_as_uint(rm), __float_as_uint(rm), false, false); rm = max2f(__uint_as_float(rr[0]), __uint_as_float(rr[1])); }
            if (__builtin_expect(__any(rm > 8.f), 0)) {
                const float dl = fmaxf(rm, 0.f); mhat += dl;
#pragma unroll
                for (int r = 0; r < 16; ++r) { p0[r] -= dl; p1[r] -= dl; }
#pragma unroll
                for (int r = 0; r < 16; ++r) negm[r] = -mhat;
                const float f = __builtin_amdgcn_exp2f(-dl); lsum *= f;
#pragma unroll
                for (int r = 0; r < 16; ++r) { o0[r] *= f; o1[r] *= f; }
            }
            float ps = 0.f;
#pragma unroll
            for (int r = 0; r < 16; ++r) { p0[r] = __builtin_amdgcn_exp2f(p0[r]); p1[r] = __builtin_amdgcn_exp2f(p1[r]); ps += p0[r] + p1[r]; }
            lsum += ps;
            u32x4 pw[4];
            pw[0] = (u32x4){pk2(p0[0], p0[1]), pk2(p0[2], p0[3]), pk2(p0[4], p0[5]), pk2(p0[6], p0[7])};
            pw[1] = (u32x4){pk2(p0[8], p0[9]), pk2(p0[10], p0[11]), pk2(p0[12], p0[13]), pk2(p0[14], p0[15])};
            pw[2] = (u32x4){pk2(p1[0], p1[1]), pk2(p1[2], p1[3]), pk2(p1[4], p1[5]), pk2(p1[6], p1[7])};
            pw[3] = (u32x4){pk2(p1[8], p1[9]), pk2(p1[10], p1[11]), pk2(p1[12], p1[13]), pk2(p1[14], p1[15])};
#pragma unroll
            for (int ks = 0; ks < 4; ++ks) {
                const s16x4 l0 = vtr(Vb + ks * 1024), h0 = vtr(Vb + ks * 1024 + 512), l1 = vtr(Vb + 4096 + ks * 1024), h1 = vtr(Vb + 4096 + ks * 1024 + 512);
                const bf16x8 v0 = (bf16x8){l0[0], l0[1], l0[2], l0[3], h0[0], h0[1], h0[2], h0[3]}, v1 = (bf16x8){l1[0], l1[1], l1[2], l1[3], h1[0], h1[1], h1[2], h1[3]};
                const bf16x8 pb = __builtin_bit_cast(bf16x8, pw[ks]);
                o0 = __builtin_amdgcn_mfma_f32_32x32x16_bf16(v0, pb, o0, 0, 0, 0);
                o1 = __builtin_amdgcn_mfma_f32_32x32x16_bf16(v1, pb, o1, 0, 0, 0);
            }
        }
        VM_WAIT(); __syncthreads();
    }
#undef ATT_LOAD
    if (myT >= 0) {
        lsum += __shfl_xor(lsum, 32);
        const float inv = 1.f / lsum;
        bf16* orow = O + (size_t)qrow * 1024 + h * 64;
#pragma unroll
        for (int g = 0; g < 4; ++g) {
            u32x2 w0, w1; w0.x = pk2(o0[4 * g] * inv, o0[4 * g + 1] * inv); w0.y = pk2(o0[4 * g + 2] * inv, o0[4 * g + 3] * inv);
            w1.x = pk2(o1[4 * g] * inv, o1[4 * g + 1] * inv); w1.y = pk2(o1[4 * g + 2] * inv, o1[4 * g + 3] * inv);
            *(u32x2*)(orow + 8 * g + 4 * hi) = w0; *(u32x2*)(orow + 32 + 8 * g + 4 * hi) = w1;
        }
    }
}

namespace fa {
constexpr int SLOTK = 8192, SLOTV = 4096, NSLOTK = 4, NSLOT = 3;
constexpr int LDS_K = 0, LDS_V = NSLOTK * SLOTK, LDS_WS = LDS_V + NSLOT * SLOTV, LDS_OST = LDS_WS + NWAVES * 64 * 4, LDS_BYTES_ = LDS_OST + NWAVES * 4096;
typedef int v8i_t __attribute__((ext_vector_type(8)));
typedef const LAS char* lds_cptr;
#define FA_SBAR() __builtin_amdgcn_sched_barrier(0)
#define FA_WAIT_BAR(N) asm volatile("s_waitcnt vmcnt(" #N ") lgkmcnt(0)\n\ts_barrier" ::: "memory")
__device__ __forceinline__ v8i_t kload8(lds_cptr kp, int kb, int j) {
    const u32x4 a = *(const LAS u32x4*)(kp + j * 4096 + kb * 512), b = *(const LAS u32x4*)(kp + j * 4096 + kb * 512 + 1024);
    return (v8i_t){(int)a.x, (int)a.y, (int)a.z, (int)a.w, (int)b.x, (int)b.y, (int)b.z, (int)b.w};
}
__device__ __forceinline__ void attn_unit_fast(const Args& args, Frame& F, int bh, int qb) {
    const int lane = F.lane, r32 = lane & 31, hi = lane >> 5, wid = F.wave;
    const int b = bh >> 4, h = bh & 15;
    const bf16* QR = (const bf16*)(F.ws + A_QRAW); const unsigned char* Kt = (const unsigned char*)(F.ws + A_K) + (size_t)bh * NTILE * 8192; const unsigned char* Vt = (const unsigned char*)F.out + V8_OFF + (size_t)bh * NTILE * 4096;
    bf16* O = (bf16*)(F.ws + A_O);
    char* shm = (char*)(F.lds + RING_OFF);
    const unsigned lds0 = (unsigned)(uintptr_t)shm;
    const int NT = 4 * qb + 5;
    const int qrow = b * SEQ + 256 * qb + 32 * wid + r32;
    const int myband = wid >> 1;
    float* wsf = (float*)(shm + LDS_WS) + wid * 64;
    const unsigned char* ksrc = Kt + lane * 16 + wid * 1024; const unsigned char* vsrc = Vt + (lane & 31) * 16 + wid * 512;
    const unsigned kdst = lds0 + LDS_K + wid * 1024, vdst = lds0 + LDS_V + wid * 512;
#define FA_DMA_K(t, slot) glds16(ksrc + (size_t)(t) * 8192, (unsigned)__builtin_amdgcn_readfirstlane(kdst + (slot) * SLOTK))
#define FA_DMA_V(t, slot) do { const unsigned vd_ = (unsigned)__builtin_amdgcn_readfirstlane(vdst + (slot) * SLOTV); if (lane < 32) glds16(vsrc + (size_t)(t) * 4096, vd_); } while (0)
    const lds_cptr shm3 = (lds_cptr)shm; const lds_cptr kp0 = shm3 + LDS_K + hi * 2048 + r32 * 16; const lds_cptr vp0 = shm3 + LDS_V + hi * 1024 + r32 * 16;
    v8i_t kf[4];
    FA_DMA_K(0, 0); FA_DMA_V(0, 0); FA_DMA_K(1, 1);
    v8i_t qr[2];
    {
        float qa[32], qb_[32];
        const bf16* qsrc = QR + (size_t)qrow * 1536 + h * QK;
#pragma unroll
        for (int c = 0; c < 4; ++c) { const u32x4 w = *(const u32x4*)(qsrc + 32 * hi + 8 * c), w2 = *(const u32x4*)(qsrc + 64 + 8 * c);
            qa[8 * c + 0] = bf2f(w.x & 0xffff); qa[8 * c + 1] = bf2f(w.x >> 16); qa[8 * c + 2] = bf2f(w.y & 0xffff); qa[8 * c + 3] = bf2f(w.y >> 16);
            qa[8 * c + 4] = bf2f(w.z & 0xffff); qa[8 * c + 5] = bf2f(w.z >> 16); qa[8 * c + 6] = bf2f(w.w & 0xffff); qa[8 * c + 7] = bf2f(w.w >> 16);
            qb_[8 * c + 0] = bf2f(w2.x & 0xffff); qb_[8 * c + 1] = bf2f(w2.x >> 16); qb_[8 * c + 2] = bf2f(w2.y & 0xffff); qb_[8 * c + 3] = bf2f(w2.y >> 16);
            qb_[8 * c + 4] = bf2f(w2.z & 0xffff); qb_[8 * c + 5] = bf2f(w2.z >> 16); qb_[8 * c + 6] = bf2f(w2.w & 0xffff); qb_[8 * c + 7] = bf2f(w2.w >> 16); }
        float ss = 0.f, sr = 0.f;
#pragma unroll
        for (int j = 0; j < 32; ++j) { ss += qa[j] * qa[j]; sr += qb_[j] * qb_[j]; }
        ss += __shfl_xor(ss, 32);
        const float rstd = rsqrtf((ss + sr) * (1.f / QK) + EPS) * KQ_SC;
        const float* gqn = FIN(I_MGQN);
#pragma unroll
        for (int j = 0; j < 32; ++j) { qa[j] *= rstd * gqn[32 * hi + j]; qb_[j] *= rstd * gqn[64 + j]; }
        const float pos = (float)row_pos(qrow);
#pragma unroll
        for (int j = 0; j < 16; ++j) { float sn, cs; fast_sincos(pos * ROPE_INV[j], sn, cs); const float x1 = qb_[j], x2 = qb_[16 + j]; qb_[j] = x1 * cs - x2 * sn; qb_[16 + j] = x2 * cs + x1 * sn; }
#pragma unroll
        for (int c = 0; c < 8; ++c) { qr[0][c] = (int)pk4_e4m3(qa[4 * c], qa[4 * c + 1], qa[4 * c + 2], qa[4 * c + 3]);
            const unsigned rb = pk4_e4m3(qb_[4 * c], qb_[4 * c + 1], qb_[4 * c + 2], qb_[4 * c + 3]); qr[1][c] = hi ? 0 : (int)rb; }
    }
    f32x16 o[2], o2; o[0] = f32x16{}; o[1] = f32x16{}; o2 = f32x16{};
    v8i_t ones8; { int one_ = 0x38383838; asm volatile("" : "+v"(one_)); ones8 = (v8i_t){one_, one_, one_, one_, one_, one_, one_, one_}; }
#define FA_CMASK(P0, P1, t) do { if (FA_CMASK_ON && (t) - (NT - 4) > myband) { _Pragma("unroll") for (int r = 0; r < 16; ++r) { P0[r] = -INFINITY; P1[r] = -INFINITY; } } } while (0)
    f32x16 pA0, pA1, pB0, pB1;
    int sk_cur = 0, sk_next = 1, sk_prev = 2;
#define FA_ROT() do { const int tmp_ = sk_prev; sk_prev = sk_cur; sk_cur = sk_next; sk_next = tmp_; } while (0)
    FA_DMA_K(2, 2); FA_DMA_K(3, 3);
    FA_WAIT_BAR(4);
#define FA_MF8(a, b, c) __builtin_amdgcn_mfma_scale_f32_32x32x64_f8f6f4(a, b, c, 0, 0, 0, 0, 0, 0)
    { const f32x16 z = {};
      pA0 = FA_MF8(kload8(kp0, 0, 0), qr[0], z); pA1 = FA_MF8(kload8(kp0, 1, 0), qr[0], z); pA0 = FA_MF8(kload8(kp0, 0, 1), qr[1], pA0); pA1 = FA_MF8(kload8(kp0, 1, 1), qr[1], pA1); }
#pragma unroll
    for (int r = 0; r < 16; ++r) { pA0[r] = -INFINITY; if (r < 8) pA1[r] = -INFINITY; }
#pragma unroll
    for (int r = 0; r < 16; ++r) { pA0[r] = __builtin_amdgcn_exp2f(pA0[r]); pA1[r] = __builtin_amdgcn_exp2f(pA1[r]); }
    FA_WAIT_BAR(0);
    FA_DMA_V(1, 1);
    FA_ROT();
    kf[0] = kload8(kp0 + 1 * SLOTK, 0, 0); kf[1] = kload8(kp0 + 1 * SLOTK, 1, 0);
    FA_WAIT_BAR(1);
    v8i_t vf[2], pq;
#define FA_PKW(P, B) pk2(P[B], P[B + 1])
#define FA_PAF(k) __builtin_bit_cast(bf16x8, pw##k)
#define FA_VFR(i) (bf16x8){vlo[i][0], vlo[i][1], vlo[i][2], vlo[i][3], vhi[i][0], vhi[i][1], vhi[i][2], vhi[i][3]}
#define FA_PIN(x) asm volatile("" : "+v"(x))
#define FA_GAPA(MF, A0, A1, A2, A3, W0, W1, PW) do { MF; sacc += A0; sacc += A1; sacc += A2; sacc += A3; FA_PIN(sacc); W0; W1; FA_PIN(PW); FA_SBAR(); } while (0)
#define FA_GAPA0(MF) do { MF; FA_SBAR(); } while (0)
#define FA_GAPA8(MF, A0, A1, A2, A3, A4, A5, A6, A7, W0, W1) do { MF; W0; W1; FA_SBAR(); } while (0)
#define FA_GAPB8(MF, X, B) do { MF; _Pragma("unroll") for (int e_ = 0; e_ < 8; ++e_) X[(B) + e_] = FA_EX(X[(B) + e_]); FA_PIN(X); FA_SBAR(); } while (0)
#define FA_GAPA2(MF, A0, A1, W0, W1, PW) do { MF; sacc += A0; sacc += A1; FA_PIN(sacc); W0; W1; FA_PIN(PW); FA_SBAR(); } while (0)
#define FA_GAPA4(MF, A0, A1, A2, A3) do { MF; sacc += A0; sacc += A1; sacc += A2; sacc += A3; FA_PIN(sacc); FA_SBAR(); } while (0)
#define FA_EX(v) __builtin_amdgcn_exp2f(v)
#define FA_GAPB(MF, X, B) do { MF; X[B] = FA_EX(X[B]); X[B + 1] = FA_EX(X[B + 1]); X[B + 2] = FA_EX(X[B + 2]); X[B + 3] = FA_EX(X[B + 3]); FA_PIN(X); FA_SBAR(); } while (0)
#define FA_VRD(dvb_) do { const u32x4 a_ = *(const LAS u32x4*)(vp_ + (dvb_) * 2048), b_ = *(const LAS u32x4*)(vp_ + (dvb_) * 2048 + 512); vf[dvb_] = (v8i_t){(int)a_.x, (int)a_.y, (int)a_.z, (int)a_.w, (int)b_.x, (int)b_.y, (int)b_.z, (int)b_.w}; } while (0)
#define FA_PQ(P, B) (int)pk4_bf8(P[B], P[(B) + 1], P[(B) + 2], P[(B) + 3])
#define FA_MFPV(d_) o[d_] = __builtin_amdgcn_mfma_scale_f32_32x32x64_f8f6f4(pq, vf[d_], o[d_], 1, 0, 0, 0, 0, 0)
#define FA_KRD(G, kb_, t) do { if (G) { kf[kb_] = kload8(kp0 + (((t) + 1) & 3) * SLOTK, kb_, 0); FA_SBAR(); } } while (0)
#define FA_MF(a, b, c) __builtin_amdgcn_mfma_f32_32x32x16_bf16(a, b, c, 0, 0, 0)
#define FA_KJ(kb_, t) do { kf[2 + (kb_)] = kload8(kp0 + ((t) & 3) * SLOTK, kb_, 1); FA_SBAR(); } while (0)
#define FA_STEP(C0, C1, P0, P1, t, GK, GV, GL) do { FA_SBAR(); \
    const lds_cptr vp_ = vp0 + sk_prev * SLOTV; const f32x16 z_ = {}; \
    FA_KJ(0, t); FA_KJ(1, t); \
    FA_GAPA8(C0 = FA_MF8(kf[0], qr[0], z_), P0[2], P0[3], P0[4], P0[5], P0[6], P0[7], P0[8], P0[9],         pq[0] = FA_PQ(P0, 0), pq[1] = FA_PQ(P0, 4)); \
    FA_GAPA8(C1 = FA_MF8(kf[1], qr[0], z_), P0[10], P0[11], P0[12], P0[13], P0[14], P0[15], P1[0], P1[1],   pq[2] = FA_PQ(P0, 8), pq[3] = FA_PQ(P0, 12)); \
    FA_VRD(0); FA_SBAR(); \
    FA_GAPA8(C0 = FA_MF8(kf[2], qr[1], C0), P1[2], P1[3], P1[4], P1[5], P1[6], P1[7], P1[8], P1[9],         pq[4] = FA_PQ(P1, 0), pq[5] = FA_PQ(P1, 4)); \
    FA_VRD(1); FA_SBAR(); \
    FA_GAPA8(C1 = FA_MF8(kf[3], qr[1], C1), P1[10], P1[11], P1[12], P1[13], P1[14], P1[15], 0.f, 0.f,       pq[6] = FA_PQ(P1, 8), pq[7] = FA_PQ(P1, 12)); FA_PIN(pq); \
    if (GK) { FA_DMA_K((t) + 3, ((t) + 3) & 3); } if (GV) { FA_DMA_V((t) + 1, sk_next); } \
    FA_CMASK(C0, C1, t); \
    FA_SBAR(); \
    FA_GAPB8(FA_MFPV(0), C0, 0); \
    FA_KRD(GL, 0, t); FA_GAPB8(FA_MFPV(1), C0, 8); \
    FA_KRD(GL, 1, t); FA_GAPB8(o2 = __builtin_amdgcn_mfma_scale_f32_32x32x64_f8f6f4(pq, ones8, o2, 1, 0, 0, 0, 0, 0), C1, 0); \
    FA_GAPB8((void)0, C1, 8); \
    } while (0)
#define FA_ENDW(tt) do { if ((tt) + 3 < NT) { FA_WAIT_BAR(2); } else if ((tt) + 1 < NT) { FA_WAIT_BAR(1); } else { FA_WAIT_BAR(0); } } while (0)
    int t = 1;
#define FA_CMASK_ON 0
    for (; t + 5 < NT; t += 2) {
        FA_STEP(pB0, pB1, pA0, pA1, t, true, true, true);     FA_WAIT_BAR(2); FA_ROT();
        FA_STEP(pA0, pA1, pB0, pB1, t + 1, true, true, true); FA_WAIT_BAR(2); FA_ROT();
    }
#undef FA_CMASK_ON
#define FA_CMASK_ON 1
    for (; t + 1 < NT; t += 2) {
        FA_STEP(pB0, pB1, pA0, pA1, t, (t + 3 < NT), (t + 1 < NT), (t + 1 < NT));     FA_ENDW(t);     FA_ROT();
        FA_STEP(pA0, pA1, pB0, pB1, t + 1, (t + 4 < NT), (t + 2 < NT), (t + 2 < NT)); FA_ENDW(t + 1); FA_ROT();
    }
#undef FA_CMASK_ON
    {
      pq = (v8i_t){FA_PQ(pA0, 0), FA_PQ(pA0, 4), FA_PQ(pA0, 8), FA_PQ(pA0, 12), FA_PQ(pA1, 0), FA_PQ(pA1, 4), FA_PQ(pA1, 8), FA_PQ(pA1, 12)};
      const lds_cptr vp_ = vp0 + sk_prev * SLOTV;
      FA_VRD(0); FA_VRD(1);
      FA_MFPV(0); FA_MFPV(1); o2 = __builtin_amdgcn_mfma_scale_f32_32x32x64_f8f6f4(pq, ones8, o2, 1, 0, 0, 0, 0, 0); }
    float rli[16];
#pragma unroll
    for (int r = 0; r < 16; ++r) rli[r] = __builtin_amdgcn_rcpf(o2[r]);
    unsigned char* Ow = (unsigned char*)(F.ws + A_O8) + (size_t)(b * SEQ + 256 * qb + wid * 32) * 1024 + h * 64;
    { unsigned char* stg = (unsigned char*)(shm + LDS_OST) + wid * 2048;
#pragma unroll
      for (int r = 0; r < 16; r += 2) { const int ra = crow(r, hi), rb = crow(r + 1, hi);
#pragma unroll
          for (int d0 = 0; d0 < 2; ++d0) { const unsigned w = pk4_e4m3(o[d0][r] * rli[r] * O_SC, o[d0][r + 1] * rli[r + 1] * O_SC, 0.f, 0.f);
              stg[ra * 64 + d0 * 32 + r32] = (unsigned char)(w & 0xffu); stg[rb * 64 + d0 * 32 + r32] = (unsigned char)((w >> 8) & 0xffu); } }
      asm volatile("s_waitcnt lgkmcnt(0)" ::: "memory");
      { const int row = lane >> 1, hb_ = (lane & 1) * 32; const u32x4 v0 = *(const u32x4*)(stg + row * 64 + hb_), v1 = *(const u32x4*)(stg + row * 64 + hb_ + 16);
        *(u32x4*)(Ow + (size_t)row * 1024 + hb_) = v0; *(u32x4*)(Ow + (size_t)row * 1024 + hb_ + 16) = v1; } }
    asm volatile("s_waitcnt vmcnt(0) lgkmcnt(0)\n\ts_barrier" ::: "memory");
#undef FA_DMA_K
#undef FA_DMA_V
#undef FA_CMASK
#undef FA_ROT
#undef FA_PKW
#undef FA_PAF
#undef FA_VFR
#undef FA_PIN
#undef FA_GAPA
#undef FA_GAPA0
#undef FA_GAPA8
#undef FA_MF8
#undef FA_GAPA2
#undef FA_GAPA4
#undef FA_EX
#undef FA_GAPB
#undef FA_VRD
#undef FA_PQ
#undef FA_MFPV
#undef FA_GAPB8
#undef FA_KRD
#undef FA_KJ
#undef FA_MF
#undef FA_STEP
#undef FA_ENDW
}
#undef FA_SBAR
#undef FA_WAIT_BAR
}

__device__ __forceinline__ void attn_phase(const Args& args, Frame& F) {
    const int v = F.vcu, xg = v >> 5, j32 = v & 31;
    for (int i = 0; ; ++i) {
        int bh, qb;
        if (F.G == 256) { if (i > 8 || (i == 8 && j32 >= 8)) break;
            if (i == 8) { bh = 8 * xg + j32; qb = -1; } else { bh = 8 * xg + i; qb = (i & 1) ? 31 - j32 : j32; } }
        else { const int u = blockIdx.x + i * F.G; if (u >= 64 * 33) break; bh = u / 33; qb = (u % 33) - 1; }
        if (qb >= 0) fa::attn_unit_fast(args, F, bh, qb); else attn_unit(args, F, bh, qb);
    }
}

__device__ __forceinline__ void route_phase(const Args& args, Frame& F, int layer, const bf16* hb, unsigned* gcnt, int* list, float* wts, unsigned* epos, float* rsl) {
    const int lane = F.lane, wave = F.wave, tid = F.tid, l15 = lane & 15, kq = lane >> 4;
    const float* gain = FIN(I_NFFN) + layer * 1024; const float* wrg = FIN(I_RWG) + (size_t)layer * 1024 * 4; const float* wre = FIN(I_RWE) + (size_t)layer * 1024 * 32;
    const float* brg = FIN(I_RBG) + layer * 4; const float* bre = FIN(I_RBE) + layer * 32;
    float* part_lg = (float*)(F.lds + RING_OFF);
    float* part_ss = (float*)(F.lds + RING_OFF + 49152);
    float* logit_s = (float*)(F.lds + RING_OFF + 50176);
    float* rstd_s = (float*)(F.lds + RING_OFF + 56320);
    int* dec_e = (int*)(F.lds + RING_OFF + 57344);
    float* dec_w = (float*)(F.lds + RING_OFF + 57344 + 2048);
    int* dec_rank = (int*)(F.lds + RING_OFF + 57344 + 4096);
    int* lcnt = (int*)(F.lds + RING_OFF + 57344 + 6144);
    int* lbase = (int*)(F.lds + RING_OFF + 57344 + 6144 + 128);
    float* rstd_all = (float*)(F.lds + RING_OFF + 57344 + 6144 + 256);
    const int RPB = (MROWS + F.G - 1) / F.G;
    const int r0 = blockIdx.x * RPB, r1 = (r0 + RPB < MROWS) ? r0 + RPB : MROWS;
    if (tid < 32) lcnt[tid] = 0;
    const int kbase = 128 * wave;
    bf16x8 wh[4][3], wl[4][3];
#pragma unroll
    for (int s4 = 0; s4 < 4; ++s4)
#pragma unroll
        for (int cb = 0; cb < 3; ++cb) {
            float w[8]; const int col = 16 * cb + l15;
#pragma unroll
            for (int j = 0; j < 8; ++j) { const int k = kbase + 32 * s4 + 8 * kq + j; float v = 0.f; if (col < 4) v = wrg[k * 4 + col]; else if (col < 36) v = wre[k * 32 + (col - 4)]; w[j] = v * gain[k]; }
            u32x4 ph, pl; unsigned hw[4], lw[4];
#pragma unroll
            for (int j = 0; j < 4; ++j) { const unsigned hb_ = pk2(w[2 * j], w[2 * j + 1]); hw[j] = hb_; lw[j] = pk2(w[2 * j] - bf2f(hb_ & 0xffff), w[2 * j + 1] - bf2f(hb_ >> 16)); }
            ph = (u32x4){hw[0], hw[1], hw[2], hw[3]}; pl = (u32x4){lw[0], lw[1], lw[2], lw[3]};
            wh[s4][cb] = __builtin_bit_cast(bf16x8, ph); wl[s4][cb] = __builtin_bit_cast(bf16x8, pl);
        }
    __syncthreads();
    const int ngroups = (RPB + 31) / 32;
    u32x4 xa[2][4];
    auto load_rows = [&](int g) {
#pragma unroll
        for (int rb = 0; rb < 2; ++rb) { const int lr = 32 * g + 16 * rb + l15, r = r0 + lr; const bool ok = lr < RPB && r < r1 && !row_is_dummy(r);
#pragma unroll
            for (int s4 = 0; s4 < 4; ++s4) xa[rb][s4] = ok ? *(const u32x4*)(hb + (size_t)r * 1024 + kbase + 32 * s4 + 8 * kq) : (u32x4){0u, 0u, 0u, 0u}; }
    };
    load_rows(0);
    for (int g = 0; g < ngroups; ++g) {
        u32x4 xc[2][4];
#pragma unroll
        for (int rb = 0; rb < 2; ++rb)
#pragma unroll
            for (int s4 = 0; s4 < 4; ++s4) xc[rb][s4] = xa[rb][s4];
        if (g + 1 < ngroups) load_rows(g + 1);
#pragma unroll
        for (int rb = 0; rb < 2; ++rb) {
            float ss = 0.f; f32x4 acc[3] = {};
#pragma unroll
            for (int s4 = 0; s4 < 4; ++s4) {
                const u32x4 q = xc[rb][s4]; const unsigned qw[4] = {q.x, q.y, q.z, q.w};
#pragma unroll
                for (int j = 0; j < 4; ++j) { const float a = bf2f(qw[j] & 0xffff), b = bf2f(qw[j] >> 16); ss += a * a + b * b; }
                const bf16x8 xh = __builtin_bit_cast(bf16x8, q);
#pragma unroll
                for (int cb = 0; cb < 3; ++cb) {
                    acc[cb] = __builtin_amdgcn_mfma_f32_16x16x32_bf16(xh, wh[s4][cb], acc[cb], 0, 0, 0);
                    acc[cb] = __builtin_amdgcn_mfma_f32_16x16x32_bf16(xh, wl[s4][cb], acc[cb], 0, 0, 0);
                }
            }
            ss += __shfl_xor(ss, 16); ss += __shfl_xor(ss, 32);
#pragma unroll
            for (int cb = 0; cb < 3; ++cb)
#pragma unroll
                for (int rg = 0; rg < 4; ++rg) part_lg[(wave * 32 + 16 * rb + 4 * kq + rg) * 48 + 16 * cb + l15] = acc[cb][rg];
            if (kq == 0) part_ss[wave * 32 + 16 * rb + l15] = ss;
        }
        __syncthreads();
        for (int i = tid; i < 1536; i += NTHREADS) { float a = 0.f;
#pragma unroll
            for (int w = 0; w < 8; ++w) a += part_lg[w * 1536 + i];
            logit_s[i] = a; }
        if (tid < 32) { float tot = 0.f;
#pragma unroll
            for (int w = 0; w < 8; ++w) tot += part_ss[w * 32 + tid];
            const float rstd = rsqrtf(tot * (1.f / 1024.f) + EPS); rstd_s[tid] = rstd; if (32 * g + tid < RPB) rstd_all[32 * g + tid] = rstd; }
        __syncthreads();
        if (tid < 32) {
            const int lr = 32 * g + tid, r = r0 + lr;
            if (lr < RPB) {
                int e1 = -1, e2 = -1; float w1 = 0.f, w2 = 0.f;
                if (r < r1 && !row_is_dummy(r)) {
                    const float* lg = logit_s + tid * 48; const float rs = rstd_s[tid];
                    float gl[4]; int gs = 0;
#pragma unroll
                    for (int i = 0; i < 4; ++i) gl[i] = lg[i] * rs + brg[i];
#pragma unroll
                    for (int i = 1; i < 4; ++i) if (gl[i] > gl[gs]) gs = i;
                    float den = 0.f;
#pragma unroll
                    for (int i = 0; i < 4; ++i) den += __expf(gl[i] - gl[gs]);
                    const float pg = 1.f / den;
                    float el[8]; int i1 = 0;
#pragma unroll
                    for (int i = 0; i < 8; ++i) el[i] = lg[4 + 8 * gs + i] * rs + bre[8 * gs + i];
#pragma unroll
                    for (int i = 1; i < 8; ++i) if (el[i] > el[i1]) i1 = i;
                    int i2 = (i1 == 0) ? 1 : 0;
#pragma unroll
                    for (int i = 0; i < 8; ++i) if (i != i1 && el[i] > el[i2]) i2 = i;
                    float e1v = el[0], e2v = el[0];
#pragma unroll
                    for (int i = 0; i < 8; ++i) { if (i == i1) e1v = el[i]; if (i == i2) e2v = el[i]; }
                    const float ex = __expf(e2v - e1v);
                    w1 = pg / (1.f + ex); w2 = pg * ex / (1.f + ex); e1 = 8 * gs + i1; e2 = 8 * gs + i2;
                }
                dec_e[2 * lr] = e1; dec_e[2 * lr + 1] = e2; dec_w[2 * lr] = w1; dec_w[2 * lr + 1] = w2;
                dec_rank[2 * lr] = e1 >= 0 ? atomicAdd(&lcnt[e1], 1) : 0; dec_rank[2 * lr + 1] = e2 >= 0 ? atomicAdd(&lcnt[e2], 1) : 0;
            }
        }
    }
    __syncthreads();
    if (tid < 32) lbase[tid] = (int)atomicAdd(gcnt + tid, (unsigned)lcnt[tid]);
    __syncthreads();
    for (int i = tid; i < 2 * RPB; i += NTHREADS) {
        const int e = dec_e[i]; if (e < 0) continue;
        const int slot = 2 * (r0 + (i >> 1)) + (i & 1); const int pos = lbase[e] + dec_rank[i];
        list[(size_t)e * MROWS + pos] = slot; wts[slot] = dec_w[i]; epos[slot] = ((unsigned)e << 20) | (unsigned)pos; rsl[(size_t)e * MROWS + pos] = rstd_all[i >> 1];
    }
    __syncthreads();
}

constexpr int G1_QT = 0, G1_KM = 17408, G1_KH = 34816, G1_VT = 55296, G1_BL = 92160, G1_GLR = 124928, G1_SCR = 129024;
constexpr int PQ = 272, PKH = 320, PV = 576;
__device__ __forceinline__ float logsigmoid_f(float x) { const float e = __builtin_amdgcn_exp2f(-1.4426950408889634f * fabsf(x)); return fminf(x, 0.f) - 0.6931471805599453f * __builtin_amdgcn_logf(1.f + e); }

__device__ __forceinline__ bf16x8 tr_frag(const LAS char* tile, int pitch, int col0, int ks, int lane) {
    const int hi = lane >> 5, q = (lane & 15) >> 2, p = lane & 3, h16 = (lane >> 4) & 1;
    const LAS char* a = tile + (16 * ks + 8 * hi + q) * pitch + (col0 + 16 * h16 + 4 * p) * 2;
    const s16x4 lo = vtr(a), hi4 = vtr(a + 4 * pitch);
    return (bf16x8){lo[0], lo[1], lo[2], lo[3], hi4[0], hi4[1], hi4[2], hi4[3]};
}

__device__ __forceinline__ void g1_phase(const Args& args, Frame& F) {
    const int tid = F.tid, lane = F.lane, wave = F.wave, r32 = lane & 31, hi = lane >> 5;
    unsigned char* shm = F.lds + RING_OFF;
    const bf16* ZQK = (const bf16*)(F.ws + A_ZQK); const bf16* ZV = (const bf16*)(F.ws + A_ZV); const float* GLR = (const float*)(F.ws + S_GLR);
    bf16* QT = (bf16*)(F.ws + A_QT);
    float* bL = (float*)(shm + G1_BL); float* scr = (float*)(shm + G1_SCR);
    constexpr int NPAIR = NB * GH * 16;
    int pair = blockIdx.x; if (pair >= NPAIR) return;
    int ci = 0;
    int bh = pair & 15, c = 8 * (pair >> 4), b = bh >> 2, h = bh & 3;
    f32x16 acc[4]; float pcum = 1.f;
    u32x4 qp[2], kp[2], vp[4]; f32x4 gl0 = {}, gl1 = {}; int prow[2], pd[2];
    const int tbw = wave & 1, dbw = wave >> 1;
#pragma unroll
    for (int j = 0; j < 2; ++j) { const int p = tid + 512 * j; prow[j] = p >> 4; pd[j] = (p & 15) * 8; }
#define G1_LOAD_QK(b_, c_, h_) do { _Pragma("unroll") for (int j = 0; j < 2; ++j) { const int row = row_of(b_, c_, prow[j]); const bool dz_ = (c_) == 0 && prow[j] < 48;     \
            qp[j] = dz_ ? (u32x4){0u, 0u, 0u, 0u} : *(const u32x4*)(ZQK + (size_t)row * 1024 + (h_) * 128 + pd[j]); kp[j] = dz_ ? (u32x4){0u, 0u, 0u, 0u} : *(const u32x4*)(ZQK + (size_t)row * 1024 + 512 + (h_) * 128 + pd[j]); } } while (0)
#define G1_LOAD_V(b_, c_, h_) do { _Pragma("unroll") for (int j = 0; j < 4; ++j) { const int p = tid + 512 * j, i = p >> 5, dc = (p & 31) * 8; vp[j] = ((c_) == 0 && i < 48) ? (u32x4){0u, 0u, 0u, 0u} : *(const u32x4*)(ZV + (size_t)row_of(b_, c_, i) * 1024 + (h_) * 256 + dc); } \
        { const float* gp_ = GLR + (size_t)row_of(b_, c_, 32 * tbw + r32) * 16 + 8 * hi; gl0 = *(const f32x4*)gp_; gl1 = *(const f32x4*)(gp_ + 4); } } while (0)
    G1_LOAD_V(b, c, h); G1_LOAD_QK(b, c, h);
    int wh_ = -1; bf16x8 wfh = {}, wfl = {}; float bg = 0.f;
    for (;;) {
        const int unit = bh * NTILE + c;
        bf16* ATT = (bf16*)(F.ws + A_ATT) + (size_t)unit * 4096; unsigned char* DST = (unsigned char*)F.out + (size_t)(bh * (NTILE - 1) + c) * 32768;     float* GAM = (float*)(F.ws + S_GAM) + (size_t)unit * 128;
        if (h != wh_) { const float* wgu = FIN(I_GWGU); unsigned hw[4], lw[4];
#pragma unroll
            for (int j = 0; j < 4; ++j) { const float w0 = wgu[(8 * hi + 2 * j) * GNK + h * 128 + 32 * dbw + r32], w1 = wgu[(8 * hi + 2 * j + 1) * GNK + h * 128 + 32 * dbw + r32];
                const unsigned hb_ = pk2(w0, w1); hw[j] = hb_; lw[j] = pk2(w0 - bf2f(hb_ & 0xffff), w1 - bf2f(hb_ >> 16)); }
            wfh = __builtin_bit_cast(bf16x8, (u32x4){hw[0], hw[1], hw[2], hw[3]}); wfl = __builtin_bit_cast(bf16x8, (u32x4){lw[0], lw[1], lw[2], lw[3]});
            bg = FIN(I_GBG)[h * 128 + 32 * dbw + r32]; wh_ = h; }
#pragma unroll
        for (int j = 0; j < 4; ++j) { const int p = tid + 512 * j, i = p >> 5, dc = (p & 31) * 8; *(u32x4*)(shm + G1_VT + i * PV + dc * 2) = vp[j]; }
        f32x16 gx;
        { const float gv[8] = {gl0.x, gl0.y, gl0.z, gl0.w, gl1.x, gl1.y, gl1.z, gl1.w}; unsigned hw[4], lw[4];
#pragma unroll
          for (int j = 0; j < 4; ++j) { const unsigned hb_ = pk2(gv[2 * j], gv[2 * j + 1]); hw[j] = hb_; lw[j] = pk2(gv[2 * j] - bf2f(hb_ & 0xffff), gv[2 * j + 1] - bf2f(hb_ >> 16)); }
          const bf16x8 xh = __builtin_bit_cast(bf16x8, (u32x4){hw[0], hw[1], hw[2], hw[3]}), xl = __builtin_bit_cast(bf16x8, (u32x4){lw[0], lw[1], lw[2], lw[3]});
#pragma unroll
          for (int r = 0; r < 16; ++r) gx[r] = bg;
          gx = __builtin_amdgcn_mfma_f32_32x32x16_bf16(xh, wfh, gx, 0, 0, 0); gx = __builtin_amdgcn_mfma_f32_32x32x16_bf16(xl, wfh, gx, 0, 0, 0); gx = __builtin_amdgcn_mfma_f32_32x32x16_bf16(xh, wfl, gx, 0, 0, 0); }
        const int nci = ((pair >> 4) == 15) ? 9 : 8; const bool same = ci + 1 < nci; const int pairn = same ? pair : pair + F.G; const bool more = same || pairn < NPAIR;
        const int bhn = pairn & 15, cn = same ? c + 1 : 8 * (pairn >> 4);
        if (more) G1_LOAD_V(bhn >> 2, cn, bhn & 3);
        { const int d = 32 * dbw + r32; float t0[4], t1[4];
#pragma unroll
          for (int g = 0; g < 4; ++g) { float run = 0.f;
#pragma unroll
              for (int e = 0; e < 4; ++e) { run += logsigmoid_f(gx[4 * g + e]) * (1.f / 16.f); gx[4 * g + e] = run; }
              const auto rr = __builtin_amdgcn_permlane32_swap(__float_as_uint(run), __float_as_uint(run), false, false); t0[g] = __uint_as_float(rr[0]); t1[g] = __uint_as_float(rr[1]); }
          float off[4], run = 0.f;
#pragma unroll
          for (int g = 0; g < 4; ++g) { const float o1 = run + t0[g]; off[g] = hi ? o1 : run; run = o1 + t1[g]; }
          if (tbw == 0 && hi == 0) scr[d] = run;
          __syncthreads();
          const float base = tbw ? scr[d] : 0.f;
#pragma unroll
          for (int g = 0; g < 4; ++g)
#pragma unroll
              for (int e = 0; e < 4; ++e) bL[(32 * tbw + 8 * g + 4 * hi + e) * 128 + d] = gx[4 * g + e] + (off[g] + base);
          if (tbw == 1 && hi == 0) { const float gam = __expf(run + base); scr[512 + d] = gam; pcum = (ci == 0) ? gam : pcum * gam; GAM[d] = pcum; } }
        __syncthreads();
#pragma unroll
        for (int j = 0; j < 2; ++j) {
            const int i = prow[j], d0 = pd[j]; const unsigned qw[4] = {qp[j].x, qp[j].y, qp[j].z, qp[j].w}, kw[4] = {kp[j].x, kp[j].y, kp[j].z, kp[j].w};
            float qt[8], km[8], kh[8];
#pragma unroll
            for (int e = 0; e < 8; ++e) { const float bb = bL[i * 128 + d0 + e], gam = scr[512 + d0 + e];
                const float qv = bf2f((e & 1) ? (qw[e >> 1] >> 16) : (qw[e >> 1] & 0xffff)), kv = bf2f((e & 1) ? (kw[e >> 1] >> 16) : (kw[e >> 1] & 0xffff));
                qt[e] = qv * 0.08838834764831845f * __expf(bb); km[e] = kv * __expf(-bb); kh[e] = km[e] * gam; }
            u32x4 wq, wm, wh; wq.x = pk2(qt[0], qt[1]); wq.y = pk2(qt[2], qt[3]); wq.z = pk2(qt[4], qt[5]); wq.w = pk2(qt[6], qt[7]);
            wm.x = pk2(km[0], km[1]); wm.y = pk2(km[2], km[3]); wm.z = pk2(km[4], km[5]); wm.w = pk2(km[6], km[7]);
            wh.x = pk2(kh[0], kh[1]); wh.y = pk2(kh[2], kh[3]); wh.z = pk2(kh[4], kh[5]); wh.w = pk2(kh[6], kh[7]);
            *(u32x4*)(shm + G1_QT + i * PQ + d0 * 2) = wq; *(u32x4*)(shm + G1_KM + i * PQ + d0 * 2) = wm; *(u32x4*)(shm + G1_KH + i * PKH + d0 * 2) = wh;
            *(u32x4*)(QT + (size_t)row_of(b, c, i) * 512 + h * 128 + d0) = wq;
        }
        if (more) G1_LOAD_QK(bhn >> 2, cn, bhn & 3);
        __syncthreads();
        if (wave < 4) {
            const int sb = wave & 1, tb = wave >> 1; f32x16 a = {};
            if (!(sb == 1 && tb == 0)) {
#pragma unroll
                for (int ks = 0; ks < 8; ++ks) { const bf16x8 fa = *(const LAS bf16x8*)((const LAS char*)(shm + G1_KM) + (32 * sb + r32) * PQ + (16 * ks + 8 * hi) * 2), fb = *(const LAS bf16x8*)((const LAS char*)(shm + G1_QT) + (32 * tb + r32) * PQ + (16 * ks + 8 * hi) * 2);
                    a = __builtin_amdgcn_mfma_f32_32x32x16_bf16(fa, fb, a, 0, 0, 0); }
            }
            const int t = 32 * tb + r32;
#pragma unroll
            for (int g = 0; g < 4; ++g) { const int s0 = 32 * sb + 8 * g + 4 * hi; float v[4];
#pragma unroll
                for (int e = 0; e < 4; ++e) v[e] = (s0 + e <= t) ? a[4 * g + e] : 0.f;
                u32x2 w; w.x = pk2(v[0], v[1]); w.y = pk2(v[2], v[3]); *(u32x2*)(ATT + t * 64 + s0) = w; }
        }
        if (c < NTILE - 1) {
          if (ci == 0) {
#pragma unroll
              for (int kb = 0; kb < 4; ++kb) acc[kb] = f32x16{};
          } else {
#pragma unroll
              for (int kb = 0; kb < 4; ++kb)
#pragma unroll
                  for (int g = 0; g < 4; ++g) { const f32x4 gm = *(const f32x4*)(scr + 512 + 32 * kb + 8 * g + 4 * hi); acc[kb][4 * g] *= gm.x; acc[kb][4 * g + 1] *= gm.y; acc[kb][4 * g + 2] *= gm.z; acc[kb][4 * g + 3] *= gm.w; }
          }
#pragma unroll
          for (int ks = 0; ks < 4; ++ks) {
              const bf16x8 fv = tr_frag((const LAS char*)(shm + G1_VT), PV, 32 * wave, ks, lane);
#pragma unroll
              for (int kb = 0; kb < 4; ++kb) { const bf16x8 fk = tr_frag((const LAS char*)(shm + G1_KH), PKH, 32 * kb, ks, lane); acc[kb] = __builtin_amdgcn_mfma_f32_32x32x16_bf16(fk, fv, acc[kb], 0, 0, 0); }
          }
          const int dv = 32 * wave + r32;
#pragma unroll
          for (int kb = 0; kb < 4; ++kb) {
              unsigned g0 = pk4_e4m3(acc[kb][0], acc[kb][1], acc[kb][2], acc[kb][3]), g1 = pk4_e4m3(acc[kb][4], acc[kb][5], acc[kb][6], acc[kb][7]);
              unsigned g2 = pk4_e4m3(acc[kb][8], acc[kb][9], acc[kb][10], acc[kb][11]), g3 = pk4_e4m3(acc[kb][12], acc[kb][13], acc[kb][14], acc[kb][15]);
              { const auto r = __builtin_amdgcn_permlane32_swap(g0, g2, false, false); g0 = r[0]; g2 = r[1]; }
              { const auto r = __builtin_amdgcn_permlane32_swap(g1, g3, false, false); g1 = r[0]; g3 = r[1]; }
              *(u32x4*)(DST + dv * 128 + 32 * kb + 16 * hi) = (u32x4){g0, g2, g1, g3};
          } }
        __syncthreads();
        if (!more) break;
        ci = same ? ci + 1 : 0; pair = pairn; bh = bhn; c = cn; b = bh >> 2; h = bh & 3;
    }
#undef G1_LOAD_QK
#undef G1_LOAD_V
}
__device__ __forceinline__ void g2_phase(Frame& F) {
    const unsigned char* LS = (const unsigned char*)F.out; const float* GAM = (const float*)(F.ws + S_GAM); bf16* BST = (bf16*)(F.ws + A_BST);
    for (int e4 = blockIdx.x * NTHREADS + F.tid; e4 < NB * GH * 8192; e4 += F.G * NTHREADS) {
        const int bh = e4 >> 13, idx = e4 & 8191, dk0 = (idx * 4) & 127;
        unsigned dd[15]; f32x4 gg[15];
#pragma unroll
        for (int r = 0; r < 15; ++r) { const size_t j = 8 * r + 7; dd[r] = *(const unsigned*)(LS + ((size_t)bh * (NTILE - 1) + j) * 32768 + idx * 4); gg[r] = *(const f32x4*)(GAM + ((size_t)bh * NTILE + j) * 128 + dk0); }
        float s0 = 0.f, s1 = 0.f, s2 = 0.f, s3 = 0.f;
#pragma unroll
        for (int r = 0; r < 15; ++r) {
            const f32x2_t lo = __builtin_amdgcn_cvt_pk_f32_fp8((int)dd[r], false), hi2 = __builtin_amdgcn_cvt_pk_f32_fp8((int)dd[r], true);
            s0 = gg[r].x * s0 + lo.x; s1 = gg[r].y * s1 + lo.y; s2 = gg[r].z * s2 + hi2.x; s3 = gg[r].w * s3 + hi2.y;
            *(u32x2*)(BST + ((size_t)bh * 15 + r) * 32768 + idx * 4) = (u32x2){pk2(s0, s1), pk2(s2, s3)}; }
    }
}
constexpr int G3_QT = 0, G3_AT = 17408, G3_VT = 26624, G3_PART = 63488, G3_QT2 = 65536;
constexpr int PA = 144;
__device__ __forceinline__ void g3_phase(const Args& args, Frame& F) {
    const int tid = F.tid, lane = F.lane, wave = F.wave, r32 = lane & 31, hi = lane >> 5;
    unsigned char* shm = F.lds + RING_OFF;
    const bf16* QT = (const bf16*)(F.ws + A_QT); const bf16* ZV = (const bf16*)(F.ws + A_ZV); const bf16* ZR = (const bf16*)(F.ws + A_ZR); bf16* OG = (bf16*)(F.ws + A_OG);
    float* part = (float*)(shm + G3_PART);
    const float* gout = FIN(I_GGOUT);
    constexpr int NPAIR = NB * GH * 16;
    const float* GAM = (const float*)(F.ws + S_GAM); const bf16* BST = (const bf16*)(F.ws + A_BST);
    int pair = blockIdx.x; if (pair >= NPAIR) return;
    int ci = 0;
    int bh = pair & 15, c = 8 * (pair >> 4) + 1, b = bh >> 2, h = bh & 3;
    u32x4 qp[2], ap, vp[4]; u32x2 sf[8]; f32x4 pj[2][2];
    bf16x8 bfr[8];
#define G3_LOAD() do { const int unit_ = bh * NTILE + c; const bf16* ATT_ = (const bf16*)(F.ws + A_ATT) + (size_t)unit_ * 4096; const unsigned char* SB_ = (const unsigned char*)F.out + (size_t)(bh * (NTILE - 1) + c - 1) * 32768; \
        _Pragma("unroll") for (int j = 0; j < 2; ++j) { const int p = tid + 512 * j, i = p >> 4, d0 = (p & 15) * 8; qp[j] = *(const u32x4*)(QT + (size_t)row_of(b, c, i) * 512 + h * 128 + d0); } \
        { const int i = tid >> 3, s0 = (tid & 7) * 8; ap = *(const u32x4*)(ATT_ + i * 64 + s0); } \
        _Pragma("unroll") for (int j = 0; j < 4; ++j) { const int p = tid + 512 * j, i = p >> 5, dc = (p & 31) * 8; vp[j] = *(const u32x4*)(ZV + (size_t)row_of(b, c, i) * 1024 + h * 256 + dc); } \
        _Pragma("unroll") for (int j = 0; j < 2; ++j) { const int d0 = ((tid + 512 * j) & 15) * 8; const float* pp_ = GAM + ((size_t)bh * NTILE + c - 1) * 128 + d0; pj[j][0] = *(const f32x4*)pp_; pj[j][1] = *(const f32x4*)(pp_ + 4); } \
        { _Pragma("unroll") for (int ks = 0; ks < 8; ++ks) sf[ks] = *(const u32x2*)(SB_ + (32 * wave + r32) * 128 + 16 * ks + 8 * hi); } } while (0)
#define G3_LOADB() do { if ((pair >> 4) > 0) { const bf16* bp_ = BST + ((size_t)bh * 15 + (pair >> 4) - 1) * 32768 + (32 * wave + r32) * 128 + 8 * hi; _Pragma("unroll") for (int ks = 0; ks < 8; ++ks) bfr[ks] = *(const bf16x8*)(bp_ + 16 * ks); } } while (0)
    G3_LOAD(); G3_LOADB();
    float go[4][4];
#pragma unroll
    for (int g = 0; g < 4; ++g)
#pragma unroll
        for (int e = 0; e < 4; ++e) go[g][e] = gout[32 * wave + 8 * g + 4 * hi + e];
    for (;;) {
#pragma unroll
        for (int j = 0; j < 2; ++j) { const int p = tid + 512 * j, i = p >> 4, d0 = (p & 15) * 8; *(u32x4*)(shm + G3_QT + i * PQ + d0 * 2) = qp[j];
            if ((pair >> 4) > 0) { float x[8]; unpack8(qp[j], x);
                x[0] *= pj[j][0].x; x[1] *= pj[j][0].y; x[2] *= pj[j][0].z; x[3] *= pj[j][0].w; x[4] *= pj[j][1].x; x[5] *= pj[j][1].y; x[6] *= pj[j][1].z; x[7] *= pj[j][1].w;
                *(u32x4*)(shm + G3_QT2 + i * PQ + d0 * 2) = pack8(x); } }
        { const int i = tid >> 3, s0 = (tid & 7) * 8; *(u32x4*)(shm + G3_AT + i * PA + s0 * 2) = ap; }
#pragma unroll
        for (int j = 0; j < 4; ++j) { const int p = tid + 512 * j, i = p >> 5, dc = (p & 31) * 8; *(u32x4*)(shm + G3_VT + i * PV + dc * 2) = vp[j]; }
        u32x2 rw[2][4];
#pragma unroll
        for (int tb = 0; tb < 2; ++tb) { const int row = row_of(b, c, 32 * tb + r32);
#pragma unroll
            for (int g = 0; g < 4; ++g) rw[tb][g] = *(const u32x2*)(ZR + (size_t)row * 1024 + h * 256 + 32 * wave + 8 * g + 4 * hi); }
        __syncthreads();
        f32x16 acc[2] = {};
        {
#pragma unroll
            for (int ks = 0; ks < 8; ++ks) {
                const f32x2_t e0 = __builtin_amdgcn_cvt_pk_f32_fp8((int)sf[ks].x, false), e1 = __builtin_amdgcn_cvt_pk_f32_fp8((int)sf[ks].x, true), e2 = __builtin_amdgcn_cvt_pk_f32_fp8((int)sf[ks].y, false), e3 = __builtin_amdgcn_cvt_pk_f32_fp8((int)sf[ks].y, true);
                const bf16x8 sfb = __builtin_bit_cast(bf16x8, (u32x4){pk2(e0.x, e0.y), pk2(e1.x, e1.y), pk2(e2.x, e2.y), pk2(e3.x, e3.y)});
#pragma unroll
                for (int tb = 0; tb < 2; ++tb) { const bf16x8 fb = *(const LAS bf16x8*)((const LAS char*)(shm + G3_QT) + (32 * tb + r32) * PQ + (16 * ks + 8 * hi) * 2); acc[tb] = __builtin_amdgcn_mfma_f32_32x32x16_bf16(sfb, fb, acc[tb], 0, 0, 0); }
            }
            if ((pair >> 4) > 0) {
#pragma unroll
                for (int ks = 0; ks < 8; ++ks)
#pragma unroll
                    for (int tb = 0; tb < 2; ++tb) { const bf16x8 fb = *(const LAS bf16x8*)((const LAS char*)(shm + G3_QT2) + (32 * tb + r32) * PQ + (16 * ks + 8 * hi) * 2); acc[tb] = __builtin_amdgcn_mfma_f32_32x32x16_bf16(bfr[ks], fb, acc[tb], 0, 0, 0); }
            }
        }
        const bool same = ci + 1 < 8; const int pairn = same ? pair : pair + F.G; const bool more = same || pairn < NPAIR; const int bhn = pairn & 15, cn = same ? c + 1 : 8 * (pairn >> 4) + 1;
        const int b0 = b, c0 = c, h0 = h, bh0 = bh;
        if (more) { bh = bhn; c = cn; b = bh >> 2; h = bh & 3; G3_LOAD(); bh = bh0; c = c0; b = b0; h = h0; }
#pragma unroll
        for (int ks = 0; ks < 4; ++ks) {
            const bf16x8 fv = tr_frag((const LAS char*)(shm + G3_VT), PV, 32 * wave, ks, lane);
#pragma unroll
            for (int tb = 0; tb < 2; ++tb) { const bf16x8 fb = *(const LAS bf16x8*)((const LAS char*)(shm + G3_AT) + (32 * tb + r32) * PA + (16 * ks + 8 * hi) * 2); acc[tb] = __builtin_amdgcn_mfma_f32_32x32x16_bf16(fv, fb, acc[tb], 0, 0, 0); }
        }
#pragma unroll
        for (int tb = 0; tb < 2; ++tb) { float sq = 0.f;
#pragma unroll
            for (int r = 0; r < 16; ++r) sq += acc[tb][r] * acc[tb][r];
            sq += __shfl_xor(sq, 32);
            if (hi == 0) part[wave * 64 + 32 * tb + r32] = sq; }
        __syncthreads();
#pragma unroll
        for (int tb = 0; tb < 2; ++tb) {
            const int t = 32 * tb + r32; float tot = 0.f;
#pragma unroll
            for (int w = 0; w < 8; ++w) tot += part[w * 64 + t];
            const float rstd = rsqrtf(tot * (1.f / GDV) + EPS);
            const int row = row_of(b, c, t);
#pragma unroll
            for (int g = 0; g < 4; ++g) {
                const int dv = 32 * wave + 8 * g + 4 * hi; const u32x2 rwv = rw[tb][g];
                const float rv[4] = {bf2f(rwv.x & 0xffff), bf2f(rwv.x >> 16), bf2f(rwv.y & 0xffff), bf2f(rwv.y >> 16)}; float o[4];
#pragma unroll
                for (int e = 0; e < 4; ++e) o[e] = acc[tb][4 * g + e] * rstd * go[g][e] * (rv[e] * __builtin_amdgcn_rcpf(1.f + __expf(-rv[e])));
                u32x2 w; w.x = pk2(o[0], o[1]); w.y = pk2(o[2], o[3]); *(u32x2*)(OG + (size_t)row * 1024 + h * 256 + dv) = w;
            }
        }
        __syncthreads();
        if (!more) break;
        ci = same ? ci + 1 : 0; pair = pairn; bh = bhn; c = cn; b = bh >> 2; h = bh & 3;
        if (!same) G3_LOADB();
    }
#undef G3_LOAD
#undef G3_LOADB
}

template <bool FINAL>
__device__ __forceinline__ void combine_rows(const Args& args, Frame& F, const MoeTables& T, float* rs2) {
    const unsigned char* y = (const unsigned char*)(F.ws + A_Y); bf16* hb = (bf16*)(F.ws + A_HB); const unsigned* epos = (const unsigned*)(F.ws + S_EPOS); const unsigned* wtsu = (const unsigned*)(F.ws + S_WTS);
    const int gw = F.vcu * NWAVES + F.wave, NGW = F.G * NWAVES, lane = F.lane;
    const int RMAX = FINAL ? NREAL : MROWS;
#define CB_META(r_) ((lane < 2 ? epos : wtsu)[2 * (size_t)(r_) + (lane & 1)])
#define CB_LOAD(r_, m_, h_, y0_, y1_, w0_, w1_) do { if (!row_is_dummy(r_)) { \
            const unsigned e0_ = (unsigned)__builtin_amdgcn_readlane((int)m_, 0), e1_ = (unsigned)__builtin_amdgcn_readlane((int)m_, 1); \
            w0_ = Y_INV * __uint_as_float((unsigned)__builtin_amdgcn_readlane((int)m_, 2)); w1_ = Y_INV * __uint_as_float((unsigned)__builtin_amdgcn_readlane((int)m_, 3)); \
            const size_t ya_ = (size_t)T.cpre[e0_ >> 20] + (e0_ & 0xfffffu), yb_ = (size_t)T.cpre[e1_ >> 20] + (e1_ & 0xfffffu); \
            _Pragma("unroll") for (int j = 0; j < 4; ++j) { h_[j] = *(const u32x2*)(hb + (size_t)(r_) * 1024 + 4 * lane + 256 * j); \
                y0_[j] = *(const unsigned*)(y + ya_ * 1024 + 4 * lane + 256 * j); y1_[j] = *(const unsigned*)(y + yb_ * 1024 + 4 * lane + 256 * j); } } } while (0)
    u32x2 ha[4], hq[4]; unsigned ya0[4], ya1[4], yb0[4], yb1[4]; float wa0 = 0.f, wa1 = 0.f, wb0 = 0.f, wb1 = 0.f; unsigned mnext = 0u;
    if (gw < RMAX) { unsigned m0 = row_is_dummy(gw) ? 0u : CB_META(gw); CB_LOAD(gw, m0, ha, ya0, ya1, wa0, wa1); if (gw + NGW < RMAX && !row_is_dummy(gw + NGW)) mnext = CB_META(gw + NGW); }
    for (int r = gw; r < RMAX; r += NGW) {
        const int rn = r + NGW, rnn = r + 2 * NGW;
        if (rn < RMAX) CB_LOAD(rn, mnext, hq, yb0, yb1, wb0, wb1);
        if (rnn < RMAX && !row_is_dummy(rnn)) mnext = CB_META(rnn);
        if (row_is_dummy(r)) {
            if (!FINAL && lane == 0) rs2[r] = 0.f;
        } else {
            f32x4 v[4];
#pragma unroll
            for (int j = 0; j < 4; ++j) { const u32x2 q = ha[j];
                const f32x2_t a0 = __builtin_amdgcn_cvt_pk_f32_fp8((int)ya0[j], false), a1 = __builtin_amdgcn_cvt_pk_f32_fp8((int)ya0[j], true), b0 = __builtin_amdgcn_cvt_pk_f32_fp8((int)ya1[j], false), b1 = __builtin_amdgcn_cvt_pk_f32_fp8((int)ya1[j], true);
                v[j].x = bf2f(q.x & 0xffff) + (wa0 * a0.x + wa1 * b0.x); v[j].y = bf2f(q.x >> 16) + (wa0 * a0.y + wa1 * b0.y);
                v[j].z = bf2f(q.y & 0xffff) + (wa0 * a1.x + wa1 * b1.x); v[j].w = bf2f(q.y >> 16) + (wa0 * a1.y + wa1 * b1.y); }
            if (FINAL) {
#pragma unroll
                for (int j = 0; j < 4; ++j) __builtin_nontemporal_store(v[j], (f32x4*)(F.out + (size_t)r * 1024 + 4 * lane + 256 * j));
            } else {
#pragma unroll
                for (int j = 0; j < 4; ++j) { u32x2 o; o.x = pk2(v[j].x, v[j].y); o.y = pk2(v[j].z, v[j].w); *(u32x2*)(hb + (size_t)r * 1024 + 4 * lane + 256 * j) = o;
                    v[j] = (f32x4){bf2f(o.x & 0xffff), bf2f(o.x >> 16), bf2f(o.y & 0xffff), bf2f(o.y >> 16)}; }
                float sq = 0.f;
#pragma unroll
                for (int j = 0; j < 4; ++j) sq += (v[j].x * v[j].x + v[j].y * v[j].y) + (v[j].z * v[j].z + v[j].w * v[j].w);
                const float rstd = rsqrtf(wave_sum(sq) * (1.f / 1024.f) + EPS);
                if (lane == 0) rs2[r] = rstd;
            }
        }
#pragma unroll
        for (int j = 0; j < 4; ++j) { ha[j] = hq[j]; ya0[j] = yb0[j]; ya1[j] = yb1[j]; }
        wa0 = wb0; wa1 = wb1;
    }
#undef CB_META
#undef CB_LOAD
}

__device__ __forceinline__ void glr_skinny(Frame& F, const bf16* hb, const bf16* Wg, const float* rs2, float* GLR) {
    const int tid = F.tid, lane = F.lane, l15 = lane & 15, kq = lane >> 4;
    LAS unsigned char* wl = (LAS unsigned char*)F.lds + RING_OFF;
    __syncthreads();
#pragma unroll
    for (int i = 0; i < 4; ++i) { const int p = tid + 512 * i, n = p >> 7, c = (p & 127) * 16; *(LAS u32x4*)(wl + n * 2064 + c) = *(const u32x4*)((const char*)Wg + (size_t)n * 2048 + c); }
    __syncthreads();
    const int NG = MROWS / 16;
    for (int grp = F.vcu * NWAVES + F.wave; grp < NG; grp += F.G * NWAVES) {
        const bf16* ap = hb + (size_t)(16 * grp + l15) * 1024 + 8 * kq;
        f32x4 acc = {};
#pragma unroll 1
        for (int bt = 0; bt < 4; ++bt) {
            u32x4 a[8];
#pragma unroll
            for (int j = 0; j < 8; ++j) a[j] = *(const u32x4*)(ap + 32 * (8 * bt + j));
#pragma unroll
            for (int j = 0; j < 8; ++j) { const bf16x8 b = *(const LAS bf16x8*)(wl + l15 * 2064 + (8 * bt + j) * 64 + kq * 16); acc = __builtin_amdgcn_mfma_f32_16x16x32_bf16(__builtin_bit_cast(bf16x8, a[j]), b, acc, 0, 0, 0); }
        }
#pragma unroll
        for (int r = 0; r < 4; ++r) { const int row = 16 * grp + 4 * kq + r; GLR[(size_t)row * 16 + l15] = acc[r] * rs2[row]; }
    }
    __syncthreads();
}

template <class EpiF>
__device__ __forceinline__ void meta_gemm(const bf16* A, int lda, const bf16* Bt, int K, int N, Frame& F, EpiF epi) {
    if (F.vcu >= N / 32) return;
    const int lane = F.lane, wave = F.wave, l15 = lane & 15, kq = lane >> 4, kpart = wave & 3;
    const int col0 = 16 * (2 * F.vcu + (wave >> 2)), k0 = kpart * (K / 4), nks = K / 128;
    float* red = (float*)(F.lds + RING_OFF);
    f32x4 acc[4] = {};
#pragma unroll 4
    for (int s4 = 0; s4 < nks; ++s4) {
        const bf16x8 bfr = *(const bf16x8*)(Bt + (size_t)(col0 + l15) * K + k0 + 32 * s4 + 8 * kq);
#pragma unroll
        for (int rb = 0; rb < 4; ++rb) { const bf16x8 afr = *(const bf16x8*)(A + (size_t)(NREAL + rb * 64 + 48 + l15) * lda + k0 + 32 * s4 + 8 * kq); acc[rb] = __builtin_amdgcn_mfma_f32_16x16x32_bf16(afr, bfr, acc[rb], 0, 0, 0); }
    }
#pragma unroll
    for (int rb = 0; rb < 4; ++rb)
#pragma unroll
        for (int rg = 0; rg < 4; ++rg) red[(wave * 16 + rb * 4 + rg) * 64 + lane] = acc[rb][rg];
    __syncthreads();
    if (kpart == 0) {
#pragma unroll
        for (int rb = 0; rb < 4; ++rb)
#pragma unroll
            for (int rg = 0; rg < 4; ++rg) { float v = acc[rb][rg];
#pragma unroll
                for (int w = 1; w < 4; ++w) v += red[((wave + w) * 16 + rb * 4 + rg) * 64 + lane];
                epi(NREAL + rb * 64 + 48 + 4 * kq + rg, col0 + l15, v); }
    }
    __syncthreads();
}

struct MetaEpiQ { bf16* QR; const float* part;
    __device__ __forceinline__ void operator()(int row, int col, float v) const { float ss = 0.f;
#pragma unroll
        for (int i = 0; i < 12; ++i) ss += part[(size_t)row * 24 + i];
        QR[(size_t)row * 1536 + col] = (bf16)f2bf(v * rsqrtf(ss * (1.f / MLA_Q) + EPS)); } };
struct MetaEpiKV { bf16* KN; bf16* VT; const float* part;
    __device__ __forceinline__ void operator()(int row, int col, float v) const { float ss = 0.f;
#pragma unroll
        for (int i = 12; i < 20; ++i) ss += part[(size_t)row * 24 + i];
        const bf16 o = (bf16)f2bf(v * rsqrtf(ss * (1.f / MLA_KV) + EPS));
        int b, tile, r64; row_btr(row, b, tile, r64);
        if (col < 1024) { const int pn = col >> 8, bj = (col >> 7) & 1, wc = (col >> 5) & 3, head = 4 * pn + wc, d = 32 * bj + (col & 31); KN[(size_t)row * 1024 + head * 64 + d] = o; }
        else { const int hv = (col - 1024) >> 6, d = col & 63; VT[((((size_t)(b * NHEAD + hv) * NTILE + tile) * 2 + (d >> 5)) * 64 + r64) * 32 + (d & 31)] = o; } } };
struct MetaEpiRes { const float* meta; bf16* hb;
    __device__ __forceinline__ void operator()(int row, int col, float v) const { const int q = row - NREAL;
        const float sv = meta ? meta[(size_t)((q & 63) - 48) * 1024 + col] : bf2f(hb[(size_t)row * 1024 + col]); hb[(size_t)row * 1024 + col] = (bf16)f2bf(sv + v); } };

struct MetaEpiZgla { bf16* ZQK; bf16* ZV; bf16* ZR; const float* rs2;
    __device__ __forceinline__ void operator()(int row, int col, float v) const { bf16* dst = col < 1024 ? ZQK : (col < 2048 ? ZV : ZR); dst[(size_t)row * 1024 + (col & 1023)] = (bf16)f2bf(v * rs2[row]); } };

#ifndef STOP_AFTER
#define STOP_AFTER 99
#endif
constexpr int N_PHASES = 19;
__global__ void __launch_bounds__(NTHREADS, 2) fwd_kernel(const Args args) {
    extern __shared__ __attribute__((aligned(16))) unsigned char lds_raw[];
    Frame F;
    F.lds = lds_raw; F.MISC = (volatile LAS unsigned*)((LAS unsigned char*)lds_raw + MISC_OFF);
    F.tid = threadIdx.x; F.lane = F.tid & 63; F.wave = __builtin_amdgcn_readfirstlane(F.tid >> 6);
    F.G = gridDim.x; { const int bx = blockIdx.x; F.vcu = (F.G % 8 == 0) ? (bx % 8) * (F.G / 8) + bx / 8 : bx; }
    F.ws = args.ws; F.ctl = (unsigned*)(args.ws + WS_CTL); F.out = args.out;
    for (int u = F.tid; u < (LDS_BYTES - LDSCTL_OFF) / 4; u += NTHREADS) ((LAS unsigned*)((LAS unsigned char*)lds_raw + LDSCTL_OFF))[u] = 0u;
    __syncthreads();
    XcdBarrier bar = xcd_barrier_post(F.ctl + CW_BAR, F.MISC);
    const int lo = args.ph_lo, hi = args.ph_hi;
    LAS unsigned char* ldsl = (LAS unsigned char*)lds_raw + RING_OFF;
    unsigned char* ws = F.ws;
#ifndef ONLY_PHASE
#define ONLY_PHASE -1
#endif
#define IN(k) ((ONLY_PHASE < 0 || ONLY_PHASE == (k)) && lo <= (k) && (k) < hi)
#ifndef DUP_MASK
#define DUP_MASK 0
#endif
#define REP(k) _Pragma("unroll") for (int rep_ = 0; rep_ < 1 + ((DUP_MASK >> (k)) & 1); ++rep_)
#define SEAM(k) do { if (IN(k) && IN((k) + 1)) xcd_barrier(bar); } while (0)

    if (IN(0)) REP(0) { __syncthreads(); p0_prologue(args, F); } SEAM(0);
    if (IN(1)) REP(1) { __syncthreads();
        pg8::DenseSched S; S.init(MROWS, MLA_INP, F.G, (int)blockIdx.x, ws + A_HN, 512, ws + W_MI, 512);
        EpiZmla E{(bf16*)(ws + A_ZMLA), (float*)(ws + S_PART)};
        pg8::gemm_phase(ldsl, 512, S, E);
        if (F.G == 256 && (int)blockIdx.x >= 387 - 256) {
            const int nw = (2 * 256 - 387) * NWAVES, lim = nw * P1_FILL_PER_WAVE < D1_ITEMS ? nw * P1_FILL_PER_WAVE : D1_ITEMS;
            def_convert<1>(args, F, ((int)blockIdx.x - (387 - 256)) * NWAVES + F.wave, nw, lim, P1_FILL_PER_WAVE); }
    } SEAM(1);
    if (IN(2)) REP(2) { __syncthreads();
        { meta_gemm((const bf16*)(ws + A_ZMLA), MLA_INP, (const bf16*)(ws + W_UQ), MLA_Q, 1536, F, MetaEpiQ{(bf16*)(ws + A_QRAW), (const float*)(ws + S_PART)});
          meta_gemm((const bf16*)(ws + A_ZMLA) + MLA_Q, MLA_INP, (const bf16*)(ws + W_UKV), MLA_KV, 2048, F, MetaEpiKV{(bf16*)(ws + A_KNRAW), (bf16*)F.out, (const float*)(ws + S_PART)}); }
        { pg8::DenseSched S; S.init(NREAL, 1536, F.G, (int)blockIdx.x, ws + A_ZMLA, MLA_INP, ws + W_UQ, MLA_Q);
          EpiQ E{(bf16*)(ws + A_QRAW), (const float*)(ws + S_PART)}; pg8::gemm_phase(ldsl, MLA_Q, S, E);
#ifdef DUP_Q
          __syncthreads(); pg8::gemm_phase(ldsl, MLA_Q, S, E);
#endif
        }
        { pg8::DenseSched S; S.init(NREAL, 2048, F.G, (int)blockIdx.x, ws + A_ZMLA + MLA_Q * 2, MLA_INP, ws + W_UKV, MLA_KV);
          EpiKV E{(bf16*)(ws + A_K), (bf16*)F.out, (const float*)(ws + S_PART), (float*)(ws + A_KNRAW), FIN(I_MGKN)}; pg8::gemm_phase(ldsl, MLA_KV, S, E);
#ifdef DUP_KV
          __syncthreads(); pg8::gemm_phase(ldsl, MLA_KV, S, E);
#endif
        }
    } SEAM(2);
    if (IN(3)) REP(3) { __syncthreads(); kprep_phase(args, F); } SEAM(3);
    if (IN(4)) REP(4) { __syncthreads(); attn_phase(args, F); } SEAM(4);
    if (IN(5)) REP(5) { __syncthreads();
        meta_gemm((const bf16*)(ws + A_O), 1024, (const bf16*)(ws + W_OM), 1024, 1024, F, MetaEpiRes{FIN(I_META), (bf16*)(ws + A_HB)});
        pg8::DenseSched S; S.init(NREAL, 1024, F.G, (int)blockIdx.x, ws + A_O8, 512, ws + A_WOM8, 512);
        EpiRes8 E{FIN(I_X), (bf16*)(ws + A_HB)}; pg8::gemm_phase(ldsl, 512, S, E);
    } SEAM(5);
#if STOP_AFTER >= 6
    if (IN(6)) { route_phase(args, F, 0, (const bf16*)(ws + A_HB), F.ctl + CW_CNT, (int*)(ws + S_LIST), (float*)(ws + S_WTS), (unsigned*)(ws + S_EPOS), (float*)(ws + A_RSL));
 } SEAM(6);
    if (IN(7)) REP(7) { __syncthreads();
        MoeTables T = moe_tables(F, F.ctl + CW_CNT);
        MoeSched S{T, 2, F.G, F.vcu, true, (const char*)(ws + A_HB), 1024, (const char*)(ws + W_GU), 1024, (size_t)512 * 1024 * 2, (const int*)(ws + S_LIST)};
        EpiGU E{(bf16*)(ws + A_HID), (const float*)(ws + A_RSL), T.cnt}; pg8::gemm_phase(ldsl, 1024, S, E);
        def_fill_idle<7>(args, F, (int)T.tpre[32] * 2, WD_ITEMS, P7_FILL_PER_WAVE, true);
        { const int tot = (int)T.tpre[32] * 2, maxu = (tot + F.G - 1) / F.G, thr = tot - (maxu - 1) * F.G, nfill = F.G - thr;
          if (F.vcu >= thr && nfill > 0) { int cov = nfill * NWAVES * P7_FILL2_PER_WAVE; cov = cov < GU_ITEMS ? cov : GU_ITEMS; def_convert<7>(args, F, WD_ITEMS + (F.vcu - thr) * NWAVES + F.wave, nfill * NWAVES, WD_ITEMS + cov, P7_FILL2_PER_WAVE); } }
    } SEAM(7);
    if (IN(8)) REP(8) { __syncthreads();
        MoeTables T = moe_tables(F, F.ctl + CW_CNT);
        MoeSched S{T, 4, F.G, F.vcu, false, (const char*)(ws + A_HID), 256, (const char*)(ws + W_D), 256, (size_t)1024 * 256 * 2, (const int*)(ws + S_LIST)};
        EpiDown E{(unsigned char*)(ws + A_Y), T.cnt, T.cpre}; pg8::gemm_phase(ldsl, 256, S, E);
    } SEAM(8);
#endif
#if STOP_AFTER >= 9
    if (IN(9)) { MoeTables T = moe_tables(F, F.ctl + CW_CNT); combine_rows<false>(args, F, T, (float*)(ws + S_SSQ_Q)); } SEAM(9);
#endif
#if STOP_AFTER >= 10
    if (IN(10)) REP(10) { __syncthreads();
        meta_gemm((const bf16*)(ws + A_HB), 1024, (const bf16*)(ws + W_GI), 1024, 3072, F, MetaEpiZgla{(bf16*)(ws + A_ZQK), (bf16*)(ws + A_ZV), (bf16*)(ws + A_ZR), (const float*)(ws + S_SSQ_Q)});
        pg8::DenseSched S; S.init(NREAL, 3072, F.G, (int)blockIdx.x, ws + A_HB, 1024, ws + W_GI, 1024);
        EpiZgla E{(bf16*)(ws + A_ZQK), (bf16*)(ws + A_ZV), (bf16*)(ws + A_ZR), (float*)(ws + S_GLR), (const float*)(ws + S_SSQ_Q)}; pg8::gemm_phase(ldsl, 1024, S, E);
        glr_skinny(F, (const bf16*)(ws + A_HB), (const bf16*)(ws + W_GI) + (size_t)3072 * 1024, (const float*)(ws + S_SSQ_Q), (float*)(ws + S_GLR));
    } SEAM(10);
    if (IN(11)) REP(11) { __syncthreads(); g1_phase(args, F); } SEAM(11);
    if (IN(12)) { g2_phase(F); } SEAM(12);
    if (IN(13)) REP(13) { __syncthreads(); g3_phase(args, F); } SEAM(13);
    if (IN(14)) {
        pg8::DenseSched S; S.init(NREAL, 1024, F.G, (int)blockIdx.x, ws + A_OG, 1024, ws + W_OG, 1024);
        EpiRes E{nullptr, (bf16*)(ws + A_HB)}; pg8::gemm_phase(ldsl, 1024, S, E);
    } SEAM(14);
#endif
#if STOP_AFTER >= 15
    if (IN(15)) { route_phase(args, F, 1, (const bf16*)(ws + A_HB), F.ctl + CW_CNT + 32, (int*)(ws + S_LIST), (float*)(ws + S_WTS), (unsigned*)(ws + S_EPOS), (float*)(ws + A_RSL));
        { MoeTables T0 = moe_tables(F, F.ctl + CW_CNT);
          const int tot = (int)T0.tpre[32] * 2, maxu = (tot + F.G - 1) / F.G, thr = tot - (maxu - 1) * F.G, nfill = F.G - thr; int cov = nfill > 0 ? nfill * NWAVES * P7_FILL2_PER_WAVE : 0; cov = cov < GU_ITEMS ? cov : GU_ITEMS;
          def_convert<7>(args, F, WD_ITEMS + cov + F.vcu * NWAVES + F.wave, F.G * NWAVES, D7_ITEMS, 1 << 30); }
    } SEAM(15);
    if (IN(16)) REP(16) { __syncthreads();
        MoeTables T = moe_tables(F, F.ctl + CW_CNT + 32);
        MoeSched S{T, 2, F.G, F.vcu, true, (const char*)(ws + A_HB), 1024, (const char*)(ws + W_GU) + (size_t)32 * 512 * 1024 * 2, 1024, (size_t)512 * 1024 * 2, (const int*)(ws + S_LIST)};
        EpiGU E{(bf16*)(ws + A_HID), (const float*)(ws + A_RSL), T.cnt}; pg8::gemm_phase(ldsl, 1024, S, E);
        def_fill_idle<16>(args, F, (int)T.tpre[32] * 2, D16_ITEMS, P7_FILL_PER_WAVE, true);
    } SEAM(16);
    if (IN(17)) REP(17) { __syncthreads();
        MoeTables T = moe_tables(F, F.ctl + CW_CNT + 32);
        MoeSched S{T, 4, F.G, F.vcu, false, (const char*)(ws + A_HID), 256, (const char*)(ws + W_D) + (size_t)32 * 1024 * 256 * 2, 256, (size_t)1024 * 256 * 2, (const int*)(ws + S_LIST)};
        EpiDown E{(unsigned char*)(ws + A_Y), T.cnt, T.cpre}; pg8::gemm_phase(ldsl, 256, S, E);
    } SEAM(17);
    if (IN(18)) { MoeTables T = moe_tables(F, F.ctl + CW_CNT + 32); combine_rows<true>(args, F, T, nullptr); }
#endif
#undef IN
#undef SEAM
}

#ifndef N_LAUNCH_SPLIT
#define N_LAUNCH_SPLIT 0
#endif
extern "C" void kernel_launch(void* const* d_in, const int* in_sizes, int n_in, void* d_out, int out_size, void* d_ws, size_t ws_size, hipStream_t stream) {
    static int grid = 0;
    if (grid == 0) {
        if (n_in != 24 || ws_size < WS_END) { fprintf(stderr, "kernel_launch: needs 24 inputs and %zu bytes of workspace (got %d, %zu)\n", (size_t)WS_END, n_in, ws_size); grid = -1; return; }
        int dev = 0, cus = 0, per_cu = 0;
        if (hipGetDevice(&dev) != hipSuccess || hipDeviceGetAttribute(&cus, hipDeviceAttributeMultiprocessorCount, dev) != hipSuccess) { grid = -1; return; }
        if (hipFuncSetAttribute((const void*)fwd_kernel, hipFuncAttributeMaxDynamicSharedMemorySize, LDS_BYTES) != hipSuccess) { fprintf(stderr, "kernel_launch: hipFuncSetAttribute failed\n"); grid = -1; return; }
        if (hipOccupancyMaxActiveBlocksPerMultiprocessor(&per_cu, (const void*)fwd_kernel, NTHREADS, LDS_BYTES) != hipSuccess || per_cu < 1) fprintf(stderr, "kernel_launch: occupancy query says %d\n", per_cu);
        (void)hipGetLastError();
        grid = cus;
    }
    if (grid < 0) return;
    (void)hipMemsetAsync((char*)d_ws + WS_CTL, 0, CTL_ZERO_BYTES, stream);
    Args a{};
    for (int i = 0; i < 24; ++i) a.in[i] = (const float*)d_in[i];
    a.out = (float*)d_out; a.ws = (unsigned char*)d_ws;
#if N_LAUNCH_SPLIT
    for (int p = 0; p < N_PHASES; ++p) { a.ph_lo = p; a.ph_hi = p + 1; hipLaunchKernelGGL(fwd_kernel, dim3(grid), dim3(NTHREADS), LDS_BYTES, stream, a); }
#else
    a.ph_lo = 0; a.ph_hi = N_PHASES;
    hipLaunchKernelGGL(fwd_kernel, dim3(grid), dim3(NTHREADS), LDS_BYTES, stream, a);
#endif
}
```
